# Optimizing an MI355X kernel written in HIP

```python
import math
import jax, jax.numpy as jnp
from jax import lax
import numpy as np

D_MODEL = 2048
BATCH = 4
SEQ = 2048
DEPTH = 1

PLE_DIM = 256
EPS = 1e-6
NEG = -1e30
POOL_WIDTH = D_MODEL // 2
POOL_WINDOWS = (2, 4, 8, 16)
POOL_GROUPS = len(POOL_WINDOWS)
POOL_GROUP_DIM = POOL_WIDTH // POOL_GROUPS
HEAD_DIM = 128
N_HEADS = (D_MODEL // 2) // HEAD_DIM
N_KV_GROUPS = 2
HEADS_PER_GROUP = N_HEADS // N_KV_GROUPS
NSA_WIDTH = N_HEADS * HEAD_DIM
KV_WIDTH = N_KV_GROUPS * HEAD_DIM
N_BRANCH = 3
IN_WIDTH = POOL_WIDTH + NSA_WIDTH + 6 * KV_WIDTH + N_HEADS * N_BRANCH
ATTN_SCALE = HEAD_DIM ** -0.5
CMP_BLOCK = 32
CMP_STRIDE = 16
CMP_HIDDEN = 128
SEL_BLOCK = 64
N_SELECT = 16
SEL_QCHUNK = 32
WINDOW = 512
WIN_QBLOCK = 128
ROPE_THETA = 500000.0
ROPE_DIM = HEAD_DIM // 4
D_FF = -(-8 * D_MODEL // (3 * 256)) * 256

kernel_name = "hymba_pool_nsa_swiglu_ple"


def rmsnorm(x, g):
    xf = x.astype(jnp.float32)
    y = xf * lax.rsqrt(jnp.mean(xf * xf, axis=-1, keepdims=True) + EPS)
    return (y * g.astype(jnp.float32)).astype(x.dtype)


def rope_tables(T):
    pos = jnp.arange(T, dtype=jnp.float32)
    inv_freq = ROPE_THETA ** (-jnp.arange(0, ROPE_DIM, 2, dtype=jnp.float32) / ROPE_DIM)
    ang = pos[:, None] * inv_freq[None, :]
    return jnp.cos(ang)[:, None, :], jnp.sin(ang)[:, None, :]


def partial_rope(x, cos, sin):
    half = ROPE_DIM // 2
    cos = cos.astype(x.dtype)
    sin = sin.astype(x.dtype)
    x1 = x[..., :half]
    x2 = x[..., half:ROPE_DIM]
    return jnp.concatenate([x1 * cos - x2 * sin, x2 * cos + x1 * sin, x[..., ROPE_DIM:]], axis=-1)


def pool_mixer(u, pool_w, pool_scale):
    B, T, _ = u.shape
    uf = u.astype(jnp.float32).reshape(B, T, POOL_GROUPS, POOL_GROUP_DIM)
    cs = jnp.concatenate([jnp.zeros_like(uf[:, :1]), jnp.cumsum(uf, axis=1)], axis=1)
    t = jnp.arange(T)
    outs = []
    for gi, w in enumerate(POOL_WINDOWS):
        start = jnp.maximum(t + 1 - w, 0)
        win_sum = cs[:, t + 1, gi] - cs[:, start, gi]
        count = (t + 1 - start).astype(jnp.float32)[None, :, None]
        outs.append(win_sum / count - uf[:, :, gi])
    pooled = jnp.stack(outs, axis=2).astype(u.dtype)
    y = jnp.einsum('btgc,gcd->btgd', pooled, pool_w).reshape(B, T, POOL_WIDTH)
    return y * pool_scale


def compress_blocks(k, pe, w1, w2):
    B, T, G, D = k.shape
    n_cmp = (T - CMP_BLOCK) // CMP_STRIDE + 1
    idx = CMP_STRIDE * jnp.arange(n_cmp)[:, None] + jnp.arange(CMP_BLOCK)[None, :]
    blocks = k[:, idx] + pe[None, None, :, None, :]
    flat = blocks.transpose(0, 1, 3, 2, 4).reshape(B, n_cmp, G, CMP_BLOCK * D)
    return jax.nn.gelu(flat @ w1) @ w2


def nsa_mixer(q, kc, vc, ks, vs, kw, vw, gates,
              cmp_k_pe, cmp_k_w1, cmp_k_w2, cmp_v_pe, cmp_v_w1, cmp_v_w2):
    B, T, H, D = q.shape
    G, R = N_KV_GROUPS, HEADS_PER_GROUP
    dt = q.dtype
    t = jnp.arange(T)
    qg = q.reshape(B, T, G, R, D)

    kcmp = compress_blocks(kc, cmp_k_pe, cmp_k_w1, cmp_k_w2)
    vcmp = compress_blocks(vc, cmp_v_pe, cmp_v_w1, cmp_v_w2)
    n_cmp = kcmp.shape[1]
    s = jnp.einsum('btgrd,bngd->bgrtn', qg, kcmp).astype(jnp.float32) * ATTN_SCALE
    blk_end = CMP_STRIDE * jnp.arange(n_cmp) + CMP_BLOCK - 1
    valid = blk_end[None, :] <= t[:, None]
    p_cmp = jax.nn.softmax(jnp.where(valid, s, NEG), axis=-1) * valid
    o_cmp = jnp.einsum('bgrtn,bngd->btgrd', p_cmp.astype(dt), vcmp)

    n_sel = T // SEL_BLOCK
    cstart = CMP_STRIDE * jnp.arange(n_cmp)
    sstart = SEL_BLOCK * jnp.arange(n_sel)
    overlap = ((cstart[:, None] < sstart[None, :] + SEL_BLOCK) &
               (cstart[:, None] + CMP_BLOCK > sstart[None, :])).astype(jnp.float32)
    imp = jnp.einsum('bgtn,ns->bgts', p_cmp.sum(axis=2), overlap)
    j = jnp.arange(n_sel)[None, :]
    cur = (t // SEL_BLOCK)[:, None]
    forced = (j == 0) | (j == cur) | (j == cur - 1)
    imp = jnp.where(j > cur, -jnp.inf, jnp.where(forced, jnp.inf, imp))
    k_top = min(N_SELECT, n_sel)
    _, sel_idx = lax.top_k(imp, k_top)

    ksb = ks.transpose(0, 2, 1, 3).reshape(B, G, n_sel, SEL_BLOCK, D)
    vsb = vs.transpose(0, 2, 1, 3).reshape(B, G, n_sel, SEL_BLOCK, D)
    n_chunk = T // SEL_QCHUNK
    q_ch = qg.transpose(0, 2, 3, 1, 4).reshape(B, G, R, n_chunk, SEL_QCHUNK, D).transpose(3, 0, 1, 2, 4, 5)
    idx_ch = sel_idx.reshape(B, G, n_chunk, SEL_QCHUNK, k_top).transpose(2, 0, 1, 3, 4)
    t_ch = t.reshape(n_chunk, SEL_QCHUNK)
    bi = jnp.arange(B)[:, None, None, None]
    gi = jnp.arange(G)[None, :, None, None]
    in_blk = jnp.arange(SEL_BLOCK)

    def sel_chunk(args):
        qc, ic, tc = args
        kb = ksb[bi, gi, ic]
        vb = vsb[bi, gi, ic]
        sc = jnp.einsum('bgrqd,bgqksd->bgrqks', qc, kb).astype(jnp.float32) * ATTN_SCALE
        kpos = ic[..., None] * SEL_BLOCK + in_blk
        mask = kpos <= tc[None, None, :, None, None]
        sc = jnp.where(mask[:, :, None], sc, NEG)
        pr = jax.nn.softmax(sc.reshape(B, G, R, SEL_QCHUNK, -1), axis=-1).reshape(sc.shape)
        return jnp.einsum('bgrqks,bgqksd->bgrqd', pr.astype(dt), vb)

    o_sel = lax.map(sel_chunk, (q_ch, idx_ch, t_ch))
    o_sel = o_sel.transpose(1, 0, 4, 2, 3, 5).reshape(B, T, G, R, D)

    nb = T // WIN_QBLOCK
    nw = WINDOW // WIN_QBLOCK
    band = jnp.arange(nb)[:, None] + jnp.arange(nw + 1)[None, :]
    pad = ((0, 0), (0, 0), (WINDOW, 0), (0, 0))
    kwp = jnp.pad(kw.transpose(0, 2, 1, 3), pad).reshape(B, G, nb + nw, WIN_QBLOCK, D)
    vwp = jnp.pad(vw.transpose(0, 2, 1, 3), pad).reshape(B, G, nb + nw, WIN_QBLOCK, D)
    kband = kwp[:, :, band].reshape(B, G, nb, (nw + 1) * WIN_QBLOCK, D)
    vband = vwp[:, :, band].reshape(B, G, nb, (nw + 1) * WIN_QBLOCK, D)
    qb = qg.transpose(0, 2, 3, 1, 4).reshape(B, G, R, nb, WIN_QBLOCK, D)
    sw = jnp.einsum('bgrnqd,bgnkd->bgrnqk', qb, kband).astype(jnp.float32) * ATTN_SCALE
    qpos = jnp.arange(nb)[:, None] * WIN_QBLOCK + jnp.arange(WIN_QBLOCK)[None, :]
    kpos = jnp.arange(nb)[:, None] * WIN_QBLOCK - WINDOW + jnp.arange((nw + 1) * WIN_QBLOCK)[None, :]
    diff = qpos[:, :, None] - kpos[:, None, :]
    wmask = (diff >= 0) & (diff < WINDOW) & (kpos[:, None, :] >= 0)
    pw = jax.nn.softmax(jnp.where(wmask, sw, NEG), axis=-1)
    o_win = jnp.einsum('bgrnqk,bgnkd->bgrnqd', pw.astype(dt), vband)
    o_win = o_win.transpose(0, 3, 4, 1, 2, 5).reshape(B, T, G, R, D)

    g = jax.nn.sigmoid(gates.astype(jnp.float32)).astype(dt).reshape(B, T, G, R, N_BRANCH, 1)
    o = g[..., 0, :] * o_cmp + g[..., 1, :] * o_sel + g[..., 2, :] * o_win
    return o.reshape(B, T, NSA_WIDTH)


def hybrid_mixer(a, w_in, pool_w, pool_scale, cmp_k_pe, cmp_k_w1, cmp_k_w2,
                 cmp_v_pe, cmp_v_w1, cmp_v_w2, w_out, cos, sin):
    B, T, _ = a.shape
    proj = a @ w_in
    offs = [int(o) for o in np.cumsum([POOL_WIDTH, NSA_WIDTH] + [KV_WIDTH] * 6)]
    u, q, kc, vc, ks, vs, kw, vw, gts = jnp.split(proj, offs, axis=-1)
    kvshape = (B, T, N_KV_GROUPS, HEAD_DIM)
    q = partial_rope(q.reshape(B, T, N_HEADS, HEAD_DIM), cos, sin)
    kc = partial_rope(kc.reshape(kvshape), cos, sin)
    ks = partial_rope(ks.reshape(kvshape), cos, sin)
    kw = partial_rope(kw.reshape(kvshape), cos, sin)
    y_nsa = nsa_mixer(q, kc, vc.reshape(kvshape), ks, vs.reshape(kvshape), kw, vw.reshape(kvshape),
                      gts.reshape(B, T, N_HEADS, N_BRANCH),
                      cmp_k_pe, cmp_k_w1, cmp_k_w2, cmp_v_pe, cmp_v_w1, cmp_v_w2)
    y_pool = pool_mixer(u, pool_w, pool_scale)
    return jnp.concatenate([y_pool, y_nsa], axis=-1) @ w_out


def swiglu(x, w_gate, w_up, w_down):
    return (jax.nn.silu(x @ w_gate) * (x @ w_up)) @ w_down


def setup_inputs(seed: int = 0) -> dict:
    key = jax.random.key(seed)
    ks = jax.random.split(key, 24)
    f32 = jnp.float32
    L = DEPTH

    def nrm(k, shape, scale):
        return jax.random.normal(k, shape, f32) * scale

    def gain(k, shape):
        return 1.0 + 0.02 * jax.random.normal(k, shape, f32)

    return {
        'x': jax.random.normal(ks[0], (BATCH, SEQ, D_MODEL), f32),
        'p': jax.random.normal(ks[1], (DEPTH, BATCH, SEQ, PLE_DIM), f32),
        'in_norm_g': gain(ks[2], (L, D_MODEL)),
        'w_in': nrm(ks[3], (L, D_MODEL, IN_WIDTH), D_MODEL ** -0.5),
        'pool_w': nrm(ks[4], (L, POOL_GROUPS, POOL_GROUP_DIM, POOL_GROUP_DIM), POOL_GROUP_DIM ** -0.5),
        'pool_scale': gain(ks[5], (L, POOL_WIDTH)),
        'cmp_k_pe': nrm(ks[6], (L, CMP_BLOCK, HEAD_DIM), 0.02),
        'cmp_k_w1': nrm(ks[7], (L, CMP_BLOCK * HEAD_DIM, CMP_HIDDEN), (CMP_BLOCK * HEAD_DIM) ** -0.5),
        'cmp_k_w2': nrm(ks[8], (L, CMP_HIDDEN, HEAD_DIM), CMP_HIDDEN ** -0.5),
        'cmp_v_pe': nrm(ks[9], (L, CMP_BLOCK, HEAD_DIM), 0.02),
        'cmp_v_w1': nrm(ks[10], (L, CMP_BLOCK * HEAD_DIM, CMP_HIDDEN), (CMP_BLOCK * HEAD_DIM) ** -0.5),
        'cmp_v_w2': nrm(ks[11], (L, CMP_HIDDEN, HEAD_DIM), CMP_HIDDEN ** -0.5),
        'w_out': nrm(ks[12], (L, D_MODEL, D_MODEL), D_MODEL ** -0.5),
        'ffn_norm_g': gain(ks[13], (L, D_MODEL)),
        'w_gate': nrm(ks[14], (L, D_MODEL, D_FF), D_MODEL ** -0.5),
        'w_up': nrm(ks[15], (L, D_MODEL, D_FF), D_MODEL ** -0.5),
        'w_down': nrm(ks[16], (L, D_FF, D_MODEL), D_FF ** -0.5),
        'ple_norm_g': gain(ks[17], (L, D_MODEL)),
        'w_ple_gate': nrm(ks[18], (L, D_MODEL, D_MODEL), D_MODEL ** -0.5),
        'w_ple_proj': nrm(ks[19], (L, PLE_DIM, D_MODEL), PLE_DIM ** -0.5),
        'final_norm_g': gain(ks[20], (D_MODEL,)),
    }


def reference(x, p, in_norm_g, w_in, pool_w, pool_scale, cmp_k_pe, cmp_k_w1, cmp_k_w2,
              cmp_v_pe, cmp_v_w1, cmp_v_w2, w_out, ffn_norm_g, w_gate, w_up, w_down,
              ple_norm_g, w_ple_gate, w_ple_proj, final_norm_g):
    T = x.shape[1]
    cos, sin = rope_tables(T)
    h = x
    for i in range(DEPTH):
        a = rmsnorm(h, in_norm_g[i])
        h = h + hybrid_mixer(a, w_in[i], pool_w[i], pool_scale[i], cmp_k_pe[i], cmp_k_w1[i], cmp_k_w2[i],
                             cmp_v_pe[i], cmp_v_w1[i], cmp_v_w2[i], w_out[i], cos, sin)
        h = h + swiglu(rmsnorm(h, ffn_norm_g[i]), w_gate[i], w_up[i], w_down[i])
        gate = jax.nn.sigmoid((rmsnorm(h, ple_norm_g[i]) @ w_ple_gate[i]).astype(jnp.float32)).astype(h.dtype)
        h = h + (p[i] @ w_ple_proj[i]) * gate
    return rmsnorm(h, final_norm_g)
```

```cpp
#include <hip/hip_runtime.h>
#include <cstdio>
#include <cstdint>
#include <cmath>
namespace pg8 {
#define PG8_LAS __attribute__((address_space(3)))
typedef unsigned short bf16_t;
typedef short bf16x8 __attribute__((ext_vector_type(8)));
typedef float f32x4 __attribute__((ext_vector_type(4)));
typedef unsigned u32x4 __attribute__((ext_vector_type(4)));
constexpr int BM = 256, BK = 64, HALF = 128, HTB = HALF * BK * 2  , STAGE_BYTES = 8 * HTB, NXCD = 8, WGM = 8;

__host__ __device__ __forceinline__ int lds_byte(int r, int c) { const int st = (r >> 4) * 2 + (c >> 5), rr = r & 15, cc = c & 31, ob = rr * 64 + cc * 2; return st * 1024 + (ob ^ (((ob >> 9) & 1) << 5)); }
__host__ __device__ __forceinline__ void stage_rc(int b, int& R, int& C) { const int st = b / 1024, sb = b % 1024, swz = sb ^ (((sb >> 9) & 1) << 5); R = (st >> 1) * 16 + swz / 64; C = (st & 1) * 32 + (swz % 64) / 2; }
__host__ __device__ __forceinline__ int perm32(int rho) { const int n = rho >> 4, i = rho & 15; return 8 * (i >> 2) + 4 * n + (i & 3); }

struct Unit { int pm, pn; };
struct Gemm { const bf16_t* A; const bf16_t* Bt; int M, N, K; };

struct StaticOrder {
    int nM, nN, nwg, G, c;
    __host__ __device__ void init(int M, int N, int G_, int c_) { nM = M / BM; nN = N / BM; nwg = nM * nN; G = G_; c = c_; }
    __host__ __device__ bool next(int i, Unit& u) const {
        const long L = (long)i * G + c; if (L >= nwg) return false;
        int wgid = (int)L; { const int q = nwg / NXCD, r = nwg % NXCD, xcd = wgid % NXCD, off = wgid / NXCD; wgid = (xcd < r ? xcd * (q + 1) : r * (q + 1) + (xcd - r) * q) + off; }
        const int nig = WGM * nN, gid = wgid / nig, fm = gid * WGM, gsz = (nM - fm) < WGM ? (nM - fm) : WGM;
        u.pm = fm + ((wgid % nig) % gsz); u.pn = (wgid % nig) / gsz; return true;
    }
    __host__ __device__ bool next_linear(long L, Unit& u) const {
        if (L >= nwg) return false;
        int wgid = (int)L; { const int q = nwg / NXCD, r = nwg % NXCD, xcd = wgid % NXCD, off = wgid / NXCD; wgid = (xcd < r ? xcd * (q + 1) : r * (q + 1) + (xcd - r) * q) + off; }
        const int nig = WGM * nN, gid = wgid / nig, fm = gid * WGM, gsz = (nM - fm) < WGM ? (nM - fm) : WGM;
        u.pm = fm + ((wgid % nig) % gsz); u.pn = (wgid % nig) / gsz; return true;
    }
    __device__ __forceinline__ void a_ready(const Unit&) const {}
    __device__ __forceinline__ void done(const Unit&) const {}
};

typedef float f32x2_cv __attribute__((ext_vector_type(2))); typedef __bf16 bf16x2_cv __attribute__((ext_vector_type(2)));
__device__ __forceinline__ unsigned cvt_pk_bf16(float lo, float hi) { f32x2_cv v = {lo, hi}; bf16x2_cv b = __builtin_convertvector(v, bf16x2_cv); return __builtin_bit_cast(unsigned, b); }
template <class Epi, class Sched, bool ALIGN_EPI = false, bool SP2 = false>
__device__ __forceinline__ void gemm_phase(PG8_LAS unsigned char* lds, const Gemm g, const Sched& S, const Epi& E) {
    int tid_ = threadIdx.x; asm volatile("" : "+v"(tid_));
    const int tid = tid_, wid = __builtin_amdgcn_readfirstlane(tid >> 6), lane = tid & 63, wr = wid >> 2, wc = wid & 3, fr = lane & 15, fq = lane >> 4;
    const int K = g.K, nt = K / BK;
    unsigned voffA[2], voffB[2];
#pragma unroll
    for (int i = 0; i < 2; ++i) { int R, C; stage_rc(tid * 16 + i * 8192, R, C); const int Rb = Epi::PERM ? ((R & ~31) + perm32(R & 31)) : R;
        voffA[i] = (unsigned)(R * K + C) * 2u; voffB[i] = (unsigned)(Rb * K + C) * 2u; }
    const size_t kstep = (size_t)(BK * 2);
    const size_t hstep = (size_t)HALF * K * 2;
    const size_t tstep = 2 * hstep;
    const unsigned ldsw = (unsigned)wid * 1024u;
    const int aoff = lds_byte(wr * 64 + fr, fq * 8), boff = lds_byte(wc * 32 + fr, fq * 8);
#define PG8_SA(b, h) (((b) * 2 + (h)) * HTB)
#define PG8_SB(b, h) ((4 + (b) * 2 + (h)) * HTB)
#define PG8_STAGE(bufoff, gbase, voff) do { _Pragma("unroll") for (int _i = 0; _i < 2; ++_i) \
        __builtin_amdgcn_global_load_lds((const unsigned*)((const char*)(gbase) + (voff)[_i]), (PG8_LAS unsigned*)(lds + (bufoff) + ldsw + _i * 8192), 16, 0, 0); } while (0)
#define PG8_LDA(dst, b, h) do { _Pragma("unroll") for (int m = 0; m < 4; ++m) _Pragma("unroll") for (int k = 0; k < 2; ++k) dst[m][k] = *(const PG8_LAS bf16x8*)(lds + PG8_SA(b, h) + aoff + m * 2048 + k * 1024); } while (0)
#define PG8_LDB(dst, b, h) do { _Pragma("unroll") for (int n = 0; n < 2; ++n) _Pragma("unroll") for (int k = 0; k < 2; ++k) dst[n][k] = *(const PG8_LAS bf16x8*)(lds + PG8_SB(b, h) + boff + n * 2048 + k * 1024); } while (0)
#define PG8_MMA(ai, bj, At, Bt) do { __builtin_amdgcn_s_setprio(1); _Pragma("unroll") for (int m = 0; m < 4; ++m) _Pragma("unroll") for (int n = 0; n < 2; ++n) _Pragma("unroll") for (int k = 0; k < 2; ++k) \
        acc[ai][bj][m][n] = __builtin_amdgcn_mfma_f32_16x16x32_bf16(Bt[n][k], At[m][k], acc[ai][bj][m][n], 0, 0, 0); __builtin_amdgcn_s_setprio(0); } while (0)
#define PG8_WAIT_V(n) asm volatile("s_waitcnt vmcnt(" #n ")" ::: "memory")
#define PG8_WAIT_L(n) asm volatile("s_waitcnt lgkmcnt(" #n ")" ::: "memory")
#define PG8_BAR __builtin_amdgcn_s_barrier()
#define PG8_SCHED __builtin_amdgcn_sched_barrier(0)
    Unit cur, nxt; int ui = 0;
    if (!S.next(0, cur)) return;
    f32x4 acc[2][2][4][2];
#pragma unroll
    for (int a = 0; a < 2; ++a)
#pragma unroll
        for (int b = 0; b < 2; ++b)
#pragma unroll
            for (int m = 0; m < 4; ++m)
#pragma unroll
                for (int n = 0; n < 2; ++n) acc[a][b][m][n] = (f32x4){0.f, 0.f, 0.f, 0.f};
    bf16x8 At[4][2], B0[2][2], B1[2][2];
    const char* cA = (const char*)g.A + (size_t)cur.pm * tstep; const char* cB = (const char*)g.Bt + (size_t)cur.pn * tstep;
    S.a_ready(cur);
    if constexpr (SP2) {
        PG8_STAGE(PG8_SB(0, 0), cB, voffB); PG8_STAGE(PG8_SB(0, 1), cB + hstep, voffB); PG8_STAGE(PG8_SA(0, 0), cA, voffA); PG8_STAGE(PG8_SA(0, 1), cA + hstep, voffA);
        if (wr == 1) PG8_BAR;
        PG8_WAIT_V(2); PG8_BAR;
        PG8_STAGE(PG8_SB(1, 0), cB + kstep, voffB); PG8_STAGE(PG8_SA(1, 0), cA + kstep, voffA); PG8_STAGE(PG8_SB(1, 1), cB + hstep + kstep, voffB);
        PG8_WAIT_V(6); PG8_BAR;
    } else {
        PG8_STAGE(PG8_SB(0, 0), cB, voffB); PG8_STAGE(PG8_SA(0, 0), cA, voffA); PG8_STAGE(PG8_SB(0, 1), cB + hstep, voffB); PG8_STAGE(PG8_SA(0, 1), cA + hstep, voffA);
        if (wr == 1) PG8_BAR;
        PG8_WAIT_V(4); PG8_BAR;
        PG8_STAGE(PG8_SB(1, 0), cB + kstep, voffB); PG8_STAGE(PG8_SA(1, 0), cA + kstep, voffA); PG8_STAGE(PG8_SB(1, 1), cB + hstep + kstep, voffB);
        PG8_WAIT_V(6); PG8_BAR;
    }
    for (;;) {
        const bool has_next = S.next(ui + 1, nxt);
        const char* nA = has_next ? (const char*)g.A + (size_t)nxt.pm * tstep : cA; const char* nB = has_next ? (const char*)g.Bt + (size_t)nxt.pn * tstep : cB;
        for (int t = 0; t < nt; t += 2) {
            const bool last = (t == nt - 2);
            const char* a1 = cA + (size_t)(t + 1) * kstep;
            const char* a2 = last ? nA : cA + (size_t)(t + 2) * kstep; const char* b2 = last ? nB : cB + (size_t)(t + 2) * kstep;
            const char* a3 = a2 + kstep; const char* b3 = b2 + kstep;
            if (last && has_next) S.a_ready(nxt);
            if constexpr (SP2) {
            PG8_LDB(B0, 0, 0); PG8_LDB(B1, 0, 1); PG8_SCHED; PG8_LDA(At, 0, 0); PG8_STAGE(PG8_SA(1, 1), a1 + hstep, voffA);
            PG8_WAIT_V(8); PG8_WAIT_L(0); PG8_BAR; PG8_MMA(0, 0, At, B0); PG8_MMA(0, 1, At, B1); PG8_BAR; PG8_SCHED;
            PG8_LDA(At, 0, 1); PG8_STAGE(PG8_SB(0, 0), b2, voffB); PG8_STAGE(PG8_SB(0, 1), b2 + hstep, voffB); PG8_STAGE(PG8_SA(0, 0), a2, voffA);
            PG8_WAIT_V(8); PG8_WAIT_L(0); PG8_BAR; PG8_MMA(1, 0, At, B0); PG8_MMA(1, 1, At, B1); PG8_BAR; PG8_SCHED;
            PG8_LDB(B0, 1, 0); PG8_LDB(B1, 1, 1); PG8_SCHED; PG8_LDA(At, 1, 0); PG8_STAGE(PG8_SA(0, 1), a2 + hstep, voffA);
            PG8_WAIT_V(8); PG8_WAIT_L(0); PG8_BAR; PG8_MMA(0, 0, At, B0); PG8_MMA(0, 1, At, B1); PG8_BAR; PG8_SCHED;
            PG8_LDA(At, 1, 1); PG8_STAGE(PG8_SB(1, 0), b3, voffB); PG8_STAGE(PG8_SB(1, 1), b3 + hstep, voffB); PG8_STAGE(PG8_SA(1, 0), a3, voffA);
            PG8_WAIT_V(8); PG8_WAIT_L(0); PG8_BAR; PG8_MMA(1, 0, At, B0); PG8_MMA(1, 1, At, B1); PG8_BAR; PG8_SCHED;
            } else {
            PG8_LDB(B0, 0, 0); PG8_SCHED; PG8_LDA(At, 0, 0); PG8_STAGE(PG8_SA(1, 1), a1 + hstep, voffA);
            PG8_WAIT_L(8); PG8_BAR; PG8_WAIT_L(0); PG8_MMA(0, 0, At, B0); PG8_BAR; PG8_SCHED;
            PG8_LDB(B1, 0, 1); PG8_STAGE(PG8_SB(0, 0), b2, voffB);
            PG8_BAR; PG8_WAIT_L(0); PG8_MMA(0, 1, At, B1); PG8_BAR;
            PG8_LDA(At, 0, 1); PG8_STAGE(PG8_SA(0, 0), a2, voffA);
            PG8_BAR; PG8_WAIT_L(0); PG8_MMA(1, 0, At, B0); PG8_BAR; PG8_SCHED;
            PG8_STAGE(PG8_SB(0, 1), b2 + hstep, voffB);
            PG8_WAIT_V(6); PG8_BAR; PG8_MMA(1, 1, At, B1); PG8_BAR;
            PG8_LDB(B0, 1, 0); PG8_SCHED; PG8_LDA(At, 1, 0); PG8_STAGE(PG8_SA(0, 1), a2 + hstep, voffA);
            PG8_WAIT_L(8); PG8_BAR; PG8_WAIT_L(0); PG8_MMA(0, 0, At, B0); PG8_BAR; PG8_SCHED;
            PG8_LDB(B1, 1, 1); PG8_STAGE(PG8_SB(1, 0), b3, voffB);
            PG8_BAR; PG8_WAIT_L(0); PG8_MMA(0, 1, At, B1); PG8_BAR;
            PG8_LDA(At, 1, 1); PG8_STAGE(PG8_SA(1, 0), a3, voffA);
            PG8_BAR; PG8_WAIT_L(0); PG8_MMA(1, 0, At, B0); PG8_BAR; PG8_SCHED;
            PG8_STAGE(PG8_SB(1, 1), b3 + hstep, voffB);
            PG8_WAIT_V(6); PG8_BAR; PG8_MMA(1, 1, At, B1); PG8_BAR;
            }
        }
        if constexpr (ALIGN_EPI) { if (wr == 0) PG8_BAR; }
        if constexpr (!Epi::AFTER_DRAIN) { E(acc, cur, wr, wc, fr, fq); S.done(cur); }
        if (!has_next) break;
#pragma unroll
        for (int a = 0; a < 2; ++a)
#pragma unroll
            for (int b = 0; b < 2; ++b)
#pragma unroll
                for (int m = 0; m < 4; ++m)
#pragma unroll
                    for (int n = 0; n < 2; ++n) acc[a][b][m][n] = (f32x4){0.f, 0.f, 0.f, 0.f};
        cur = nxt; cA = nA; cB = nB; ++ui;
        if constexpr (ALIGN_EPI) { if (wr == 1) PG8_BAR; }
    }
    PG8_WAIT_V(0);
    if constexpr (!ALIGN_EPI) { if (wr == 0) PG8_BAR; }
    PG8_BAR;
    if constexpr (Epi::AFTER_DRAIN) { E.fused(acc, cur, wr, wc, fr, fq, lds, wid, lane); S.done(cur); }
#undef PG8_SA
#undef PG8_SB
#undef PG8_STAGE
#undef PG8_LDA
#undef PG8_LDB
#undef PG8_MMA
#undef PG8_WAIT_V
#undef PG8_WAIT_L
#undef PG8_BAR
#undef PG8_SCHED
}
}

using pg8::bf16_t; using pg8::bf16x8; using pg8::f32x4; using pg8::u32x4; using pg8::Unit; using pg8::cvt_pk_bf16;
#define LAS __attribute__((address_space(3)))
typedef short s16x4 __attribute__((ext_vector_type(4)));
typedef float f32x16 __attribute__((ext_vector_type(16)));
typedef unsigned u32x2 __attribute__((ext_vector_type(2)));

constexpr int DM = 2048, SEQ = 2048, MROWS = 8192, PLE = 256, INW = 3608, INWP = 3840, DFF = 5632;
constexpr int NTHREADS = 512;
constexpr size_t MiB = (size_t)1 << 20;
constexpr size_t TS = (size_t)MROWS * 256;
constexpr size_t WS_BIASK = 0, WS_BIASV = 512;
constexpr size_t WS_COS = 1 * MiB, WS_SIN = 1 * MiB + 131072, WS_GATES = 1 * MiB + 262144;
constexpr size_t WS_KCMP = 2 * MiB, WS_VCMP = 2 * MiB + 262144, WS_W2K = 2 * MiB + 524288, WS_W2V = WS_W2K + 32768;
constexpr size_t WS_W1K = 3 * MiB, WS_W1V = 4 * MiB, WS_POOLW = 5 * MiB, WS_WPP = 6 * MiB, WS_WIN = 7 * MiB, WS_WOUT = 22 * MiB;
constexpr size_t WS_WPG = 30 * MiB, WS_WD = 38 * MiB, WS_WGU = 60 * MiB, WS_PBF = 104 * MiB, WS_XN = 108 * MiB;
constexpr size_t WS_T = 140 * MiB, WS_Z = 196 * MiB, WS_SCR = 228 * MiB, WS_ACT = 140 * MiB, WS_PP = 140 * MiB, WS_END = 260 * MiB;
constexpr int LDS_BYTES = 147456;

#define LDS_WAIT() asm volatile("s_waitcnt lgkmcnt(0)" ::: "memory")
__device__ __forceinline__ float wave_sum(float v) {
#pragma unroll
    for (int o = 1; o < 64; o <<= 1) v += __shfl_xor(v, o);
    return v;
}
__device__ __forceinline__ float sigmoidf_(float x) { return __builtin_amdgcn_rcpf(1.f + __expf(-x)); }

struct EpiInProj {
    static constexpr bool PERM = true, AFTER_DRAIN = false;
    bf16_t* T; float* gates; const float* cosT; const float* sinT;
    __device__ __forceinline__ void operator()(const f32x4 (&acc)[2][2][4][2], const Unit& u, int wr, int wc, int fr, int fq) const {
        const int pn = u.pn; const int row0 = u.pm * 256 + wr * 64 + fr;
        if (pn < 14) {
            const bool rope = (wc == 0) && (pn >= 4) && (pn < 8 || ((pn & 1) == 0));
            bf16_t* base = T + (size_t)pn * TS;
#pragma unroll
            for (int ai = 0; ai < 2; ++ai)
#pragma unroll
                for (int m = 0; m < 4; ++m) {
                    const int row = row0 + ai * 128 + m * 16; const int pos = row & (SEQ - 1);
                    f32x4 cs0 = {1.f, 1.f, 1.f, 1.f}, cs1 = cs0, sn0 = {0.f, 0.f, 0.f, 0.f}, sn1 = sn0;
                    if (rope) { const float* ct = cosT + pos * 16 + 8 * (fq & 1); const float* st = sinT + pos * 16 + 8 * (fq & 1);
                        cs0 = *(const f32x4*)ct; cs1 = *(const f32x4*)(ct + 4); sn0 = *(const f32x4*)st; sn1 = *(const f32x4*)(st + 4);
                        if (fq < 2) { sn0 = -sn0; sn1 = -sn1; } }
#pragma unroll
                    for (int bj = 0; bj < 2; ++bj) {
                        f32x4 v0 = acc[ai][bj][m][0], v1 = acc[ai][bj][m][1];
                        if (rope) { f32x4 o0, o1;
#pragma unroll
                            for (int j = 0; j < 4; ++j) { o0[j] = __shfl_xor(v0[j], 32); o1[j] = __shfl_xor(v1[j], 32); }
                            v0 = v0 * cs0 + o0 * sn0; v1 = v1 * cs1 + o1 * sn1; }
                        u32x4 w; w.x = cvt_pk_bf16(v0[0], v0[1]); w.y = cvt_pk_bf16(v0[2], v0[3]); w.z = cvt_pk_bf16(v1[0], v1[1]); w.w = cvt_pk_bf16(v1[2], v1[3]);
                        *(u32x4*)(base + (size_t)row * 256 + bj * 128 + wc * 32 + 8 * fq) = w;
                    }
                }
        } else if (wc == 0 && fq < 3) {
#pragma unroll
            for (int ai = 0; ai < 2; ++ai)
#pragma unroll
                for (int m = 0; m < 4; ++m) {
                    const int row = row0 + ai * 128 + m * 16;
                    const f32x4 v0 = acc[ai][0][m][0], v1 = acc[ai][0][m][1];
                    const f32x4 s0 = {sigmoidf_(v0[0]), sigmoidf_(v0[1]), sigmoidf_(v0[2]), sigmoidf_(v0[3])}, s1 = {sigmoidf_(v1[0]), sigmoidf_(v1[1]), sigmoidf_(v1[2]), sigmoidf_(v1[3])};
                    *(f32x4*)(gates + (size_t)row * 24 + 8 * fq) = s0; *(f32x4*)(gates + (size_t)row * 24 + 8 * fq + 4) = s1;
                }
        }
    }
};
struct PoolOrder {
    int G, c;
    __device__ bool next(int i, Unit& u) const { const int L = i * G + c; if (L >= 128) return false; u.pm = L; u.pn = L >> 5; return true; }
    __device__ __forceinline__ void a_ready(const Unit&) const {}
    __device__ __forceinline__ void done(const Unit&) const {}
};
struct EpiPoolZ {
    static constexpr bool PERM = false, AFTER_DRAIN = false;
    float* Z;
    __device__ __forceinline__ void operator()(const f32x4 (&acc)[2][2][4][2], const Unit& u, int wr, int wc, int fr, int fq) const {
        const int row0 = (u.pm & 31) * 256 + wr * 64 + fr; const int col0 = u.pn * 256 + wc * 32 + 4 * fq;
        const __amdgpu_buffer_rsrc_t zr = __builtin_amdgcn_make_buffer_rsrc(Z, 0, MROWS * 1024 * 4, 0x00020000);
#pragma unroll
        for (int ai = 0; ai < 2; ++ai)
#pragma unroll
            for (int m = 0; m < 4; ++m)
#pragma unroll
                for (int bj = 0; bj < 2; ++bj)
#pragma unroll
                    for (int n = 0; n < 2; ++n) __builtin_amdgcn_raw_buffer_store_b128(__builtin_bit_cast(u32x4, acc[ai][bj][m][n]), zr, (unsigned)(((row0 + ai * 128 + m * 16) * 1024 + col0 + bj * 128 + n * 16) * 4), 0, 16);
    }
};
struct EpiStoreBf16 {
    static constexpr bool PERM = false, AFTER_DRAIN = false;
    bf16_t* O; int ldc;
    __device__ __forceinline__ void operator()(const f32x4 (&acc)[2][2][4][2], const Unit& u, int wr, int wc, int fr, int fq) const {
        const int row0 = u.pm * 256 + wr * 64 + fr; const int col0 = u.pn * 256 + wc * 32 + 4 * fq;
#pragma unroll
        for (int ai = 0; ai < 2; ++ai)
#pragma unroll
            for (int m = 0; m < 4; ++m)
#pragma unroll
                for (int bj = 0; bj < 2; ++bj)
#pragma unroll
                    for (int n = 0; n < 2; ++n) { const f32x4 v = acc[ai][bj][m][n]; u32x2 w; w.x = cvt_pk_bf16(v[0], v[1]); w.y = cvt_pk_bf16(v[2], v[3]);
                        *(u32x2*)(O + (size_t)(row0 + ai * 128 + m * 16) * ldc + col0 + bj * 128 + n * 16) = w; }
    }
};
struct EpiResid {
    static constexpr bool PERM = false, AFTER_DRAIN = false;
    const float* base; float* out;
    __device__ __forceinline__ void operator()(const f32x4 (&acc)[2][2][4][2], const Unit& u, int wr, int wc, int fr, int fq) const {
        const int row0 = u.pm * 256 + wr * 64 + fr; const int col0 = u.pn * 256 + wc * 32 + 4 * fq;
#pragma unroll
        for (int ai = 0; ai < 2; ++ai)
#pragma unroll
            for (int m = 0; m < 4; ++m)
#pragma unroll
                for (int bj = 0; bj < 2; ++bj)
#pragma unroll
                    for (int n = 0; n < 2; ++n) { const size_t off = (size_t)(row0 + ai * 128 + m * 16) * DM + col0 + bj * 128 + n * 16;
                        const f32x4 b = *(const f32x4*)(base + off); *(f32x4*)(out + off) = b + acc[ai][bj][m][n]; }
    }
};
struct EpiResidNorm {
    static constexpr bool PERM = true, AFTER_DRAIN = false;
    const float* basef; const bf16_t* baseb; bf16_t* hb; float* rowss;
    __device__ __forceinline__ void operator()(const f32x4 (&acc)[2][2][4][2], const Unit& u, int wr, int wc, int fr, int fq) const {
        const int row0 = u.pm * 256 + wr * 64 + fr; const int col0 = u.pn * 256 + wc * 32 + 8 * fq;
#pragma unroll
        for (int ai = 0; ai < 2; ++ai)
#pragma unroll
            for (int m = 0; m < 4; ++m) { const int row = row0 + ai * 128 + m * 16; float ss = 0.f;
#pragma unroll
                for (int bj = 0; bj < 2; ++bj) { const size_t off = (size_t)row * DM + col0 + bj * 128;
                    f32x4 b0, b1;
                    if (basef) { b0 = *(const f32x4*)(basef + off); b1 = *(const f32x4*)(basef + off + 4); }
                    else { const u32x4 bw = *(const u32x4*)(baseb + off);
                        b0 = (f32x4){__uint_as_float(bw.x << 16), __uint_as_float(bw.x & 0xffff0000u), __uint_as_float(bw.y << 16), __uint_as_float(bw.y & 0xffff0000u)};
                        b1 = (f32x4){__uint_as_float(bw.z << 16), __uint_as_float(bw.z & 0xffff0000u), __uint_as_float(bw.w << 16), __uint_as_float(bw.w & 0xffff0000u)}; }
                    const f32x4 o0 = b0 + acc[ai][bj][m][0], o1 = b1 + acc[ai][bj][m][1];
                    u32x4 w; w.x = cvt_pk_bf16(o0[0], o0[1]); w.y = cvt_pk_bf16(o0[2], o0[3]); w.z = cvt_pk_bf16(o1[0], o1[1]); w.w = cvt_pk_bf16(o1[2], o1[3]);
                    *(u32x4*)(hb + off) = w;
                    ss += ((o0[0] * o0[0] + o0[1] * o0[1]) + (o0[2] * o0[2] + o0[3] * o0[3])) + ((o1[0] * o1[0] + o1[1] * o1[1]) + (o1[2] * o1[2] + o1[3] * o1[3])); }
                ss += __shfl_xor(ss, 16); ss += __shfl_xor(ss, 32);
                if (fq == 0) unsafeAtomicAdd(rowss + row, ss); }
    }
};
struct UpperOrder {
    pg8::StaticOrder S; int lo, nup, c;
    __device__ bool next(int i, Unit& u) const { if (c < lo) return false; return S.next_linear((long)i * nup + (c - lo), u); }
    __device__ __forceinline__ void a_ready(const Unit&) const {}
    __device__ __forceinline__ void done(const Unit&) const {}
};
struct EpiSwiglu {
    static constexpr bool PERM = true, AFTER_DRAIN = false;
    bf16_t* O; const float* rowss;
    __device__ __forceinline__ void operator()(const f32x4 (&acc)[2][2][4][2], const Unit& u, int wr, int wc, int fr, int fq) const {
        const int row0 = u.pm * 256 + wr * 64 + fr; const int col0 = u.pn * 128 + wc * 32 + 8 * fq;
#pragma unroll
        for (int ai = 0; ai < 2; ++ai)
#pragma unroll
            for (int m = 0; m < 4; ++m) {
                const float rs = 1.0f / sqrtf(rowss[row0 + ai * 128 + m * 16] * (1.f / DM) + 1e-6f);
                float r[8];
#pragma unroll
                for (int n = 0; n < 2; ++n)
#pragma unroll
                    for (int j = 0; j < 4; ++j) { const float g = acc[ai][0][m][n][j] * rs, up = acc[ai][1][m][n][j] * rs; r[n * 4 + j] = g * sigmoidf_(g) * up; }
                u32x4 w; w.x = cvt_pk_bf16(r[0], r[1]); w.y = cvt_pk_bf16(r[2], r[3]); w.z = cvt_pk_bf16(r[4], r[5]); w.w = cvt_pk_bf16(r[6], r[7]);
                *(u32x4*)(O + (size_t)(row0 + ai * 128 + m * 16) * DFF + col0) = w;
            }
    }
};
struct EpiPle {
    static constexpr bool PERM = true, AFTER_DRAIN = false;
    const bf16_t* h; const bf16_t* pp; const float* rowss; bf16_t* hb3; float* rowss_out;
    __device__ __forceinline__ void operator()(const f32x4 (&acc)[2][2][4][2], const Unit& u, int wr, int wc, int fr, int fq) const {
        const int row0 = u.pm * 256 + wr * 64 + fr; const int col0 = u.pn * 256 + wc * 32 + 8 * fq;
#pragma unroll
        for (int ai = 0; ai < 2; ++ai)
#pragma unroll
            for (int m = 0; m < 4; ++m) { const int row = row0 + ai * 128 + m * 16; const float rs = 1.0f / sqrtf(rowss[row] * (1.f / DM) + 1e-6f); float ss = 0.f;
#pragma unroll
                for (int bj = 0; bj < 2; ++bj) { const size_t off = (size_t)row * DM + col0 + bj * 128;
                    const u32x4 bw = *(const u32x4*)(h + off); const u32x4 pw = *(const u32x4*)(pp + off);
                    const unsigned bwa[4] = {bw.x, bw.y, bw.z, bw.w}, pwa[4] = {pw.x, pw.y, pw.z, pw.w};
                    float o[8];
#pragma unroll
                    for (int e = 0; e < 8; ++e) { const float a_ = acc[ai][bj][m][e >> 2][e & 3] * rs;
                        const float bv = (e & 1) ? __uint_as_float(bwa[e >> 1] & 0xffff0000u) : __uint_as_float(bwa[e >> 1] << 16);
                        const float pv = (e & 1) ? __uint_as_float(pwa[e >> 1] & 0xffff0000u) : __uint_as_float(pwa[e >> 1] << 16);
                        o[e] = bv + pv * sigmoidf_(a_); ss += o[e] * o[e]; }
                    u32x4 w; w.x = cvt_pk_bf16(o[0], o[1]); w.y = cvt_pk_bf16(o[2], o[3]); w.z = cvt_pk_bf16(o[4], o[5]); w.w = cvt_pk_bf16(o[6], o[7]);
                    *(u32x4*)(hb3 + off) = w; }
                ss += __shfl_xor(ss, 16); ss += __shfl_xor(ss, 32);
                if (fq == 0) unsafeAtomicAdd(rowss_out + row, ss); }
    }
};

__device__ __forceinline__ void tr_item(const float* __restrict__ W, int K, int N, int nvalid, bf16_t* __restrict__ WT, int drow0, LAS float*, int k0, int n0, int lane, const float* __restrict__ gain = nullptr) {
    const int ko = lane & 7, nq = lane >> 3; const int n = n0 + 4 * nq; const bool ok = n < nvalid;
    const float* src = W + (size_t)(k0 + 8 * ko) * N + n;
    f32x4 v[8];
#pragma unroll
    for (int i = 0; i < 8; ++i) v[i] = ok ? __builtin_nontemporal_load((const f32x4*)(src + (size_t)i * N)) : (f32x4){0.f, 0.f, 0.f, 0.f};
    if (gain) { const f32x4 g0 = *(const f32x4*)(gain + k0 + 8 * ko), g1 = *(const f32x4*)(gain + k0 + 8 * ko + 4);
#pragma unroll
        for (int i = 0; i < 4; ++i) { v[i] = v[i] * g0[i]; v[4 + i] = v[4 + i] * g1[i]; } }
#pragma unroll
    for (int j = 0; j < 4; ++j) { u32x4 o; o.x = cvt_pk_bf16(v[0][j], v[1][j]); o.y = cvt_pk_bf16(v[2][j], v[3][j]); o.z = cvt_pk_bf16(v[4][j], v[5][j]); o.w = cvt_pk_bf16(v[6][j], v[7][j]);
        __builtin_nontemporal_store(o, (u32x4*)(WT + (size_t)(drow0 + 4 * nq + j) * K + k0 + 8 * ko)); }
}
template <bool OUT_BF16>
__device__ __forceinline__ void rms_row(const float* src, const float* __restrict__ g, void* dst, int lane) {
    const f32x4* xr = (const f32x4*)src + lane; f32x4 v[8]; float s = 0.f;
#pragma unroll
    for (int j = 0; j < 8; ++j) { v[j] = xr[64 * j]; s += (v[j][0] * v[j][0] + v[j][1] * v[j][1]) + (v[j][2] * v[j][2] + v[j][3] * v[j][3]); }
    const float rstd = 1.0f / sqrtf(wave_sum(s) * (1.f / DM) + 1e-6f);
#pragma unroll
    for (int j = 0; j < 8; ++j) { const f32x4 gv = ((const f32x4*)g)[lane + 64 * j]; const f32x4 y = v[j] * rstd * gv;
        if (OUT_BF16) { u32x2 w; w.x = cvt_pk_bf16(y[0], y[1]); w.y = cvt_pk_bf16(y[2], y[3]); ((u32x2*)dst)[lane + 64 * j] = w; }
        else ((f32x4*)dst)[lane + 64 * j] = y; }
}

__device__ __forceinline__ float gelu_tanh(float x) { const float y = 0.7978845608028654f * (x + 0.044715f * x * x * x); const float e = __expf(2.f * y); return 0.5f * x * (2.f - 2.f * __builtin_amdgcn_rcpf(e + 1.f)); }
__device__ __forceinline__ void compress_job(LAS unsigned char* lds, const bf16_t* __restrict__ X, const bf16_t* __restrict__ W1t, const bf16_t* __restrict__ W2t,
                                             const float* __restrict__ bias, bf16_t* outc, int b, int g, int n0) {
    int tid_ = threadIdx.x; asm volatile("" : "+v"(tid_));
    const int tid = tid_, wid = __builtin_amdgcn_readfirstlane(tid >> 6), lane = tid & 63, fr = lane & 15, fq = lane >> 4;
    const int nn = min(n0 + fr, 126);
    const bf16_t* Ab = X + ((size_t)b * SEQ + 16 * nn) * 256 + g * 128 + 16 * fq;
    const bf16_t* Bb = W1t + (size_t)fr * 4096 + 16 * fq;
    f32x4 acc[8];
#pragma unroll
    for (int ct = 0; ct < 8; ++ct) acc[ct] = (f32x4){0.f, 0.f, 0.f, 0.f};
#pragma unroll 1
    for (int i = 0; i < 8; i += 2) {
        bf16x8 av[2][2], bv[2][8][2];
#pragma unroll
        for (int u = 0; u < 2; ++u) { const int pp = 8 * wid + i + u; const bf16_t* ap = Ab + (pp >> 1) * 256 + (pp & 1) * 64;
            av[u][0] = *(const bf16x8*)ap; av[u][1] = *(const bf16x8*)(ap + 8);
#pragma unroll
            for (int ct = 0; ct < 8; ++ct) { const bf16_t* bp = Bb + (size_t)ct * 16 * 4096 + 64 * pp; bv[u][ct][0] = *(const bf16x8*)bp; bv[u][ct][1] = *(const bf16x8*)(bp + 8); } }
        __builtin_amdgcn_sched_barrier(0);
#pragma unroll
        for (int u = 0; u < 2; ++u)
#pragma unroll
            for (int hh = 0; hh < 2; ++hh)
#pragma unroll
                for (int ct = 0; ct < 8; ++ct) acc[ct] = __builtin_amdgcn_mfma_f32_16x16x32_bf16(av[u][hh], bv[u][ct][hh], acc[ct], 0, 0, 0);
    }
    LAS float* part = (LAS float*)lds;
#pragma unroll
    for (int ct = 0; ct < 8; ++ct)
#pragma unroll
        for (int r = 0; r < 4; ++r) part[(wid * 16 + 4 * fq + r) * 132 + 16 * ct + fr] = acc[ct][r];
    __syncthreads();
    LAS bf16_t* hid = (LAS bf16_t*)(lds + 67584);
    { const int row = tid >> 5, c4 = (tid & 31) * 4; f32x4 s = *(const f32x4*)(bias + c4);
#pragma unroll 8
      for (int l = 1; l < 32; ++l) s += *(const f32x4*)(bias + l * 128 + c4);
#pragma unroll
      for (int w = 0; w < 8; ++w) s += *(const LAS f32x4*)(part + (w * 16 + row) * 132 + c4);
      u32x2 hw; hw.x = cvt_pk_bf16(gelu_tanh(s[0]), gelu_tanh(s[1])); hw.y = cvt_pk_bf16(gelu_tanh(s[2]), gelu_tanh(s[3]));
      *(LAS u32x2*)(hid + row * 136 + c4) = hw; }
    __syncthreads();
    f32x4 acc2 = {0.f, 0.f, 0.f, 0.f};
    const __amdgpu_buffer_rsrc_t orsrc = __builtin_amdgcn_make_buffer_rsrc(outc, 0, 8 * 128 * 128 * 2, 0x00020000);
#pragma unroll
    for (int s = 0; s < 4; ++s) { const bf16x8 a = *(const LAS bf16x8*)(hid + fr * 136 + 32 * s + 8 * fq);
        const bf16x8 bb = *(const bf16x8*)(W2t + (size_t)(16 * wid + fr) * 128 + 32 * s + 8 * fq); acc2 = __builtin_amdgcn_mfma_f32_16x16x32_bf16(a, bb, acc2, 0, 0, 0); }
#pragma unroll
    for (int r = 0; r < 4; ++r) { const int n = n0 + 4 * fq + r; const float v = (n == 127) ? 0.f : acc2[r];
        __builtin_amdgcn_raw_buffer_store_b16((short)(cvt_pk_bf16(v, v) & 0xffffu), orsrc, (unsigned)((((b * 2 + g) * 128 + n) * 128 + 16 * wid + fr) * 2), 0, 16); }
    __syncthreads();
}


template <bool FENCE>
__device__ __forceinline__ void signal_done(unsigned* cnt, unsigned n) {
    asm volatile("s_waitcnt vmcnt(0)" ::: "memory"); __syncthreads();
    if (threadIdx.x == 0 && n) { if (FENCE) { __builtin_amdgcn_fence(__ATOMIC_RELEASE, "agent"); asm volatile("s_waitcnt vmcnt(0)" ::: "memory"); }
        (void)__hip_atomic_fetch_add(cnt, n, __ATOMIC_RELAXED, __HIP_MEMORY_SCOPE_AGENT); }
}
__device__ __forceinline__ void wait_count(unsigned* cnt, unsigned want) {
    if (threadIdx.x == 0) { unsigned spins = 0;
        while (__hip_atomic_load(cnt, __ATOMIC_RELAXED, __HIP_MEMORY_SCOPE_AGENT) < want && ++spins < (1u << 22)) __builtin_amdgcn_s_sleep(2);
        __builtin_amdgcn_fence(__ATOMIC_ACQUIRE, "agent"); asm volatile("s_waitcnt vmcnt(0)" ::: "memory"); }
    __syncthreads();
}
namespace att {
constexpr float SCALE = 0.08838834764831845f, CL2 = SCALE * 1.4426950408889634f, NEGB = -1e30f;
#define KSWZ(row, colB) ((row) * 256 + ((colB) ^ (((row) & 7) << 4)))
#define SBAR() __builtin_amdgcn_sched_barrier(0)
__device__ __forceinline__ int crow(int r, int hi) { return (r & 3) + 8 * (r >> 2) + 4 * hi; }
__device__ __forceinline__ int v_st(int k, int c) { const int kk = (k & ~0xC) | ((k & 4) << 1) | ((k & 8) >> 1); return ((kk >> 3) * 4 + (c >> 5)) * 512 + ((kk & 7) * 32 + (c & 31)) * 2; }
__device__ __forceinline__ int v_rd_base(int lane) { return ((lane & 3) << 3) | (((lane >> 2) & 3) << 6) | (((lane >> 4) & 1) << 5) | (((lane >> 5) & 1) << 8); }
constexpr int v_rd_off(int d0, int ks, int half) { return d0 * 512 + ks * 4096 + half * 2048; }
template <int OFF> __device__ __forceinline__ s16x4 tr_read(int vb) { s16x4 r; asm volatile("ds_read_b64_tr_b16 %0, %1 offset:%2" : "=&v"(r) : "v"(vb), "i"(OFF) : "memory"); return r; }
template <int D0> __device__ __forceinline__ void pv_one(f32x16& od, int vb, bf16x8 pa0, bf16x8 pa1, bf16x8 pa2, bf16x8 pa3) {
    const s16x4 l0 = tr_read<v_rd_off(D0, 0, 0)>(vb), h0 = tr_read<v_rd_off(D0, 0, 1)>(vb), l1 = tr_read<v_rd_off(D0, 1, 0)>(vb), h1 = tr_read<v_rd_off(D0, 1, 1)>(vb);
    const s16x4 l2 = tr_read<v_rd_off(D0, 2, 0)>(vb), h2 = tr_read<v_rd_off(D0, 2, 1)>(vb), l3 = tr_read<v_rd_off(D0, 3, 0)>(vb), h3 = tr_read<v_rd_off(D0, 3, 1)>(vb);
    asm volatile("s_waitcnt lgkmcnt(0)" ::: "memory"); SBAR();
#define PK(L, H) (bf16x8){L[0], L[1], L[2], L[3], H[0], H[1], H[2], H[3]}
    __builtin_amdgcn_s_setprio(1);
    od = __builtin_amdgcn_mfma_f32_32x32x16_bf16(pa0, PK(l0, h0), od, 0, 0, 0);
    od = __builtin_amdgcn_mfma_f32_32x32x16_bf16(pa1, PK(l1, h1), od, 0, 0, 0);
    od = __builtin_amdgcn_mfma_f32_32x32x16_bf16(pa2, PK(l2, h2), od, 0, 0, 0);
    od = __builtin_amdgcn_mfma_f32_32x32x16_bf16(pa3, PK(l3, h3), od, 0, 0, 0);
    __builtin_amdgcn_s_setprio(0);
#undef PK
}
__device__ __forceinline__ void pv_d0(f32x16* o, int vb, bf16x8 pa0, bf16x8 pa1, bf16x8 pa2, bf16x8 pa3) {
    pv_one<0>(o[0], vb, pa0, pa1, pa2, pa3); pv_one<1>(o[1], vb, pa0, pa1, pa2, pa3); pv_one<2>(o[2], vb, pa0, pa1, pa2, pa3); pv_one<3>(o[3], vb, pa0, pa1, pa2, pa3);
}
__device__ __forceinline__ void qkt(f32x16& p0, f32x16& p1, const LAS char* Ks, const bf16x8* qr, int r32, int hi) {
    p0 = f32x16{}; p1 = f32x16{};
    __builtin_amdgcn_s_setprio(1);
#pragma unroll
    for (int d0 = 0; d0 < 8; ++d0) { const int cb = (d0 * 16 + hi * 8) * 2;
        const bf16x8 b0 = *(const LAS bf16x8*)(Ks + KSWZ(r32, cb));
        const bf16x8 b1 = *(const LAS bf16x8*)(Ks + KSWZ(32 + r32, cb));
        p0 = __builtin_amdgcn_mfma_f32_32x32x16_bf16(b0, qr[d0], p0, 0, 0, 0);
        p1 = __builtin_amdgcn_mfma_f32_32x32x16_bf16(b1, qr[d0], p1, 0, 0, 0);
#ifdef QKT_SBAR
        if ((d0 & (QKT_SBAR - 1)) == QKT_SBAR - 1) SBAR();
#endif
    }
    __builtin_amdgcn_s_setprio(0);
}
__device__ __forceinline__ void sm_step(f32x16& p0, f32x16& p1, bool lane_on, float& m_reg, float& l_reg, f32x16* o, LAS float* al_l, int r32, int hi,
                                        bf16x8& pa0, bf16x8& pa1, bf16x8& pa2, bf16x8& pa3, float& alpha_out) {
    float pmax = p0[0];
#pragma unroll
    for (int r = 1; r < 16; ++r) pmax = fmaxf(pmax, p0[r]);
#pragma unroll
    for (int r = 0; r < 16; ++r) pmax = fmaxf(pmax, p1[r]);
    pmax = lane_on ? pmax : NEGB;
    { auto rr = __builtin_amdgcn_permlane32_swap(__float_as_uint(pmax), __float_as_uint(pmax), false, false);
      pmax = fmaxf(__uint_as_float(rr[0]), __uint_as_float(rr[1])); }
    const float mn = fmaxf(m_reg, pmax);
    const float alpha = __builtin_amdgcn_exp2f((m_reg - mn) * CL2);
    m_reg = mn; alpha_out = alpha;
    const float mnC = (!lane_on || mn < -1e29f) ? -INFINITY : -mn * CL2;
#pragma unroll
    for (int r = 0; r < 16; ++r) p0[r] = __builtin_amdgcn_exp2f(fmaf(p0[r], CL2, mnC));
#pragma unroll
    for (int r = 0; r < 16; ++r) p1[r] = __builtin_amdgcn_exp2f(fmaf(p1[r], CL2, mnC));
    float ps = 0.f;
#pragma unroll
    for (int r = 0; r < 16; ++r) ps += p0[r];
#pragma unroll
    for (int r = 0; r < 16; ++r) ps += p1[r];
    { auto rr = __builtin_amdgcn_permlane32_swap(__float_as_uint(ps), __float_as_uint(ps), false, false);
      ps = __uint_as_float(rr[0]) + __uint_as_float(rr[1]); }
    l_reg = l_reg * alpha + ps;
    if (__any(alpha < 1.f)) { if (hi == 0) al_l[r32] = alpha; LDS_WAIT();
#pragma unroll
        for (int d = 0; d < 4; ++d)
#pragma unroll
            for (int r = 0; r < 16; ++r) o[d][r] *= al_l[crow(r, hi)];
    }
#define PK4(P, BASE, OUT) do { unsigned a0_ = cvt_pk_bf16(P[BASE + 0], P[BASE + 1]), a1_ = cvt_pk_bf16(P[BASE + 2], P[BASE + 3]);   \
    unsigned b0_ = cvt_pk_bf16(P[BASE + 4], P[BASE + 5]), b1_ = cvt_pk_bf16(P[BASE + 6], P[BASE + 7]);                              \
    auto r0_ = __builtin_amdgcn_permlane32_swap(a0_, b0_, false, false); auto r1_ = __builtin_amdgcn_permlane32_swap(a1_, b1_, false, false); \
    u32x4 w_ = {r0_[0], r1_[0], r0_[1], r1_[1]}; OUT = __builtin_bit_cast(bf16x8, w_); } while (0)
    PK4(p0, 0, pa0); PK4(p0, 8, pa1); PK4(p1, 0, pa2); PK4(p1, 8, pa3);
#undef PK4
}
struct Stg { bf16x8 k0, k1, v0, v1; };
__device__ __forceinline__ void tile_load(Stg& s, const bf16_t* Kb, const bf16_t* Vb, int pitch, int key0, int sr, int sc) {
    s.k0 = *(const bf16x8*)(Kb + (size_t)(key0 + sr) * pitch + sc); s.k1 = *(const bf16x8*)(Kb + (size_t)(key0 + 32 + sr) * pitch + sc);
    s.v0 = *(const bf16x8*)(Vb + (size_t)(key0 + sr) * pitch + sc); s.v1 = *(const bf16x8*)(Vb + (size_t)(key0 + 32 + sr) * pitch + sc);
}
__device__ __forceinline__ void tile_write(LAS char* Kl, LAS char* Vl, const Stg& s, int sr, int sc) {
    *(LAS bf16x8*)(Vl + v_st(sr, sc)) = s.v0; *(LAS bf16x8*)(Vl + v_st(32 + sr, sc)) = s.v1;
    *(LAS bf16x8*)(Kl + KSWZ(sr, sc * 2)) = s.k0; *(LAS bf16x8*)(Kl + KSWZ(32 + sr, sc * 2)) = s.k1;
}
__device__ __forceinline__ void tile_dma(LAS char* Kl, LAS char* Vl, const bf16_t* Kb, const bf16_t* Vb, int pitch, int key0, int wid, int lane) {
#pragma unroll
    for (int h = 0; h < 2; ++h) {
        const int ch = wid * 2 + h; const int L = ch * 1024 + lane * 16;
        { const int row = L >> 8, c16 = ((L >> 4) & 15) ^ (row & 7);
          __builtin_amdgcn_global_load_lds((const unsigned*)(Kb + (size_t)(key0 + row) * pitch + c16 * 8), (LAS unsigned*)(Kl + ch * 1024), 16, 0, 0); }
        { const int sub = L >> 9, kk = (sub >> 2) * 8 + ((L >> 6) & 7), c8 = (sub & 3) * 4 + ((L >> 4) & 3);
          const int k = (kk & ~0xC) | ((kk & 4) << 1) | ((kk & 8) >> 1);
          __builtin_amdgcn_global_load_lds((const unsigned*)(Vb + (size_t)(key0 + k) * pitch + c8 * 8), (LAS unsigned*)(Vl + ch * 1024), 16, 0, 0); }
    }
}
template <int MODE>
__device__ __forceinline__ void finalize(const f32x16* o, float l_reg, float gate, LAS float* li_l, int r32, int hi, float* scrA, float* scrB, bf16_t* catp) {
    if (hi == 0) li_l[r32] = l_reg > 0.f ? gate / l_reg : 0.f;
    LDS_WAIT();
#pragma unroll
    for (int r = 0; r < 16; ++r) {
        const int rc = (r & 3) + 8 * (r >> 2);
        unsigned lo = (unsigned)(4 * hi) * 1024u + (unsigned)r32, lc = (unsigned)(4 * hi) * 2048u + (unsigned)r32;
        asm volatile("" : "+v"(lo), "+v"(lc));
        const float f = li_l[rc + 4 * hi];
        if (MODE == 2) {
            float va[4], vb[4];
#pragma unroll
            for (int d0 = 0; d0 < 4; ++d0) { va[d0] = scrA[lo + rc * 1024 + 32 * d0]; vb[d0] = scrB[lo + rc * 1024 + 32 * d0]; }
#pragma unroll
            for (int d0 = 0; d0 < 4; ++d0) { const float v = o[d0][r] * f + (va[d0] + vb[d0]); catp[lc + rc * 2048 + 32 * d0] = (bf16_t)(cvt_pk_bf16(v, v) & 0xffffu); }
            if (r & 1) asm volatile("" ::: "memory");
        } else {
#pragma unroll
            for (int d0 = 0; d0 < 4; ++d0) { const float v = o[d0][r] * f; if (MODE == 0) scrA[lo + rc * 1024 + 32 * d0] = v; else scrB[lo + rc * 1024 + 32 * d0] = v; }
        }
    }
    LDS_WAIT();
}
template <bool WIN>
__device__ __forceinline__ void run_branch(LAS char* K_l, LAS char* V_l, const bf16_t* Kb, const bf16_t* Vb, unsigned tiles, unsigned lanemask, int c, int tl,
                                           const bf16x8* qr, float& m_reg, float& l_reg, f32x16* o, LAS float* al_l, int r32, int hi, int wid, int lane, int vb0) {
    unsigned rem = tiles; int j = __builtin_ctz(rem); rem &= rem - 1;
    __syncthreads();
    tile_dma(K_l, V_l, Kb, Vb, 256, 64 * j, wid, lane);
    asm volatile("s_waitcnt vmcnt(0)" ::: "memory"); __syncthreads();
    int cur = 0;
    for (;;) {
        const int jn = rem ? __builtin_ctz(rem) : -1;
        if (jn >= 0) { rem &= rem - 1; tile_dma(K_l + (cur ^ 1) * 32768, V_l + (cur ^ 1) * 32768, Kb, Vb, 256, 64 * jn, wid, lane); }
        const bool lane_on = (lanemask >> j) & 1u;
#ifdef ATT_NOANY
        {
#else
        if (__any(lane_on)) {
#endif
            f32x16 p0, p1; qkt(p0, p1, K_l + cur * 32768, qr, r32, hi);
            if (j == c) {
                int tlv = tl - 4 * hi; asm volatile("" : "+v"(tlv));
#pragma unroll
                for (int r = 0; r < 16; ++r) { const int kk = (r & 3) + 8 * (r >> 2); p0[r] = (kk > tlv) ? NEGB : p0[r]; p1[r] = (kk + 32 > tlv) ? NEGB : p1[r]; }
            }
            if (WIN && j == c - 8) {
                int tlv = tl - 4 * hi; asm volatile("" : "+v"(tlv));
#pragma unroll
                for (int r = 0; r < 16; ++r) { const int kk = (r & 3) + 8 * (r >> 2); p0[r] = (kk <= tlv) ? NEGB : p0[r]; p1[r] = (kk + 32 <= tlv) ? NEGB : p1[r]; }
            }
            bf16x8 pa0, pa1, pa2, pa3; float al;
            sm_step(p0, p1, lane_on, m_reg, l_reg, o, al_l, r32, hi, pa0, pa1, pa2, pa3, al);
            pv_d0(o, vb0 + cur * 32768, pa0, pa1, pa2, pa3);
        }
        if (jn < 0) break;
        asm volatile("s_waitcnt vmcnt(0)" ::: "memory"); __syncthreads();
        j = jn; cur ^= 1;
    }
}
constexpr int L_V = 0, L_K = 16384, L_IMP = 65536, L_SIMP = 99328, L_MASK = 107776, L_WS = 108288;
__device__ __forceinline__ void attn_unit(LAS unsigned char* ldsb, const bf16_t* __restrict__ T, const bf16_t* kcmp, const bf16_t* vcmp,
                                          const float* __restrict__ gates, float* scr, float* scr2, bf16_t* cat, int b, int g, int c, unsigned* cmp_cnt) {
    LAS char* lds = (LAS char*)ldsb;
    int tid_ = threadIdx.x; asm volatile("" : "+v"(tid_));
    const int tid = tid_, wid = __builtin_amdgcn_readfirstlane(tid >> 6), lane = tid & 63, r32 = lane & 31, hi = lane >> 5;
    const int hh = wid & 3, ch = wid >> 2, h = g * 4 + hh;
    const int tl = 32 * ch + r32, t = 64 * c + tl;
    const size_t row = (size_t)b * SEQ + t;
    LAS char* V_l = lds + L_V; LAS char* K_l = lds + L_K;
    LAS float* impw = (LAS float*)(lds + L_IMP) + wid * 1056;
    LAS float* simp = (LAS float*)(lds + L_SIMP);
    LAS unsigned* maskw = (LAS unsigned*)(lds + L_MASK);
    LAS float* li_l = (LAS float*)(lds + L_WS) + wid * 64; LAS float* al_l = li_l + 32;
    bf16x8 qr[8];
    { const bf16_t* Qw = T + (size_t)(4 + (h >> 1)) * TS + row * 256 + (h & 1) * 128 + hi * 8;
#pragma unroll
      for (int d0 = 0; d0 < 8; ++d0) qr[d0] = *(const bf16x8*)(Qw + d0 * 16); }
    const int vb0 = (int)(uintptr_t)V_l + v_rd_base(lane);
    const float g0 = gates[row * 24 + h * 3 + 0], g1 = gates[row * 24 + h * 3 + 1], g2 = gates[row * 24 + h * 3 + 2];
    float* scrp = scr + ((size_t)b * SEQ + 64 * c + 32 * ch) * 1024 + h * 128;
    float* scrq = scr2 + ((size_t)b * SEQ + 64 * c + 32 * ch) * 1024 + h * 128;
    bf16_t* catp = cat + ((size_t)b * SEQ + 64 * c + 32 * ch) * DM + 1024 + h * 128;
    if (tid == 0) maskw[64] = 0u;
    float m_reg = NEGB, l_reg = 0.f; f32x16 o[4];
#pragma unroll
    for (int d = 0; d < 4; ++d) o[d] = f32x16{};
    { const bf16_t* Kb = T + (size_t)12 * TS + (size_t)b * SEQ * 256 + g * 128; const bf16_t* Vb = T + (size_t)13 * TS + (size_t)b * SEQ * 256 + g * 128;
      const int lo = c >= 8 ? c - 8 : 0; const unsigned wt = (c == 31 ? 0xffffffffu : ((1u << (c + 1)) - 1u)) & ~((1u << lo) - 1u);
#ifndef ATT_SKIP_B2
      run_branch<true>(K_l, V_l, Kb, Vb, wt, 0xffffffffu, c, tl, qr, m_reg, l_reg, o, al_l, r32, hi, wid, lane, vb0);
#endif
      finalize<0>(o, l_reg, g2, li_l, r32, hi, scrp, scrq, catp);
    }
    wait_count(cmp_cnt, 128u);
    m_reg = NEGB; l_reg = 0.f;
#pragma unroll
    for (int d = 0; d < 4; ++d) o[d] = f32x16{};
    {
        const bf16_t* Kb = kcmp + (size_t)(b * 2 + g) * 128 * 128; const bf16_t* Vb = vcmp + (size_t)(b * 2 + g) * 128 * 128;
        const int nmax = (t >= 31) ? ((t - 31) >> 4) : -1;
        bf16x8 pa0, pa1, pa2, pa3; float alA, alB;
        float inn[4][4], lst[4][4];
        __syncthreads();
        tile_dma(K_l, V_l, Kb, Vb, 128, 0, wid, lane); tile_dma(K_l + 32768, V_l + 32768, Kb, Vb, 128, 64, wid, lane);
        asm volatile("s_waitcnt vmcnt(0)" ::: "memory"); __syncthreads();
        {
            f32x16 a0, a1;
            qkt(a0, a1, K_l, qr, r32, hi);
#pragma unroll
            for (int r = 0; r < 16; ++r) { const int n = crow(r, hi); a0[r] = (n <= nmax) ? a0[r] : NEGB; a1[r] = (n + 32 <= nmax) ? a1[r] : NEGB; }
            sm_step(a0, a1, true, m_reg, l_reg, o, al_l, r32, hi, pa0, pa1, pa2, pa3, alA);
#pragma unroll
            for (int c4 = 0; c4 < 4; ++c4) { inn[0][c4] = (a0[4 * c4] + a0[4 * c4 + 1]) + (a0[4 * c4 + 2] + a0[4 * c4 + 3]); lst[0][c4] = a0[4 * c4 + 3];
                                             inn[1][c4] = (a1[4 * c4] + a1[4 * c4 + 1]) + (a1[4 * c4 + 2] + a1[4 * c4 + 3]); lst[1][c4] = a1[4 * c4 + 3]; }
        }
        pv_d0(o, vb0, pa0, pa1, pa2, pa3);
        {
            f32x16 b0, b1;
            qkt(b0, b1, K_l + 32768, qr, r32, hi);
#pragma unroll
            for (int r = 0; r < 16; ++r) { const int n = 64 + crow(r, hi); b0[r] = (n <= nmax) ? b0[r] : NEGB; b1[r] = (n + 32 <= nmax) ? b1[r] : NEGB; }
            sm_step(b0, b1, true, m_reg, l_reg, o, al_l, r32, hi, pa0, pa1, pa2, pa3, alB);
#pragma unroll
            for (int c4 = 0; c4 < 4; ++c4) { inn[2][c4] = (b0[4 * c4] + b0[4 * c4 + 1]) + (b0[4 * c4 + 2] + b0[4 * c4 + 3]); lst[2][c4] = b0[4 * c4 + 3];
                                             inn[3][c4] = (b1[4 * c4] + b1[4 * c4 + 1]) + (b1[4 * c4 + 2] + b1[4 * c4 + 3]); lst[3][c4] = b1[4 * c4 + 3]; }
        }
        pv_d0(o, vb0 + 32768, pa0, pa1, pa2, pa3);
        const float inv = l_reg > 0.f ? 1.f / l_reg : 0.f; const float fa = alB * inv, fb = inv;
        float x[4][4];
#pragma unroll
        for (int TT = 0; TT < 4; ++TT)
#pragma unroll
            for (int c4 = 0; c4 < 4; ++c4) { const float f = TT < 2 ? fa : fb; inn[TT][c4] *= f; lst[TT][c4] *= f; x[TT][c4] = __shfl_xor(lst[TT][c4], 32); }
#pragma unroll
        for (int TT = 0; TT < 4; ++TT)
#pragma unroll
            for (int c4 = 0; c4 < 4; ++c4) {
                const float plo = c4 >= 1 ? x[TT][c4 >= 1 ? c4 - 1 : 0] : (TT >= 1 ? x[TT >= 1 ? TT - 1 : 0][3] : 0.f);
                const float prev = hi ? x[TT][c4] : plo;
                impw[r32 * 33 + 8 * TT + 2 * c4 + hi] = inn[TT][c4] + prev;
            }
#ifndef ATT_SKIP_FIN
        finalize<1>(o, l_reg, g0, li_l, r32, hi, scrp, scrq, catp);
#endif
    }
    __syncthreads();
    {
        const int pidx = tid >> 3, sub = tid & 7;
        const LAS float* ib = (const LAS float*)(lds + L_IMP) + ((pidx >> 5) * 4) * 1056 + (pidx & 31) * 33;
#pragma unroll
        for (int jj = 0; jj < 4; ++jj) { const int j = 4 * sub + jj; float sv = (ib[j] + ib[1056 + j]) + (ib[2112 + j] + ib[3168 + j]);
            if (j > c) sv = -1.f; else if (j == 0 || j == c || j == c - 1) sv = 3.0e38f;
            simp[pidx * 33 + j] = sv; }
        __syncthreads();
        float vj[4]; int rk[4];
#pragma unroll
        for (int jj = 0; jj < 4; ++jj) { vj[jj] = simp[pidx * 33 + 4 * sub + jj]; rk[jj] = 0; }
#pragma unroll 1
        for (int i = 0; i < 32; ++i) { const float vi = simp[pidx * 33 + i];
#pragma unroll
            for (int jj = 0; jj < 4; ++jj) rk[jj] += (vi > vj[jj] || (vi == vj[jj] && i < 4 * sub + jj)) ? 1 : 0; }
        unsigned bits = 0u;
#pragma unroll
        for (int jj = 0; jj < 4; ++jj) { const int j = 4 * sub + jj; if (rk[jj] < 16 && j <= c) bits |= 1u << j; }
        bits |= __shfl_xor(bits, 1); bits |= __shfl_xor(bits, 2); bits |= __shfl_xor(bits, 4);
        if (sub == 0) maskw[pidx] = bits;
        bits |= __shfl_xor(bits, 8); bits |= __shfl_xor(bits, 16); bits |= __shfl_xor(bits, 32);
        if (lane == 0) atomicOr((unsigned*)(maskw + 64), bits);
    }
    __syncthreads();
    const unsigned umask = __builtin_amdgcn_readfirstlane(maskw[64]);
    const unsigned mymask = maskw[tl];
    m_reg = NEGB; l_reg = 0.f;
#pragma unroll
    for (int d = 0; d < 4; ++d) o[d] = f32x16{};
    { const bf16_t* Kb = T + (size_t)10 * TS + (size_t)b * SEQ * 256 + g * 128; const bf16_t* Vb = T + (size_t)11 * TS + (size_t)b * SEQ * 256 + g * 128;
#ifndef ATT_SKIP_B1
      run_branch<false>(K_l, V_l, Kb, Vb, umask, mymask, c, tl, qr, m_reg, l_reg, o, al_l, r32, hi, wid, lane, vb0);
#endif
#ifndef ATT_SKIP_FIN
      finalize<2>(o, l_reg, g1, li_l, r32, hi, scrp, scrq, catp);
#endif
    }
    __syncthreads();
}
}

template <int W>
__device__ __forceinline__ void pool_rows16(const float* __restrict__ Z, const float* __restrict__ scale, bf16_t* cat, int base, int q) {
    const int seq0 = base & ~(SEQ - 1);
    f32x4 v[15 + W];
#pragma unroll
    for (int i = 0; i < 15 + W; ++i) { const int r = base - (W - 1) + i; v[i] = (r >= seq0) ? *((const f32x4*)Z + (size_t)r * 256 + q) : (f32x4){0.f, 0.f, 0.f, 0.f}; }
    const f32x4 sv = ((const f32x4*)scale)[q];
#pragma unroll
    for (int j = 0; j < 16; ++j) { f32x4 s = v[j + W - 1];
#pragma unroll
        for (int k = 1; k < W; ++k) s += v[j + W - 1 - k];
        const int t = (base + j) & (SEQ - 1); const int n = min(W, t + 1); const float rc = 1.0f / (float)n;
        const f32x4 y = (s * rc - v[j + W - 1]) * sv;
        u32x2 wv; wv.x = cvt_pk_bf16(y[0], y[1]); wv.y = cvt_pk_bf16(y[2], y[3]);
        *(u32x2*)(cat + (size_t)(base + j) * DM + 4 * q) = wv; }
}
__device__ __forceinline__ void pool_finalize(const float* __restrict__ Z, const float* __restrict__ scale, bf16_t* cat, int row_begin, int nrows) {
    const int q = threadIdx.x & 255, grp = __builtin_amdgcn_readfirstlane((int)(threadIdx.x & 255) >> 6);
    for (int base = row_begin + 16 * (int)(threadIdx.x >> 8); base < row_begin + nrows; base += 32) {
        if (grp == 0) pool_rows16<2>(Z, scale, cat, base, q); else if (grp == 1) pool_rows16<4>(Z, scale, cat, base, q);
        else if (grp == 2) pool_rows16<8>(Z, scale, cat, base, q); else pool_rows16<16>(Z, scale, cat, base, q);
    }
}

#define XB_TMO      128
#define XB_XCNT(j)  (256  + 64 * (j))
#define XB_XSUB(j)  (1280 + 64 * (j))
#define XB_XGEN(j)  (2304 + 64 * (j))
#define XB_TOP      3328
#define XB_TOPGEN   3392
#define XCD_BAR_WORDS 3456
#define XB_SPIN_CAP (1u << 18)

__device__ __forceinline__ unsigned xb_ld(unsigned* p)              { return __hip_atomic_load(p, __ATOMIC_RELAXED, __HIP_MEMORY_SCOPE_AGENT); }
__device__ __forceinline__ unsigned xb_add(unsigned* p, unsigned v) { return __hip_atomic_fetch_add(p, v, __ATOMIC_RELAXED, __HIP_MEMORY_SCOPE_AGENT); }
__device__ __forceinline__ unsigned xb_xcc_id() { return (unsigned)__builtin_amdgcn_s_getreg((3 << 11) | 20) & 0xFu; }
#define XB_SPIN(cond, bar) do { unsigned _sp = 0; while (cond) { __builtin_amdgcn_s_sleep(1); \
    if ((++_sp & 255u) == 0u) { if (xb_ld(&(bar)[XB_TMO])) break; if (_sp > XB_SPIN_CAP) { atomicAdd(&(bar)[XB_TMO], 1u); break; } } } } while (0)

struct XcdBarrier {
    unsigned* bar; unsigned x;
    volatile LAS unsigned* st;
};

__device__ __forceinline__ XcdBarrier xcd_barrier_post(unsigned* bar, volatile LAS unsigned* st) {
    XcdBarrier b; b.bar = bar; b.x = xb_xcc_id(); b.st = st;
    if (threadIdx.x == 0) (void)xb_add(&bar[XB_XCNT(b.x)], 1u);
    return b;
}
__device__ __forceinline__ void xcd_barrier_complete(unsigned* bar, unsigned x, unsigned& nloc, unsigned& nx) {
    const unsigned G = gridDim.x * gridDim.y * gridDim.z;
    unsigned sum, cnt, mine, sp = 0u;
    for (;;) {
        sum = 0u; cnt = 0u; mine = 0u;
#pragma unroll
        for (unsigned j = 0; j < 16; ++j) { const unsigned c = xb_ld(&bar[XB_XCNT(j)]); sum += c; cnt += (c > 0u) ? 1u : 0u; mine = (j == x) ? c : mine; }
        if (sum == G) break;
        __builtin_amdgcn_s_sleep(1);
        if ((++sp & 255u) == 0u) { if (xb_ld(&bar[XB_TMO])) break; if (sp > XB_SPIN_CAP) { atomicAdd(&bar[XB_TMO], 1u); break; } }
    }
    nloc = mine > 0u ? mine : 1u; nx = cnt > 0u ? cnt : 1u;
}

__device__ __forceinline__ void xcd_barrier(const XcdBarrier& b) {
    asm volatile("s_waitcnt vmcnt(0)" ::: "memory");
    __syncthreads();
    if (threadIdx.x == 0) {
        unsigned* bar = b.bar;
        __builtin_amdgcn_s_waitcnt(0);
        unsigned nloc = b.st[0], nx = b.st[1];
        if (nloc == 0u) { xcd_barrier_complete(bar, b.x, nloc, nx); b.st[0] = nloc; b.st[1] = nx; }
        const unsigned old = xb_add(&bar[XB_XSUB(b.x)], 1u);
        const unsigned gen = old / nloc;
        if (old + 1u == (gen + 1u) * nloc) {
            __builtin_amdgcn_fence(__ATOMIC_RELEASE, "agent");
            asm volatile("s_waitcnt vmcnt(0)" ::: "memory");
            const unsigned og = xb_add(&bar[XB_TOP], 1u);
            const unsigned tg = og / nx;
            if (og + 1u == (tg + 1u) * nx) xb_add(&bar[XB_TOPGEN], 1u);
            else XB_SPIN(xb_ld(&bar[XB_TOPGEN]) == tg, bar);
            __builtin_amdgcn_fence(__ATOMIC_ACQUIRE, "agent");
            xb_add(&bar[XB_XGEN(b.x)], 1u);
            asm volatile("s_waitcnt vmcnt(0)" ::: "memory");
        } else {
            XB_SPIN(xb_ld(&bar[XB_XGEN(b.x)]) == gen, bar);
            __builtin_amdgcn_fence(__ATOMIC_ACQUIRE, "agent");
            asm volatile("s_waitcnt vmcnt(0)" ::: "memory");
        }
    }
    __syncthreads();
}

#ifndef REPF
#define REPF 1
#endif
struct Args { const float* in[21]; float* out; unsigned char* ws; int ph_lo, ph_hi; };
#ifndef MK_PER_PHASE
#define MK_PER_PHASE 0
#endif
__global__ void __launch_bounds__(NTHREADS, 2) hymba_fwd(Args a) {
    extern __shared__ __attribute__((aligned(16))) unsigned char lds_raw[];
    LAS unsigned char* lds = (LAS unsigned char*)lds_raw;
    unsigned* xbar_words = (unsigned*)(a.ws + 262144);
    volatile LAS unsigned* xb_st = (volatile LAS unsigned*)(lds + 131072 + 64);
    if (threadIdx.x < 2) xb_st[threadIdx.x] = 0u;
    __syncthreads();
    XcdBarrier xb = xcd_barrier_post(xbar_words, xb_st);
    unsigned* ctl = (unsigned*)(a.ws + 262144 + 16384);
#define PHASE_IDS() int tid_ = threadIdx.x; asm volatile("" : "+v"(tid_)); const int tid = tid_, lane = tid & 63, wave = __builtin_amdgcn_readfirstlane(tid >> 6); \
    const int gw = bid * 8 + wave, NGW = G * 8, gtid = bid * NTHREADS + tid, GT = G * NTHREADS; (void)lane; (void)gw; (void)NGW; (void)gtid; (void)GT;
    const int G = gridDim.x, bid = blockIdx.x;
    unsigned char* ws = a.ws;
    const float* x = a.in[0]; float* hbuf = a.out;
    bf16_t* Win_t = (bf16_t*)(ws + WS_WIN); bf16_t* Wout_t = (bf16_t*)(ws + WS_WOUT); bf16_t* Wpg_t = (bf16_t*)(ws + WS_WPG); bf16_t* Wd_t = (bf16_t*)(ws + WS_WD);
    bf16_t* Wgu_t = (bf16_t*)(ws + WS_WGU); bf16_t* Wpp_t = (bf16_t*)(ws + WS_WPP); bf16_t* poolw_t = (bf16_t*)(ws + WS_POOLW);
    bf16_t* W1k = (bf16_t*)(ws + WS_W1K); bf16_t* W1v = (bf16_t*)(ws + WS_W1V); bf16_t* W2k = (bf16_t*)(ws + WS_W2K); bf16_t* W2v = (bf16_t*)(ws + WS_W2V);
    bf16_t* PBF = (bf16_t*)(ws + WS_PBF); bf16_t* XN = (bf16_t*)(ws + WS_XN); bf16_t* T = (bf16_t*)(ws + WS_T); float* Z = (float*)(ws + WS_Z);
    float* SCR = (float*)(ws + WS_SCR); bf16_t* ACT = (bf16_t*)(ws + WS_ACT); bf16_t* PP = (bf16_t*)a.out;
    float* rowss1 = (float*)(ws + 65536); float* rowss2 = (float*)(ws + 131072); float* rowss3 = (float*)(ws + 196608); bf16_t* HB1 = (bf16_t*)(ws + WS_SCR);
    float* cosT = (float*)(ws + WS_COS); float* sinT = (float*)(ws + WS_SIN); float* gatesb = (float*)(ws + WS_GATES);
    bf16_t* kcmp = (bf16_t*)(ws + WS_KCMP); bf16_t* vcmp = (bf16_t*)(ws + WS_VCMP); float* biasp = (float*)(ws + WS_BIASK);

#ifndef SKIP_P0
#ifndef REP0
#define REP0 1
#endif
    if (a.ph_lo <= 0 && 0 < a.ph_hi) for (int rep0 = 0; rep0 < REP0; ++rep0) {
        if (rep0) xcd_barrier(xb);
    {
        PHASE_IDS();
        LAS float* scr = (LAS float*)(lds + wave * 16384);
        constexpr int I_IN = 32 * 120, I_SQ = 32 * 64, I_GU = 32 * 176, I_DN = 88 * 64, I_PP = 4 * 64, I_PW = 4 * 8, I_W1 = 64 * 4, I_W2 = 2 * 4;
        constexpr int NITEMS = I_IN + 2 * I_SQ + 2 * I_GU + I_DN + I_PP + 4 * I_PW + 2 * I_W1 + 2 * I_W2;
        for (int it = gw; it < NITEMS; it += NGW) {
            int r = it; const float* Wsrc; const float* gain = nullptr; bf16_t* dst; int Kk, Nn, nv, nblk, mode = 0;
            if (r < I_GU) { Wsrc = a.in[14]; Kk = DM; Nn = DFF; nv = DFF; nblk = 176; dst = Wgu_t; mode = 1; gain = a.in[13]; }
            else if ((r -= I_GU) < I_GU) { Wsrc = a.in[15]; Kk = DM; Nn = DFF; nv = DFF; nblk = 176; dst = Wgu_t; mode = 2; gain = a.in[13]; }
            else if ((r -= I_GU) < I_DN) { Wsrc = a.in[16]; Kk = DFF; Nn = DM; nv = DM; nblk = 64; dst = Wd_t; }
            else if ((r -= I_DN) < I_IN) { Wsrc = a.in[3]; Kk = DM; Nn = INW; nv = INW; nblk = 120; dst = Win_t; }
            else if ((r -= I_IN) < I_SQ) { Wsrc = a.in[12]; Kk = DM; Nn = DM; nv = DM; nblk = 64; dst = Wout_t; }
            else if ((r -= I_SQ) < I_SQ) { Wsrc = a.in[18]; Kk = DM; Nn = DM; nv = DM; nblk = 64; dst = Wpg_t; gain = a.in[17]; }
            else if ((r -= I_SQ) < I_PP) { Wsrc = a.in[19]; Kk = PLE; Nn = DM; nv = DM; nblk = 64; dst = Wpp_t; }
            else if ((r -= I_PP) < 4 * I_PW) { const int gq = r / I_PW; r -= gq * I_PW; Wsrc = a.in[4] + gq * 65536; Kk = 256; Nn = 256; nv = 256; nblk = 8; dst = poolw_t + gq * 65536; }
            else if ((r -= 4 * I_PW) < I_W1) { Wsrc = a.in[7]; Kk = 4096; Nn = 128; nv = 128; nblk = 4; dst = W1k; }
            else if ((r -= I_W1) < I_W1) { Wsrc = a.in[10]; Kk = 4096; Nn = 128; nv = 128; nblk = 4; dst = W1v; }
            else if ((r -= I_W1) < I_W2) { Wsrc = a.in[8]; Kk = 128; Nn = 128; nv = 128; nblk = 4; dst = W2k; }
            else { r -= I_W2; Wsrc = a.in[11]; Kk = 128; Nn = 128; nv = 128; nblk = 4; dst = W2v; }
            const int grp = r >> 3, wq = r & 7, gpr = nblk >> 2, gkb = grp / gpr, gnb = grp - gkb * gpr; const int kb = gkb * 2 + (wq >> 2), nb = gnb * 4 + (wq & 3), n0 = nb * 32;
            const int drow = mode == 0 ? n0 : ((n0 >> 7) * 256 + (n0 & 127) + (mode == 2 ? 128 : 0));
            tr_item(Wsrc, Kk, Nn, nv, dst, drow, scr, kb * 64, n0, lane, gain);
        }
        for (int m = gw; m < MROWS; m += NGW) rms_row<true>(x + (size_t)m * DM, a.in[2], XN + (size_t)m * DM, lane);
        for (int i = gtid; i < MROWS * PLE / 4; i += GT) { const f32x4 v = ((const f32x4*)a.in[1])[i]; u32x2 w; w.x = cvt_pk_bf16(v[0], v[1]); w.y = cvt_pk_bf16(v[2], v[3]); ((u32x2*)PBF)[i] = w; }
        for (int i = gtid; i < 3 * MROWS; i += GT) { if (i < MROWS) rowss1[i] = 0.f; else if (i < 2 * MROWS) rowss2[i - MROWS] = 0.f; else rowss3[i - 2 * MROWS] = 0.f; }
        for (int i = (G == 256 ? (tid < 128 ? bid * 128 + tid : SEQ * 16) : gtid); i < SEQ * 16; i += GT) { const int pos = i >> 4, fi = i & 15; const float inv = exp2f(-(float)fi * (18.931568569324174f / 16.f)); const float ang = (float)pos * inv;
            cosT[i] = cosf(ang); sinT[i] = sinf(ang); }
        __syncthreads();
        for (int tsk = (G == 256 ? bid - 192 : bid); tsk < 64; tsk += G) { if (tsk < 0) break;
            const int kv = tsk >> 5, l = tsk & 31; const float* pe = a.in[kv == 0 ? 6 : 9] + l * 128; const float* w1 = a.in[kv == 0 ? 7 : 10] + (size_t)l * 128 * 128;
            const int cc = tid & 127, part = tid >> 7; float s = 0.f;
#pragma unroll 8
            for (int k = part * 32; k < part * 32 + 32; ++k) s += pe[k] * w1[(size_t)k * 128 + cc];
            LAS float* red = (LAS float*)lds; red[part * 128 + cc] = s; __syncthreads();
            if (tid < 128) biasp[(size_t)tsk * 128 + tid] = (red[tid] + red[128 + tid]) + (red[256 + tid] + red[384 + tid]);
            __syncthreads();
        }
    }
    }
#endif
    if (a.ph_lo <= 0 && 1 < a.ph_hi) xcd_barrier(xb);
#ifndef SKIP_P1
#ifndef REP1
#define REP1 1
#endif
    if (a.ph_lo <= 1 && 1 < a.ph_hi) for (int rep1 = 0; rep1 < REP1; ++rep1) {
        if (rep1) xcd_barrier(xb);
    {
        pg8::Gemm g{XN, Win_t, MROWS, INWP, DM}; pg8::StaticOrder S; S.init(MROWS, INWP, G, bid);
        EpiInProj E{T, gatesb, cosT, sinT};
        pg8::gemm_phase<EpiInProj, pg8::StaticOrder, true, true>(lds, g, S, E);
    }
    }
#endif
    if (a.ph_lo <= 1 && 2 < a.ph_hi) xcd_barrier(xb);
#ifndef SKIP_P2
#ifndef REP2
#define REP2 1
#endif
    if (a.ph_lo <= 2 && 2 < a.ph_hi) for (int rep2 = 0; rep2 < REP2; ++rep2) {
        if (rep2) xcd_barrier(xb);
    {
        pg8::Gemm g{T, poolw_t, 4 * MROWS, 1024, 256}; PoolOrder S{G, bid}; EpiPoolZ E{Z};
        pg8::gemm_phase<EpiPoolZ, PoolOrder, true, true>(lds, g, S, E);
        signal_done<false>(ctl + 64, bid < 128 ? (unsigned)((127 - bid) / G + 1) : 0u);
        unsigned njobs = 0;
        for (int job = G - 1 - bid; job < 128; job += G) {
            const int kv = job >> 6, b = (job >> 4) & 3, gg = (job >> 3) & 1, n0 = (job & 7) * 16;
            compress_job(lds, T + (size_t)(8 + kv) * TS, kv ? W1v : W1k, kv ? W2v : W2k, biasp + (size_t)kv * 32 * 128, kv ? vcmp : kcmp, b, gg, n0);
            ++njobs;
        }
        signal_done<false>(ctl, njobs);
    }
    }
#endif
#ifndef SKIP_P3
#ifndef REP3
#define REP3 1
#endif
    if (a.ph_lo <= 3 && 3 < a.ph_hi) for (int rep3 = 0; rep3 < REP3; ++rep3) {
        if (rep3) xcd_barrier(xb);
    {
        bf16_t* CAT = XN;
        for (int u = bid; u < 256; u += G) { const int bg = u & 7, c = (u < 128) ? 16 + (u >> 3) : 15 - ((u - 128) >> 3); att::attn_unit(lds, T, kcmp, vcmp, gatesb, SCR, hbuf, CAT, bg >> 1, bg & 1, c, ctl); }
        wait_count(ctl + 64, 128u);
        { const int per = (MROWS + G - 1) / G; const int r0 = bid * per; const int nr = min(per, MROWS - r0); if (nr > 0) for (int repf = 0; repf < REPF; ++repf) pool_finalize(Z, a.in[5], CAT, r0, nr); }
    }
    }
#endif
    if (a.ph_lo <= 3 && 4 < a.ph_hi) xcd_barrier(xb);
#ifndef SKIP_P4
    if (a.ph_lo <= 4 && 4 < a.ph_hi) {
    {
        pg8::Gemm g{XN, Wout_t, MROWS, DM, DM}; pg8::StaticOrder S; S.init(MROWS, DM, G, bid); EpiResidNorm E{x, nullptr, HB1, rowss1};
        pg8::gemm_phase<EpiResidNorm, pg8::StaticOrder, true, true>(lds, g, S, E);
    }
    }
#endif
    if (a.ph_lo <= 4 && 5 < a.ph_hi) xcd_barrier(xb);
#ifndef SKIP_P5
    if (a.ph_lo <= 5 && 5 < a.ph_hi) {
    { }
    }
#endif
#ifndef SKIP_P6
#ifndef REP6
#define REP6 1
#endif
    if (a.ph_lo <= 6 && 6 < a.ph_hi) for (int rep6 = 0; rep6 < REP6; ++rep6) {
        if (rep6) xcd_barrier(xb);
    {
        pg8::Gemm g{HB1, Wgu_t, MROWS, 2 * DFF, DM}; pg8::StaticOrder S; S.init(MROWS, 2 * DFF, G, bid); EpiSwiglu E{ACT, rowss1};
        pg8::gemm_phase<EpiSwiglu, pg8::StaticOrder, true, true>(lds, g, S, E);
        if (G == 256) {
            pg8::Gemm g2{PBF, Wpp_t, MROWS, DM, PLE}; UpperOrder S2; S2.S.init(MROWS, DM, 1, 0); S2.lo = 128; S2.nup = 128; S2.c = bid; EpiStoreBf16 E2{PP, DM};
            pg8::gemm_phase<EpiStoreBf16, UpperOrder, true, true>(lds, g2, S2, E2);
        } else { pg8::Gemm g2{PBF, Wpp_t, MROWS, DM, PLE}; pg8::StaticOrder S2; S2.init(MROWS, DM, G, bid); EpiStoreBf16 E2{PP, DM}; pg8::gemm_phase<EpiStoreBf16, pg8::StaticOrder, true, true>(lds, g2, S2, E2); }
    }
    }
#endif
    if (a.ph_lo <= 6 && 7 < a.ph_hi) xcd_barrier(xb);
#ifndef SKIP_P7
    if (a.ph_lo <= 7 && 7 < a.ph_hi) {
    {
        pg8::Gemm g{ACT, Wd_t, MROWS, DM, DFF}; pg8::StaticOrder S; S.init(MROWS, DM, G, bid); EpiResidNorm E{nullptr, HB1, XN, rowss2};
        pg8::gemm_phase<EpiResidNorm, pg8::StaticOrder, true, true>(lds, g, S, E);
    }
    }
#endif
    if (a.ph_lo <= 7 && 8 < a.ph_hi) xcd_barrier(xb);
#ifndef SKIP_P8
    if (a.ph_lo <= 8 && 8 < a.ph_hi) {
    {
    }
    }
#endif
    __syncthreads();
#ifndef SKIP_P9
    if (a.ph_lo <= 9 && 9 < a.ph_hi) {
    {
        pg8::Gemm g{XN, Wpg_t, MROWS, DM, DM}; pg8::StaticOrder S; S.init(MROWS, DM, G, bid); EpiPle E{XN, PP, rowss2, HB1, rowss3};
        pg8::gemm_phase<EpiPle, pg8::StaticOrder, true, true>(lds, g, S, E);
    }
    }
#endif
    if (a.ph_lo <= 9 && 10 < a.ph_hi) xcd_barrier(xb);
#ifdef EXTRA_SYNCS
    for (int es = 0; es < EXTRA_SYNCS; ++es) xcd_barrier(xb);
#endif
#ifndef SKIP_P10
    if (a.ph_lo <= 10 && 10 < a.ph_hi) {
#ifdef DBG_STOP
        { PHASE_IDS(); const bf16_t* dbg = (const bf16_t*)(ws + (size_t)DBG_OFF * MiB);
          for (size_t i = gtid; i < (size_t)MROWS * DM; i += GT) {
#ifdef DBG_NANDET
              const float bv = __uint_as_float((unsigned)((const bf16_t*)(ws + WS_KCMP))[i % 131072] << 16); const float wv = __uint_as_float((unsigned)((const bf16_t*)(ws + WS_VCMP))[i % 131072] << 16);
              const bool bad1 = !(fabsf(bv) < 1e30f), bad2 = !(fabsf(wv) < 1e30f);
              hbuf[i] = x[i] + (bad1 ? 1000.f : 0.f) + (bad2 ? 3000.f : 0.f);
#else
              float dv = __uint_as_float((unsigned)dbg[i % ((size_t)DBG_ELEMS)] << 16); if (!(fabsf(dv) < 1e30f)) dv = 1000.f; hbuf[i] = x[i] + DBG_SCALE * dv;
#endif
          } }
        xcd_barrier(xb);
#endif
    { PHASE_IDS();
      for (int m = gw; m < MROWS; m += NGW) { const float rstd = 1.0f / sqrtf(rowss3[m] * (1.f / DM) + 1e-6f); const u32x2* hr = (const u32x2*)(HB1 + (size_t)m * DM); f32x4* orow = (f32x4*)(hbuf + (size_t)m * DM);
#pragma unroll
          for (int j = 0; j < 8; ++j) { const u32x2 w = hr[lane + 64 * j]; const f32x4 gv = ((const f32x4*)a.in[20])[lane + 64 * j];
              const f32x4 v = {__uint_as_float(w.x << 16), __uint_as_float(w.x & 0xffff0000u), __uint_as_float(w.y << 16), __uint_as_float(w.y & 0xffff0000u)};
              orow[lane + 64 * j] = v * rstd * gv; } } }
    }
#endif
}

extern "C" void kernel_launch(void* const* d_in, const int* in_sizes, int n_in, void* d_out, int out_size, void* d_ws, size_t ws_size, hipStream_t stream) {
    static int grid = 0;
    if (grid == 0) {
        if (n_in != 21 || in_sizes[0] != MROWS * DM || out_size != MROWS * DM || ws_size < WS_END) {
            fprintf(stderr, "kernel_launch: unexpected shapes (n_in %d, in0 %d, out %d, ws %zu < %zu)\n", n_in, n_in > 0 ? in_sizes[0] : -1, out_size, ws_size, (size_t)WS_END); grid = -1; return; }
        int dev = 0, cus = 0, per_cu = 0;
        hipGetDevice(&dev); hipDeviceGetAttribute(&cus, hipDeviceAttributeMultiprocessorCount, dev);
        if (hipFuncSetAttribute((const void*)hymba_fwd, hipFuncAttributeMaxDynamicSharedMemorySize, LDS_BYTES) != hipSuccess) { fprintf(stderr, "kernel_launch: hipFuncSetAttribute failed\n"); grid = -1; return; }
        if (hipOccupancyMaxActiveBlocksPerMultiprocessor(&per_cu, (const void*)hymba_fwd, NTHREADS, LDS_BYTES) != hipSuccess || per_cu < 1) { fprintf(stderr, "kernel_launch: occupancy query failed (%d)\n", per_cu); grid = -1; return; }
        grid = cus * per_cu;
        fprintf(stderr, "kernel_launch: %d CUs x %d blocks/CU -> grid %d\n", cus, per_cu, grid);
    }
    if (grid < 0) return;
    Args a{};
    for (int i = 0; i < 21; ++i) a.in[i] = (const float*)d_in[i];
    a.out = (float*)d_out; a.ws = (unsigned char*)d_ws;
#if MK_PER_PHASE
    hipError_t e = hipSuccess;
#ifdef DBG_STOP
    for (int k = 0; k <= DBG_STOP; ++k) { a.ph_lo = k; a.ph_hi = k + 1; hipLaunchKernelGGL(hymba_fwd, dim3(grid), dim3(NTHREADS), LDS_BYTES, stream, a); }
    { a.ph_lo = 10; a.ph_hi = 11; void* args[] = {&a}; (void)hipLaunchCooperativeKernel((const void*)hymba_fwd, dim3(grid), dim3(NTHREADS), args, LDS_BYTES, stream); }
#else
    for (int k = 0; k < 11; ++k) { a.ph_lo = k; a.ph_hi = k + 1; hipLaunchKernelGGL(hymba_fwd, dim3(grid), dim3(NTHREADS), LDS_BYTES, stream, a); }
#endif
    e = hipPeekAtLastError();
#else
    a.ph_lo = 0; a.ph_hi = 11;
    if (hipMemsetAsync((char*)d_ws + 262144, 0, 32768, stream) != hipSuccess) { fprintf(stderr, "kernel_launch: hipMemsetAsync failed\n"); return; }
    void* args[] = {&a};
    hipError_t e = hipLaunchCooperativeKernel((const void*)hymba_fwd, dim3(grid), dim3(NTHREADS), args, LDS_BYTES, stream);
#endif
    if (e != hipSuccess) fprintf(stderr, "kernel_launch: cooperative launch failed: %s (grid %d)\n", hipGetErrorString(e), grid);
}
```

```cpp
#include <hip/hip_runtime.h>
#include <cstdio>
#include <cstdint>
#include <cmath>
#define ATT_NOANY 1
namespace pg8 {
#define PG8_LAS __attribute__((address_space(3)))
typedef unsigned short bf16_t;
typedef short bf16x8 __attribute__((ext_vector_type(8)));
typedef float f32x4 __attribute__((ext_vector_type(4)));
typedef unsigned u32x4 __attribute__((ext_vector_type(4)));
constexpr int BM = 256, BK = 64, HALF = 128, HTB = HALF * BK * 2  , STAGE_BYTES = 8 * HTB, NXCD = 8, WGM = 8;

__host__ __device__ __forceinline__ int lds_byte(int r, int c) { const int st = (r >> 4) * 2 + (c >> 5), rr = r & 15, cc = c & 31, ob = rr * 64 + cc * 2; return st * 1024 + (ob ^ (((ob >> 9) & 1) << 5)); }
__host__ __device__ __forceinline__ void stage_rc(int b, int& R, int& C) { const int st = b / 1024, sb = b % 1024, swz = sb ^ (((sb >> 9) & 1) << 5); R = (st >> 1) * 16 + swz / 64; C = (st & 1) * 32 + (swz % 64) / 2; }
__host__ __device__ __forceinline__ int perm32(int rho) { const int n = rho >> 4, i = rho & 15; return 8 * (i >> 2) + 4 * n + (i & 3); }

struct Unit { int pm, pn; };
struct Gemm { const bf16_t* A; const bf16_t* Bt; int M, N, K; };

struct StaticOrder {
    int nM, nN, nwg, G, c;
    __host__ __device__ void init(int M, int N, int G_, int c_) { nM = M / BM; nN = N / BM; nwg = nM * nN; G = G_; c = c_; }
    __host__ __device__ bool next(int i, Unit& u) const {
        const long L = (long)i * G + c; if (L >= nwg) return false;
        int wgid = (int)L; { const int q = nwg / NXCD, r = nwg % NXCD, xcd = wgid % NXCD, off = wgid / NXCD; wgid = (xcd < r ? xcd * (q + 1) : r * (q + 1) + (xcd - r) * q) + off; }
        const int nig = WGM * nN, gid = wgid / nig, fm = gid * WGM, gsz = (nM - fm) < WGM ? (nM - fm) : WGM;
        u.pm = fm + ((wgid % nig) % gsz); u.pn = (wgid % nig) / gsz; return true;
    }
    __host__ __device__ bool next_linear(long L, Unit& u) const {
        if (L >= nwg) return false;
        int wgid = (int)L; { const int q = nwg / NXCD, r = nwg % NXCD, xcd = wgid % NXCD, off = wgid / NXCD; wgid = (xcd < r ? xcd * (q + 1) : r * (q + 1) + (xcd - r) * q) + off; }
        const int nig = WGM * nN, gid = wgid / nig, fm = gid * WGM, gsz = (nM - fm) < WGM ? (nM - fm) : WGM;
        u.pm = fm + ((wgid % nig) % gsz); u.pn = (wgid % nig) / gsz; return true;
    }
    __device__ __forceinline__ void a_ready(const Unit&) const {}
    __device__ __forceinline__ void done(const Unit&) const {}
};

typedef float f32x2_cv __attribute__((ext_vector_type(2))); typedef __bf16 bf16x2_cv __attribute__((ext_vector_type(2)));
__device__ __forceinline__ unsigned cvt_pk_bf16(float lo, float hi) { f32x2_cv v = {lo, hi}; bf16x2_cv b = __builtin_convertvector(v, bf16x2_cv); return __builtin_bit_cast(unsigned, b); }
template <class Epi, class Sched, bool ALIGN_EPI = false, bool SP2 = false>
__device__ __forceinline__ void gemm_phase(PG8_LAS unsigned char* lds, const Gemm g, const Sched& S, const Epi& E) {
    int tid_ = threadIdx.x; asm volatile("" : "+v"(tid_));
    const int tid = tid_, wid = __builtin_amdgcn_readfirstlane(tid >> 6), lane = tid & 63, wr = wid >> 2, wc = wid & 3, fr = lane & 15, fq = lane >> 4;
    const int K = g.K, nt = K / BK;
    unsigned voffA[2], voffB[2];
#pragma unroll
    for (int i = 0; i < 2; ++i) { int R, C; stage_rc(tid * 16 + i * 8192, R, C); const int Rb = Epi::PERM ? ((R & ~31) + perm32(R & 31)) : R;
        voffA[i] = (unsigned)(R * K + C) * 2u; voffB[i] = (unsigned)(Rb * K + C) * 2u; }
    const size_t kstep = (size_t)(BK * 2);
    const size_t hstep = (size_t)HALF * K * 2;
    const size_t tstep = 2 * hstep;
    const unsigned ldsw = (unsigned)wid * 1024u;
    const int aoff = lds_byte(wr * 64 + fr, fq * 8), boff = lds_byte(wc * 32 + fr, fq * 8);
#define PG8_SA(b, h) (((b) * 2 + (h)) * HTB)
#define PG8_SB(b, h) ((4 + (b) * 2 + (h)) * HTB)
#define PG8_STAGE(bufoff, gbase, voff) do { _Pragma("unroll") for (int _i = 0; _i < 2; ++_i) \
        __builtin_amdgcn_global_load_lds((const unsigned*)((const char*)(gbase) + (voff)[_i]), (PG8_LAS unsigned*)(lds + (bufoff) + ldsw + _i * 8192), 16, 0, 0); } while (0)
#define PG8_LDA(dst, b, h) do { _Pragma("unroll") for (int m = 0; m < 4; ++m) _Pragma("unroll") for (int k = 0; k < 2; ++k) dst[m][k] = *(const PG8_LAS bf16x8*)(lds + PG8_SA(b, h) + aoff + m * 2048 + k * 1024); } while (0)
#define PG8_LDB(dst, b, h) do { _Pragma("unroll") for (int n = 0; n < 2; ++n) _Pragma("unroll") for (int k = 0; k < 2; ++k) dst[n][k] = *(const PG8_LAS bf16x8*)(lds + PG8_SB(b, h) + boff + n * 2048 + k * 1024); } while (0)
#define PG8_MMA(ai, bj, At, Bt) do { __builtin_amdgcn_s_setprio(1); _Pragma("unroll") for (int m = 0; m < 4; ++m) _Pragma("unroll") for (int n = 0; n < 2; ++n) _Pragma("unroll") for (int k = 0; k < 2; ++k) \
        acc[ai][bj][m][n] = __builtin_amdgcn_mfma_f32_16x16x32_bf16(Bt[n][k], At[m][k], acc[ai][bj][m][n], 0, 0, 0); __builtin_amdgcn_s_setprio(0); } while (0)
#define PG8_WAIT_V(n) asm volatile("s_waitcnt vmcnt(" #n ")" ::: "memory")
#define PG8_WAIT_L(n) asm volatile("s_waitcnt lgkmcnt(" #n ")" ::: "memory")
#define PG8_BAR __builtin_amdgcn_s_barrier()
#define PG8_SCHED __builtin_amdgcn_sched_barrier(0)
    Unit cur, nxt; int ui = 0;
    if (!S.next(0, cur)) return;
    f32x4 acc[2][2][4][2];
#pragma unroll
    for (int a = 0; a < 2; ++a)
#pragma unroll
        for (int b = 0; b < 2; ++b)
#pragma unroll
            for (int m = 0; m < 4; ++m)
#pragma unroll
                for (int n = 0; n < 2; ++n) acc[a][b][m][n] = (f32x4){0.f, 0.f, 0.f, 0.f};
    bf16x8 At[4][2], B0[2][2], B1[2][2];
    const char* cA = (const char*)g.A + (size_t)cur.pm * tstep; const char* cB = (const char*)g.Bt + (size_t)cur.pn * tstep;
    S.a_ready(cur);
    if constexpr (SP2) {
        PG8_STAGE(PG8_SB(0, 0), cB, voffB); PG8_STAGE(PG8_SB(0, 1), cB + hstep, voffB); PG8_STAGE(PG8_SA(0, 0), cA, voffA); PG8_STAGE(PG8_SA(0, 1), cA + hstep, voffA);
        if (wr == 1) PG8_BAR;
        PG8_WAIT_V(2); PG8_BAR;
        PG8_STAGE(PG8_SB(1, 0), cB + kstep, voffB); PG8_STAGE(PG8_SA(1, 0), cA + kstep, voffA); PG8_STAGE(PG8_SB(1, 1), cB + hstep + kstep, voffB);
        PG8_WAIT_V(6); PG8_BAR;
    } else {
        PG8_STAGE(PG8_SB(0, 0), cB, voffB); PG8_STAGE(PG8_SA(0, 0), cA, voffA); PG8_STAGE(PG8_SB(0, 1), cB + hstep, voffB); PG8_STAGE(PG8_SA(0, 1), cA + hstep, voffA);
        if (wr == 1) PG8_BAR;
        PG8_WAIT_V(4); PG8_BAR;
        PG8_STAGE(PG8_SB(1, 0), cB + kstep, voffB); PG8_STAGE(PG8_SA(1, 0), cA + kstep, voffA); PG8_STAGE(PG8_SB(1, 1), cB + hstep + kstep, voffB);
        PG8_WAIT_V(6); PG8_BAR;
    }
    for (;;) {
        const bool has_next = S.next(ui + 1, nxt);
        const char* nA = has_next ? (const char*)g.A + (size_t)nxt.pm * tstep : cA; const char* nB = has_next ? (const char*)g.Bt + (size_t)nxt.pn * tstep : cB;
        for (int t = 0; t < nt; t += 2) {
            const bool last = (t == nt - 2);
            const char* a1 = cA + (size_t)(t + 1) * kstep;
            const char* a2 = last ? nA : cA + (size_t)(t + 2) * kstep; const char* b2 = last ? nB : cB + (size_t)(t + 2) * kstep;
            const char* a3 = a2 + kstep; const char* b3 = b2 + kstep;
            if (last && has_next) S.a_ready(nxt);
            if constexpr (SP2) {
            PG8_LDB(B0, 0, 0); PG8_LDB(B1, 0, 1); PG8_SCHED; PG8_LDA(At, 0, 0); PG8_STAGE(PG8_SA(1, 1), a1 + hstep, voffA);
            PG8_WAIT_V(8); PG8_WAIT_L(0); PG8_BAR; PG8_MMA(0, 0, At, B0); PG8_MMA(0, 1, At, B1); PG8_BAR; PG8_SCHED;
            PG8_LDA(At, 0, 1); PG8_STAGE(PG8_SB(0, 0), b2, voffB); PG8_STAGE(PG8_SB(0, 1), b2 + hstep, voffB); PG8_STAGE(PG8_SA(0, 0), a2, voffA);
            PG8_WAIT_V(8); PG8_WAIT_L(0); PG8_BAR; PG8_MMA(1, 0, At, B0); PG8_MMA(1, 1, At, B1); PG8_BAR; PG8_SCHED;
            PG8_LDB(B0, 1, 0); PG8_LDB(B1, 1, 1); PG8_SCHED; PG8_LDA(At, 1, 0); PG8_STAGE(PG8_SA(0, 1), a2 + hstep, voffA);
            PG8_WAIT_V(8); PG8_WAIT_L(0); PG8_BAR; PG8_MMA(0, 0, At, B0); PG8_MMA(0, 1, At, B1); PG8_BAR; PG8_SCHED;
            PG8_LDA(At, 1, 1); PG8_STAGE(PG8_SB(1, 0), b3, voffB); PG8_STAGE(PG8_SB(1, 1), b3 + hstep, voffB); PG8_STAGE(PG8_SA(1, 0), a3, voffA);
            PG8_WAIT_V(8); PG8_WAIT_L(0); PG8_BAR; PG8_MMA(1, 0, At, B0); PG8_MMA(1, 1, At, B1); PG8_BAR; PG8_SCHED;
            } else {
            PG8_LDB(B0, 0, 0); PG8_SCHED; PG8_LDA(At, 0, 0); PG8_STAGE(PG8_SA(1, 1), a1 + hstep, voffA);
            PG8_WAIT_L(8); PG8_BAR; PG8_WAIT_L(0); PG8_MMA(0, 0, At, B0); PG8_BAR; PG8_SCHED;
            PG8_LDB(B1, 0, 1); PG8_STAGE(PG8_SB(0, 0), b2, voffB);
            PG8_BAR; PG8_WAIT_L(0); PG8_MMA(0, 1, At, B1); PG8_BAR;
            PG8_LDA(At, 0, 1); PG8_STAGE(PG8_SA(0, 0), a2, voffA);
            PG8_BAR; PG8_WAIT_L(0); PG8_MMA(1, 0, At, B0); PG8_BAR; PG8_SCHED;
            PG8_STAGE(PG8_SB(0, 1), b2 + hstep, voffB);
            PG8_WAIT_V(6); PG8_BAR; PG8_MMA(1, 1, At, B1); PG8_BAR;
            PG8_LDB(B0, 1, 0); PG8_SCHED; PG8_LDA(At, 1, 0); PG8_STAGE(PG8_SA(0, 1), a2 + hstep, voffA);
            PG8_WAIT_L(8); PG8_BAR; PG8_WAIT_L(0); PG8_MMA(0, 0, At, B0); PG8_BAR; PG8_SCHED;
            PG8_LDB(B1, 1, 1); PG8_STAGE(PG8_SB(1, 0), b3, voffB);
            PG8_BAR; PG8_WAIT_L(0); PG8_MMA(0, 1, At, B1); PG8_BAR;
            PG8_LDA(At, 1, 1); PG8_STAGE(PG8_SA(1, 0), a3, voffA);
            PG8_BAR; PG8_WAIT_L(0); PG8_MMA(1, 0, At, B0); PG8_BAR; PG8_SCHED;
            PG8_STAGE(PG8_SB(1, 1), b3 + hstep, voffB);
            PG8_WAIT_V(6); PG8_BAR; PG8_MMA(1, 1, At, B1); PG8_BAR;
            }
        }
        if constexpr (ALIGN_EPI) { if (wr == 0) PG8_BAR; }
        if constexpr (!Epi::AFTER_DRAIN) { E(acc, cur, wr, wc, fr, fq); S.done(cur); }
        if (!has_next) break;
#pragma unroll
        for (int a = 0; a < 2; ++a)
#pragma unroll
            for (int b = 0; b < 2; ++b)
#pragma unroll
                for (int m = 0; m < 4; ++m)
#pragma unroll
                    for (int n = 0; n < 2; ++n) acc[a][b][m][n] = (f32x4){0.f, 0.f, 0.f, 0.f};
        cur = nxt; cA = nA; cB = nB; ++ui;
        if constexpr (ALIGN_EPI) { if (wr == 1) PG8_BAR; }
    }
    PG8_WAIT_V(0);
    if constexpr (!ALIGN_EPI) { if (wr == 0) PG8_BAR; }
    PG8_BAR;
    if constexpr (Epi::AFTER_DRAIN) { E.fused(acc, cur, wr, wc, fr, fq, lds, wid, lane); S.done(cur); }
#undef PG8_SA
#undef PG8_SB
#undef PG8_STAGE
#undef PG8_LDA
#undef PG8_LDB
#undef PG8_MMA
#undef PG8_WAIT_V
#undef PG8_WAIT_L
#undef PG8_BAR
#undef PG8_SCHED
}
}

using pg8::bf16_t; using pg8::bf16x8; using pg8::f32x4; using pg8::u32x4; using pg8::Unit; using pg8::cvt_pk_bf16;
#define LAS __attribute__((address_space(3)))
typedef short s16x4 __attribute__((ext_vector_type(4)));
typedef float f32x16 __attribute__((ext_vector_type(16)));
typedef unsigned u32x2 __attribute__((ext_vector_type(2)));

constexpr int DM = 2048, SEQ = 2048, MROWS = 8192, PLE = 256, INW = 3608, INWP = 3840, DFF = 5632;
constexpr int NTHREADS = 512;
constexpr size_t MiB = (size_t)1 << 20;
constexpr size_t TS = (size_t)MROWS * 256;
constexpr size_t WS_BIASK = 0, WS_BIASV = 512;
constexpr size_t WS_COS = 1 * MiB, WS_SIN = 1 * MiB + 131072, WS_GATES = 1 * MiB + 262144;
constexpr size_t WS_KCMP = 2 * MiB, WS_VCMP = 2 * MiB + 262144, WS_W2K = 2 * MiB + 524288, WS_W2V = WS_W2K + 32768;
constexpr size_t WS_W1K = 3 * MiB, WS_W1V = 4 * MiB, WS_POOLW = 5 * MiB, WS_WPP = 6 * MiB, WS_WIN = 7 * MiB, WS_WOUT = 22 * MiB;
constexpr size_t WS_WPG = 30 * MiB, WS_WD = 38 * MiB, WS_WGU = 60 * MiB, WS_PBF = 104 * MiB, WS_XN = 108 * MiB;
constexpr size_t WS_T = 140 * MiB, WS_Z = 196 * MiB, WS_SCR = 228 * MiB, WS_ACT = 140 * MiB, WS_PP = 140 * MiB, WS_END = 260 * MiB;
constexpr int LDS_BYTES = 147456;

#define LDS_WAIT() asm volatile("s_waitcnt lgkmcnt(0)" ::: "memory")
__device__ __forceinline__ float wave_sum(float v) {
#pragma unroll
    for (int o = 1; o < 64; o <<= 1) v += __shfl_xor(v, o);
    return v;
}
__device__ __forceinline__ float sigmoidf_(float x) { return __builtin_amdgcn_rcpf(1.f + __expf(-x)); }

struct EpiInProj {
    static constexpr bool PERM = true, AFTER_DRAIN = false;
    bf16_t* T; float* gates; const float* cosT; const float* sinT;
    __device__ __forceinline__ void operator()(const f32x4 (&acc)[2][2][4][2], const Unit& u, int wr, int wc, int fr, int fq) const {
        const int pn = u.pn; const int row0 = u.pm * 256 + wr * 64 + fr;
        if (pn < 14) {
            const bool rope = (wc == 0) && (pn >= 4) && (pn < 8 || ((pn & 1) == 0));
            bf16_t* base = T + (size_t)pn * TS;
#pragma unroll
            for (int ai = 0; ai < 2; ++ai)
#pragma unroll
                for (int m = 0; m < 4; ++m) {
                    const int row = row0 + ai * 128 + m * 16; const int pos = row & (SEQ - 1);
                    f32x4 cs0 = {1.f, 1.f, 1.f, 1.f}, cs1 = cs0, sn0 = {0.f, 0.f, 0.f, 0.f}, sn1 = sn0;
                    if (rope) { const float* ct = cosT + pos * 16 + 8 * (fq & 1); const float* st = sinT + pos * 16 + 8 * (fq & 1);
                        cs0 = *(const f32x4*)ct; cs1 = *(const f32x4*)(ct + 4); sn0 = *(const f32x4*)st; sn1 = *(const f32x4*)(st + 4);
                        if (fq < 2) { sn0 = -sn0; sn1 = -sn1; } }
#pragma unroll
                    for (int bj = 0; bj < 2; ++bj) {
                        f32x4 v0 = acc[ai][bj][m][0], v1 = acc[ai][bj][m][1];
                        if (rope) { f32x4 o0, o1;
#pragma unroll
                            for (int j = 0; j < 4; ++j) { o0[j] = __shfl_xor(v0[j], 32); o1[j] = __shfl_xor(v1[j], 32); }
                            v0 = v0 * cs0 + o0 * sn0; v1 = v1 * cs1 + o1 * sn1; }
                        u32x4 w; w.x = cvt_pk_bf16(v0[0], v0[1]); w.y = cvt_pk_bf16(v0[2], v0[3]); w.z = cvt_pk_bf16(v1[0], v1[1]); w.w = cvt_pk_bf16(v1[2], v1[3]);
                        *(u32x4*)(base + (size_t)row * 256 + bj * 128 + wc * 32 + 8 * fq) = w;
                    }
                }
        } else if (wc == 0 && fq < 3) {
#pragma unroll
            for (int ai = 0; ai < 2; ++ai)
#pragma unroll
                for (int m = 0; m < 4; ++m) {
                    const int row = row0 + ai * 128 + m * 16;
                    const f32x4 v0 = acc[ai][0][m][0], v1 = acc[ai][0][m][1];
                    const f32x4 s0 = {sigmoidf_(v0[0]), sigmoidf_(v0[1]), sigmoidf_(v0[2]), sigmoidf_(v0[3])}, s1 = {sigmoidf_(v1[0]), sigmoidf_(v1[1]), sigmoidf_(v1[2]), sigmoidf_(v1[3])};
                    *(f32x4*)(gates + (size_t)row * 24 + 8 * fq) = s0; *(f32x4*)(gates + (size_t)row * 24 + 8 * fq + 4) = s1;
                }
        }
    }
};
struct PoolOrder {
    int G, c;
    __device__ bool next(int i, Unit& u) const { const int L = i * G + c; if (L >= 128) return false; u.pm = L; u.pn = L >> 5; return true; }
    __device__ __forceinline__ void a_ready(const Unit&) const {}
    __device__ __forceinline__ void done(const Unit&) const {}
};
struct EpiPoolZ {
    static constexpr bool PERM = false, AFTER_DRAIN = false;
    float* Z;
    __device__ __forceinline__ void operator()(const f32x4 (&acc)[2][2][4][2], const Unit& u, int wr, int wc, int fr, int fq) const {
        const int row0 = (u.pm & 31) * 256 + wr * 64 + fr; const int col0 = u.pn * 256 + wc * 32 + 4 * fq;
        const __amdgpu_buffer_rsrc_t zr = __builtin_amdgcn_make_buffer_rsrc(Z, 0, MROWS * 1024 * 4, 0x00020000);
#pragma unroll
        for (int ai = 0; ai < 2; ++ai)
#pragma unroll
            for (int m = 0; m < 4; ++m)
#pragma unroll
                for (int bj = 0; bj < 2; ++bj)
#pragma unroll
                    for (int n = 0; n < 2; ++n) __builtin_amdgcn_raw_buffer_store_b128(__builtin_bit_cast(u32x4, acc[ai][bj][m][n]), zr, (unsigned)(((row0 + ai * 128 + m * 16) * 1024 + col0 + bj * 128 + n * 16) * 4), 0, 16);
    }
};
struct EpiStoreBf16 {
    static constexpr bool PERM = false, AFTER_DRAIN = false;
    bf16_t* O; int ldc;
    __device__ __forceinline__ void operator()(const f32x4 (&acc)[2][2][4][2], const Unit& u, int wr, int wc, int fr, int fq) const {
        const int row0 = u.pm * 256 + wr * 64 + fr; const int col0 = u.pn * 256 + wc * 32 + 4 * fq;
#pragma unroll
        for (int ai = 0; ai < 2; ++ai)
#pragma unroll
            for (int m = 0; m < 4; ++m)
#pragma unroll
                for (int bj = 0; bj < 2; ++bj)
#pragma unroll
                    for (int n = 0; n < 2; ++n) { const f32x4 v = acc[ai][bj][m][n]; u32x2 w; w.x = cvt_pk_bf16(v[0], v[1]); w.y = cvt_pk_bf16(v[2], v[3]);
                        *(u32x2*)(O + (size_t)(row0 + ai * 128 + m * 16) * ldc + col0 + bj * 128 + n * 16) = w; }
    }
};
struct EpiResid {
    static constexpr bool PERM = false, AFTER_DRAIN = false;
    const float* base; float* out;
    __device__ __forceinline__ void operator()(const f32x4 (&acc)[2][2][4][2], const Unit& u, int wr, int wc, int fr, int fq) const {
        const int row0 = u.pm * 256 + wr * 64 + fr; const int col0 = u.pn * 256 + wc * 32 + 4 * fq;
#pragma unroll
        for (int ai = 0; ai < 2; ++ai)
#pragma unroll
            for (int m = 0; m < 4; ++m)
#pragma unroll
                for (int bj = 0; bj < 2; ++bj)
#pragma unroll
                    for (int n = 0; n < 2; ++n) { const size_t off = (size_t)(row0 + ai * 128 + m * 16) * DM + col0 + bj * 128 + n * 16;
                        const f32x4 b = *(const f32x4*)(base + off); *(f32x4*)(out + off) = b + acc[ai][bj][m][n]; }
    }
};
struct EpiResidNorm {
    static constexpr bool PERM = true, AFTER_DRAIN = false;
    const float* basef; const bf16_t* baseb; bf16_t* hb; float* rowss;
    __device__ __forceinline__ void operator()(const f32x4 (&acc)[2][2][4][2], const Unit& u, int wr, int wc, int fr, int fq) const {
        const int row0 = u.pm * 256 + wr * 64 + fr; const int col0 = u.pn * 256 + wc * 32 + 8 * fq;
#pragma unroll
        for (int ai = 0; ai < 2; ++ai)
#pragma unroll
            for (int m = 0; m < 4; ++m) { const int row = row0 + ai * 128 + m * 16; float ss = 0.f;
#pragma unroll
                for (int bj = 0; bj < 2; ++bj) { const size_t off = (size_t)row * DM + col0 + bj * 128;
                    f32x4 b0, b1;
                    if (basef) { b0 = *(const f32x4*)(basef + off); b1 = *(const f32x4*)(basef + off + 4); }
                    else { const u32x4 bw = *(const u32x4*)(baseb + off);
                        b0 = (f32x4){__uint_as_float(bw.x << 16), __uint_as_float(bw.x & 0xffff0000u), __uint_as_float(bw.y << 16), __uint_as_float(bw.y & 0xffff0000u)};
                        b1 = (f32x4){__uint_as_float(bw.z << 16), __uint_as_float(bw.z & 0xffff0000u), __uint_as_float(bw.w << 16), __uint_as_float(bw.w & 0xffff0000u)}; }
                    const f32x4 o0 = b0 + acc[ai][bj][m][0], o1 = b1 + acc[ai][bj][m][1];
                    u32x4 w; w.x = cvt_pk_bf16(o0[0], o0[1]); w.y = cvt_pk_bf16(o0[2], o0[3]); w.z = cvt_pk_bf16(o1[0], o1[1]); w.w = cvt_pk_bf16(o1[2], o1[3]);
                    *(u32x4*)(hb + off) = w;
                    ss += ((o0[0] * o0[0] + o0[1] * o0[1]) + (o0[2] * o0[2] + o0[3] * o0[3])) + ((o1[0] * o1[0] + o1[1] * o1[1]) + (o1[2] * o1[2] + o1[3] * o1[3])); }
                ss += __shfl_xor(ss, 16); ss += __shfl_xor(ss, 32);
                if (fq == 0) unsafeAtomicAdd(rowss + row, ss); }
    }
};
struct UpperOrder {
    pg8::StaticOrder S; int lo, nup, c;
    __device__ bool next(int i, Unit& u) const { if (c < lo) return false; return S.next_linear((long)i * nup + (c - lo), u); }
    __device__ __forceinline__ void a_ready(const Unit&) const {}
    __device__ __forceinline__ void done(const Unit&) const {}
};
struct EpiSwiglu {
    static constexpr bool PERM = true, AFTER_DRAIN = false;
    bf16_t* O; const float* rowss;
    __device__ __forceinline__ void operator()(const f32x4 (&acc)[2][2][4][2], const Unit& u, int wr, int wc, int fr, int fq) const {
        const int row0 = u.pm * 256 + wr * 64 + fr; const int col0 = u.pn * 128 + wc * 32 + 8 * fq;
#pragma unroll
        for (int ai = 0; ai < 2; ++ai)
#pragma unroll
            for (int m = 0; m < 4; ++m) {
                const float rs = 1.0f / sqrtf(rowss[row0 + ai * 128 + m * 16] * (1.f / DM) + 1e-6f);
                float r[8];
#pragma unroll
                for (int n = 0; n < 2; ++n)
#pragma unroll
                    for (int j = 0; j < 4; ++j) { const float g = acc[ai][0][m][n][j] * rs, up = acc[ai][1][m][n][j] * rs; r[n * 4 + j] = g * sigmoidf_(g) * up; }
                u32x4 w; w.x = cvt_pk_bf16(r[0], r[1]); w.y = cvt_pk_bf16(r[2], r[3]); w.z = cvt_pk_bf16(r[4], r[5]); w.w = cvt_pk_bf16(r[6], r[7]);
                *(u32x4*)(O + (size_t)(row0 + ai * 128 + m * 16) * DFF + col0) = w;
            }
    }
};
struct EpiPle {
    static constexpr bool PERM = true, AFTER_DRAIN = false;
    const bf16_t* h; const bf16_t* pp; const float* rowss; bf16_t* hb3; float* rowss_out;
    __device__ __forceinline__ void operator()(const f32x4 (&acc)[2][2][4][2], const Unit& u, int wr, int wc, int fr, int fq) const {
        const int row0 = u.pm * 256 + wr * 64 + fr; const int col0 = u.pn * 256 + wc * 32 + 8 * fq;
#pragma unroll
        for (int ai = 0; ai < 2; ++ai)
#pragma unroll
            for (int m = 0; m < 4; ++m) { const int row = row0 + ai * 128 + m * 16; const float rs = 1.0f / sqrtf(rowss[row] * (1.f / DM) + 1e-6f); float ss = 0.f;
#pragma unroll
                for (int bj = 0; bj < 2; ++bj) { const size_t off = (size_t)row * DM + col0 + bj * 128;
                    const u32x4 bw = *(const u32x4*)(h + off); const u32x4 pw = *(const u32x4*)(pp + off);
                    const unsigned bwa[4] = {bw.x, bw.y, bw.z, bw.w}, pwa[4] = {pw.x, pw.y, pw.z, pw.w};
                    float o[8];
#pragma unroll
                    for (int e = 0; e < 8; ++e) { const float a_ = acc[ai][bj][m][e >> 2][e & 3] * rs;
                        const float bv = (e & 1) ? __uint_as_float(bwa[e >> 1] & 0xffff0000u) : __uint_as_float(bwa[e >> 1] << 16);
                        const float pv = (e & 1) ? __uint_as_float(pwa[e >> 1] & 0xffff0000u) : __uint_as_float(pwa[e >> 1] << 16);
                        o[e] = bv + pv * sigmoidf_(a_); ss += o[e] * o[e]; }
                    u32x4 w; w.x = cvt_pk_bf16(o[0], o[1]); w.y = cvt_pk_bf16(o[2], o[3]); w.z = cvt_pk_bf16(o[4], o[5]); w.w = cvt_pk_bf16(o[6], o[7]);
                    *(u32x4*)(hb3 + off) = w; }
                ss += __shfl_xor(ss, 16); ss += __shfl_xor(ss, 32);
                if (fq == 0) unsafeAtomicAdd(rowss_out + row, ss); }
    }
};

__device__ __forceinline__ void tr_item(const float* __restrict__ W, int K, int N, int nvalid, bf16_t* __restrict__ WT, int drow0, LAS float*, int k0, int n0, int lane, const float* __restrict__ gain = nullptr) {
    const int ko = lane & 7, nq = lane >> 3; const int n = n0 + 4 * nq; const bool ok = n < nvalid;
    const float* src = W + (size_t)(k0 + 8 * ko) * N + n;
    f32x4 v[8];
#pragma unroll
    for (int i = 0; i < 8; ++i) v[i] = ok ? __builtin_nontemporal_load((const f32x4*)(src + (size_t)i * N)) : (f32x4){0.f, 0.f, 0.f, 0.f};
    if (gain) { const f32x4 g0 = *(const f32x4*)(gain + k0 + 8 * ko), g1 = *(const f32x4*)(gain + k0 + 8 * ko + 4);
#pragma unroll
        for (int i = 0; i < 4; ++i) { v[i] = v[i] * g0[i]; v[4 + i] = v[4 + i] * g1[i]; } }
#pragma unroll
    for (int j = 0; j < 4; ++j) { u32x4 o; o.x = cvt_pk_bf16(v[0][j], v[1][j]); o.y = cvt_pk_bf16(v[2][j], v[3][j]); o.z = cvt_pk_bf16(v[4][j], v[5][j]); o.w = cvt_pk_bf16(v[6][j], v[7][j]);
        __builtin_nontemporal_store(o, (u32x4*)(WT + (size_t)(drow0 + 4 * nq + j) * K + k0 + 8 * ko)); }
}
template <bool OUT_BF16>
__device__ __forceinline__ void rms_row(const float* src, const float* __restrict__ g, void* dst, int lane) {
    const f32x4* xr = (const f32x4*)src + lane; f32x4 v[8]; float s = 0.f;
#pragma unroll
    for (int j = 0; j < 8; ++j) { v[j] = xr[64 * j]; s += (v[j][0] * v[j][0] + v[j][1] * v[j][1]) + (v[j][2] * v[j][2] + v[j][3] * v[j][3]); }
    const float rstd = 1.0f / sqrtf(wave_sum(s) * (1.f / DM) + 1e-6f);
#pragma unroll
    for (int j = 0; j < 8; ++j) { const f32x4 gv = ((const f32x4*)g)[lane + 64 * j]; const f32x4 y = v[j] * rstd * gv;
        if (OUT_BF16) { u32x2 w; w.x = cvt_pk_bf16(y[0], y[1]); w.y = cvt_pk_bf16(y[2], y[3]); ((u32x2*)dst)[lane + 64 * j] = w; }
        else ((f32x4*)dst)[lane + 64 * j] = y; }
}

__device__ __forceinline__ float gelu_tanh(float x) { const float y = 0.7978845608028654f * (x + 0.044715f * x * x * x); const float e = __expf(2.f * y); return 0.5f * x * (2.f - 2.f * __builtin_amdgcn_rcpf(e + 1.f)); }
__device__ __forceinline__ void compress_job(LAS unsigned char* lds, const bf16_t* __restrict__ X, const bf16_t* __restrict__ W1t, const bf16_t* __restrict__ W2t,
                                             const float* __restrict__ bias, bf16_t* outc, int b, int g, int n0) {
    int tid_ = threadIdx.x; asm volatile("" : "+v"(tid_));
    const int tid = tid_, wid = __builtin_amdgcn_readfirstlane(tid >> 6), lane = tid & 63, fr = lane & 15, fq = lane >> 4;
    const int nn = min(n0 + fr, 126);
    const bf16_t* Ab = X + ((size_t)b * SEQ + 16 * nn) * 256 + g * 128 + 16 * fq;
    const bf16_t* Bb = W1t + (size_t)fr * 4096 + 16 * fq;
    f32x4 acc[8];
#pragma unroll
    for (int ct = 0; ct < 8; ++ct) acc[ct] = (f32x4){0.f, 0.f, 0.f, 0.f};
#pragma unroll 1
    for (int i = 0; i < 8; i += 2) {
        bf16x8 av[2][2], bv[2][8][2];
#pragma unroll
        for (int u = 0; u < 2; ++u) { const int pp = 8 * wid + i + u; const bf16_t* ap = Ab + (pp >> 1) * 256 + (pp & 1) * 64;
            av[u][0] = *(const bf16x8*)ap; av[u][1] = *(const bf16x8*)(ap + 8);
#pragma unroll
            for (int ct = 0; ct < 8; ++ct) { const bf16_t* bp = Bb + (size_t)ct * 16 * 4096 + 64 * pp; bv[u][ct][0] = *(const bf16x8*)bp; bv[u][ct][1] = *(const bf16x8*)(bp + 8); } }
        __builtin_amdgcn_sched_barrier(0);
#pragma unroll
        for (int u = 0; u < 2; ++u)
#pragma unroll
            for (int hh = 0; hh < 2; ++hh)
#pragma unroll
                for (int ct = 0; ct < 8; ++ct) acc[ct] = __builtin_amdgcn_mfma_f32_16x16x32_bf16(av[u][hh], bv[u][ct][hh], acc[ct], 0, 0, 0);
    }
    LAS float* part = (LAS float*)lds;
#pragma unroll
    for (int ct = 0; ct < 8; ++ct)
#pragma unroll
        for (int r = 0; r < 4; ++r) part[(wid * 16 + 4 * fq + r) * 132 + 16 * ct + fr] = acc[ct][r];
    __syncthreads();
    LAS bf16_t* hid = (LAS bf16_t*)(lds + 67584);
    { const int row = tid >> 5, c4 = (tid & 31) * 4; f32x4 s = *(const f32x4*)(bias + c4);
#pragma unroll 8
      for (int l = 1; l < 32; ++l) s += *(const f32x4*)(bias + l * 128 + c4);
#pragma unroll
      for (int w = 0; w < 8; ++w) s += *(const LAS f32x4*)(part + (w * 16 + row) * 132 + c4);
      u32x2 hw; hw.x = cvt_pk_bf16(gelu_tanh(s[0]), gelu_tanh(s[1])); hw.y = cvt_pk_bf16(gelu_tanh(s[2]), gelu_tanh(s[3]));
      *(LAS u32x2*)(hid + row * 136 + c4) = hw; }
    __syncthreads();
    f32x4 acc2 = {0.f, 0.f, 0.f, 0.f};
    const __amdgpu_buffer_rsrc_t orsrc = __builtin_amdgcn_make_buffer_rsrc(outc, 0, 8 * 128 * 128 * 2, 0x00020000);
#pragma unroll
    for (int s = 0; s < 4; ++s) { const bf16x8 a = *(const LAS bf16x8*)(hid + fr * 136 + 32 * s + 8 * fq);
        const bf16x8 bb = *(const bf16x8*)(W2t + (size_t)(16 * wid + fr) * 128 + 32 * s + 8 * fq); acc2 = __builtin_amdgcn_mfma_f32_16x16x32_bf16(a, bb, acc2, 0, 0, 0); }
#pragma unroll
    for (int r = 0; r < 4; ++r) { const int n = n0 + 4 * fq + r; const float v = (n == 127) ? 0.f : acc2[r];
        __builtin_amdgcn_raw_buffer_store_b16((short)(cvt_pk_bf16(v, v) & 0xffffu), orsrc, (unsigned)((((b * 2 + g) * 128 + n) * 128 + 16 * wid + fr) * 2), 0, 16); }
    __syncthreads();
}


template <bool FENCE>
__device__ __forceinline__ void signal_done(unsigned* cnt, unsigned n) {
    asm volatile("s_waitcnt vmcnt(0)" ::: "memory"); __syncthreads();
    if (threadIdx.x == 0 && n) { if (FENCE) { __builtin_amdgcn_fence(__ATOMIC_RELEASE, "agent"); asm volatile("s_waitcnt vmcnt(0)" ::: "memory"); }
        (void)__hip_atomic_fetch_add(cnt, n, __ATOMIC_RELAXED, __HIP_MEMORY_SCOPE_AGENT); }
}
__device__ __forceinline__ void wait_count(unsigned* cnt, unsigned want) {
    if (threadIdx.x == 0) { unsigned spins = 0;
        while (__hip_atomic_load(cnt, __ATOMIC_RELAXED, __HIP_MEMORY_SCOPE_AGENT) < want && ++spins < (1u << 22)) __builtin_amdgcn_s_sleep(2);
        __builtin_amdgcn_fence(__ATOMIC_ACQUIRE, "agent"); asm volatile("s_waitcnt vmcnt(0)" ::: "memory"); }
    __syncthreads();
}
namespace att {
constexpr float SCALE = 0.08838834764831845f, CL2 = SCALE * 1.4426950408889634f, NEGB = -1e30f;
#define KSWZ(row, colB) ((row) * 256 + ((colB) ^ (((row) & 7) << 4)))
#define SBAR() __builtin_amdgcn_sched_barrier(0)
__device__ __forceinline__ int crow(int r, int hi) { return (r & 3) + 8 * (r >> 2) + 4 * hi; }
__device__ __forceinline__ int v_st(int k, int c) { const int kk = (k & ~0xC) | ((k & 4) << 1) | ((k & 8) >> 1); return ((kk >> 3) * 4 + (c >> 5)) * 512 + ((kk & 7) * 32 + (c & 31)) * 2; }
__device__ __forceinline__ int v_rd_base(int lane) { return ((lane & 3) << 3) | (((lane >> 2) & 3) << 6) | (((lane >> 4) & 1) << 5) | (((lane >> 5) & 1) << 8); }
constexpr int v_rd_off(int d0, int ks, int half) { return d0 * 512 + ks * 4096 + half * 2048; }
template <int OFF> __device__ __forceinline__ s16x4 tr_read(int vb) { s16x4 r; asm volatile("ds_read_b64_tr_b16 %0, %1 offset:%2" : "=&v"(r) : "v"(vb), "i"(OFF) : "memory"); return r; }
template <int D0> __device__ __forceinline__ void pv_one(f32x16& od, int vb, bf16x8 pa0, bf16x8 pa1, bf16x8 pa2, bf16x8 pa3) {
    const s16x4 l0 = tr_read<v_rd_off(D0, 0, 0)>(vb), h0 = tr_read<v_rd_off(D0, 0, 1)>(vb), l1 = tr_read<v_rd_off(D0, 1, 0)>(vb), h1 = tr_read<v_rd_off(D0, 1, 1)>(vb);
    const s16x4 l2 = tr_read<v_rd_off(D0, 2, 0)>(vb), h2 = tr_read<v_rd_off(D0, 2, 1)>(vb), l3 = tr_read<v_rd_off(D0, 3, 0)>(vb), h3 = tr_read<v_rd_off(D0, 3, 1)>(vb);
    asm volatile("s_waitcnt lgkmcnt(0)" ::: "memory"); SBAR();
#define PK(L, H) (bf16x8){L[0], L[1], L[2], L[3], H[0], H[1], H[2], H[3]}
    __builtin_amdgcn_s_setprio(1);
    od = __builtin_amdgcn_mfma_f32_32x32x16_bf16(pa0, PK(l0, h0), od, 0, 0, 0);
    od = __builtin_amdgcn_mfma_f32_32x32x16_bf16(pa1, PK(l1, h1), od, 0, 0, 0);
    od = __builtin_amdgcn_mfma_f32_32x32x16_bf16(pa2, PK(l2, h2), od, 0, 0, 0);
    od = __builtin_amdgcn_mfma_f32_32x32x16_bf16(pa3, PK(l3, h3), od, 0, 0, 0);
    __builtin_amdgcn_s_setprio(0);
#undef PK
}
__device__ __forceinline__ void pv_d0(f32x16* o, int vb, bf16x8 pa0, bf16x8 pa1, bf16x8 pa2, bf16x8 pa3) {
    pv_one<0>(o[0], vb, pa0, pa1, pa2, pa3); pv_one<1>(o[1], vb, pa0, pa1, pa2, pa3); pv_one<2>(o[2], vb, pa0, pa1, pa2, pa3); pv_one<3>(o[3], vb, pa0, pa1, pa2, pa3);
}
__device__ __forceinline__ void qkt(f32x16& p0, f32x16& p1, const LAS char* Ks, const bf16x8* qr, int r32, int hi) {
    p0 = f32x16{}; p1 = f32x16{};
    __builtin_amdgcn_s_setprio(1);
#pragma unroll
    for (int d0 = 0; d0 < 8; ++d0) { const int cb = (d0 * 16 + hi * 8) * 2;
        const bf16x8 b0 = *(const LAS bf16x8*)(Ks + KSWZ(r32, cb));
        const bf16x8 b1 = *(const LAS bf16x8*)(Ks + KSWZ(32 + r32, cb));
        p0 = __builtin_amdgcn_mfma_f32_32x32x16_bf16(b0, qr[d0], p0, 0, 0, 0);
        p1 = __builtin_amdgcn_mfma_f32_32x32x16_bf16(b1, qr[d0], p1, 0, 0, 0);
#ifdef QKT_SBAR
        if ((d0 & (QKT_SBAR - 1)) == QKT_SBAR - 1) SBAR();
#endif
    }
    __builtin_amdgcn_s_setprio(0);
}
__device__ __forceinline__ void sm_step(f32x16& p0, f32x16& p1, bool lane_on, float& m_reg, float& l_reg, f32x16* o, LAS float* al_l, int r32, int hi,
                                        bf16x8& pa0, bf16x8& pa1, bf16x8& pa2, bf16x8& pa3, float& alpha_out) {
    float pmax = p0[0];
#pragma unroll
    for (int r = 1; r < 16; ++r) pmax = fmaxf(pmax, p0[r]);
#pragma unroll
    for (int r = 0; r < 16; ++r) pmax = fmaxf(pmax, p1[r]);
    pmax = lane_on ? pmax : NEGB;
    { auto rr = __builtin_amdgcn_permlane32_swap(__float_as_uint(pmax), __float_as_uint(pmax), false, false);
      pmax = fmaxf(__uint_as_float(rr[0]), __uint_as_float(rr[1])); }
    const float mn = fmaxf(m_reg, pmax);
    const float alpha = __builtin_amdgcn_exp2f((m_reg - mn) * CL2);
    m_reg = mn; alpha_out = alpha;
    const float mnC = (!lane_on || mn < -1e29f) ? -INFINITY : -mn * CL2;
#pragma unroll
    for (int r = 0; r < 16; ++r) p0[r] = __builtin_amdgcn_exp2f(fmaf(p0[r], CL2, mnC));
#pragma unroll
    for (int r = 0; r < 16; ++r) p1[r] = __builtin_amdgcn_exp2f(fmaf(p1[r], CL2, mnC));
    float ps = 0.f;
#pragma unroll
    for (int r = 0; r < 16; ++r) ps += p0[r];
#pragma unroll
    for (int r = 0; r < 16; ++r) ps += p1[r];
    { auto rr = __builtin_amdgcn_permlane32_swap(__float_as_uint(ps), __float_as_uint(ps), false, false);
      ps = __uint_as_float(rr[0]) + __uint_as_float(rr[1]); }
    l_reg = l_reg * alpha + ps;
    if (__any(alpha < 1.f)) { if (hi == 0) al_l[r32] = alpha; LDS_WAIT();
#pragma unroll
        for (int d = 0; d < 4; ++d)
#pragma unroll
            for (int r = 0; r < 16; ++r) o[d][r] *= al_l[crow(r, hi)];
    }
#define PK4(P, BASE, OUT) do { unsigned a0_ = cvt_pk_bf16(P[BASE + 0], P[BASE + 1]), a1_ = cvt_pk_bf16(P[BASE + 2], P[BASE + 3]);   \
    unsigned b0_ = cvt_pk_bf16(P[BASE + 4], P[BASE + 5]), b1_ = cvt_pk_bf16(P[BASE + 6], P[BASE + 7]);                              \
    auto r0_ = __builtin_amdgcn_permlane32_swap(a0_, b0_, false, false); auto r1_ = __builtin_amdgcn_permlane32_swap(a1_, b1_, false, false); \
    u32x4 w_ = {r0_[0], r1_[0], r0_[1], r1_[1]}; OUT = __builtin_bit_cast(bf16x8, w_); } while (0)
    PK4(p0, 0, pa0); PK4(p0, 8, pa1); PK4(p1, 0, pa2); PK4(p1, 8, pa3);
#undef PK4
}
struct Stg { bf16x8 k0, k1, v0, v1; };
__device__ __forceinline__ void tile_load(Stg& s, const bf16_t* Kb, const bf16_t* Vb, int pitch, int key0, int sr, int sc) {
    s.k0 = *(const bf16x8*)(Kb + (size_t)(key0 + sr) * pitch + sc); s.k1 = *(const bf16x8*)(Kb + (size_t)(key0 + 32 + sr) * pitch + sc);
    s.v0 = *(const bf16x8*)(Vb + (size_t)(key0 + sr) * pitch + sc); s.v1 = *(const bf16x8*)(Vb + (size_t)(key0 + 32 + sr) * pitch + sc);
}
__device__ __forceinline__ void tile_write(LAS char* Kl, LAS char* Vl, const Stg& s, int sr, int sc) {
    *(LAS bf16x8*)(Vl + v_st(sr, sc)) = s.v0; *(LAS bf16x8*)(Vl + v_st(32 + sr, sc)) = s.v1;
    *(LAS bf16x8*)(Kl + KSWZ(sr, sc * 2)) = s.k0; *(LAS bf16x8*)(Kl + KSWZ(32 + sr, sc * 2)) = s.k1;
}
__device__ __forceinline__ void tile_dma(LAS char* Kl, LAS char* Vl, const bf16_t* Kb, const bf16_t* Vb, int pitch, int key0, int wid, int lane) {
#pragma unroll
    for (int h = 0; h < 2; ++h) {
        const int ch = wid * 2 + h; const int L = ch * 1024 + lane * 16;
        { const int row = L >> 8, c16 = ((L >> 4) & 15) ^ (row & 7);
          __builtin_amdgcn_global_load_lds((const unsigned*)(Kb + (size_t)(key0 + row) * pitch + c16 * 8), (LAS unsigned*)(Kl + ch * 1024), 16, 0, 0); }
        { const int sub = L >> 9, kk = (sub >> 2) * 8 + ((L >> 6) & 7), c8 = (sub & 3) * 4 + ((L >> 4) & 3);
          const int k = (kk & ~0xC) | ((kk & 4) << 1) | ((kk & 8) >> 1);
          __builtin_amdgcn_global_load_lds((const unsigned*)(Vb + (size_t)(key0 + k) * pitch + c8 * 8), (LAS unsigned*)(Vl + ch * 1024), 16, 0, 0); }
    }
}
template <int MODE>
__device__ __forceinline__ void finalize(const f32x16* o, float l_reg, float gate, LAS float* li_l, int r32, int hi, float* scrA, float* scrB, bf16_t* catp) {
    if (hi == 0) li_l[r32] = l_reg > 0.f ? gate / l_reg : 0.f;
    LDS_WAIT();
#pragma unroll
    for (int r = 0; r < 16; ++r) {
        const int rc = (r & 3) + 8 * (r >> 2);
        unsigned lo = (unsigned)(4 * hi) * 1024u + (unsigned)r32, lc = (unsigned)(4 * hi) * 2048u + (unsigned)r32;
        asm volatile("" : "+v"(lo), "+v"(lc));
        const float f = li_l[rc + 4 * hi];
        if (MODE == 2) {
            float va[4], vb[4];
#pragma unroll
            for (int d0 = 0; d0 < 4; ++d0) { va[d0] = scrA[lo + rc * 1024 + 32 * d0]; vb[d0] = scrB[lo + rc * 1024 + 32 * d0]; }
#pragma unroll
            for (int d0 = 0; d0 < 4; ++d0) { const float v = o[d0][r] * f + (va[d0] + vb[d0]); catp[lc + rc * 2048 + 32 * d0] = (bf16_t)(cvt_pk_bf16(v, v) & 0xffffu); }
            if (r & 1) asm volatile("" ::: "memory");
        } else {
#pragma unroll
            for (int d0 = 0; d0 < 4; ++d0) { const float v = o[d0][r] * f; if (MODE == 0) scrA[lo + rc * 1024 + 32 * d0] = v; else scrB[lo + rc * 1024 + 32 * d0] = v; }
        }
    }
    LDS_WAIT();
}
template <bool WIN>
__device__ __forceinline__ void run_branch(LAS char* K_l, LAS char* V_l, const bf16_t* Kb, const bf16_t* Vb, unsigned tiles, unsigned lanemask, int c, int tl,
                                           const bf16x8* qr, float& m_reg, float& l_reg, f32x16* o, LAS float* al_l, int r32, int hi, int wid, int lane, int vb0) {
    unsigned rem = tiles; int j = __builtin_ctz(rem); rem &= rem - 1;
    __syncthreads();
    tile_dma(K_l, V_l, Kb, Vb, 256, 64 * j, wid, lane);
    asm volatile("s_waitcnt vmcnt(0)" ::: "memory"); __syncthreads();
    int cur = 0;
    for (;;) {
        const int jn = rem ? __builtin_ctz(rem) : -1;
        if (jn >= 0) { rem &= rem - 1; tile_dma(K_l + (cur ^ 1) * 32768, V_l + (cur ^ 1) * 32768, Kb, Vb, 256, 64 * jn, wid, lane); }
        const bool lane_on = (lanemask >> j) & 1u;
#ifdef ATT_NOANY
        {
#else
        if (__any(lane_on)) {
#endif
            f32x16 p0, p1; qkt(p0, p1, K_l + cur * 32768, qr, r32, hi);
            if (j == c) {
                int tlv = tl - 4 * hi; asm volatile("" : "+v"(tlv));
#pragma unroll
                for (int r = 0; r < 16; ++r) { const int kk = (r & 3) + 8 * (r >> 2); p0[r] = (kk > tlv) ? NEGB : p0[r]; p1[r] = (kk + 32 > tlv) ? NEGB : p1[r]; }
            }
            if (WIN && j == c - 8) {
                int tlv = tl - 4 * hi; asm volatile("" : "+v"(tlv));
#pragma unroll
                for (int r = 0; r < 16; ++r) { const int kk = (r & 3) + 8 * (r >> 2); p0[r] = (kk <= tlv) ? NEGB : p0[r]; p1[r] = (kk + 32 <= tlv) ? NEGB : p1[r]; }
            }
            bf16x8 pa0, pa1, pa2, pa3; float al;
            sm_step(p0, p1, lane_on, m_reg, l_reg, o, al_l, r32, hi, pa0, pa1, pa2, pa3, al);
            pv_d0(o, vb0 + cur * 32768, pa0, pa1, pa2, pa3);
        }
        if (jn < 0) break;
        asm volatile("s_waitcnt vmcnt(0)" ::: "memory"); __syncthreads();
        j = jn; cur ^= 1;
    }
}
constexpr int L_V = 0, L_K = 16384, L_IMP = 65536, L_SIMP = 99328, L_MASK = 107776, L_WS = 108288;
__device__ __forceinline__ void attn_unit(LAS unsigned char* ldsb, const bf16_t* __restrict__ T, const bf16_t* kcmp, const bf16_t* vcmp,
                                          const float* __restrict__ gates, float* scr, float* scr2, bf16_t* cat, int b, int g, int c, unsigned* cmp_cnt) {
    LAS char* lds = (LAS char*)ldsb;
    int tid_ = threadIdx.x; asm volatile("" : "+v"(tid_));
    const int tid = tid_, wid = __builtin_amdgcn_readfirstlane(tid >> 6), lane = tid & 63, r32 = lane & 31, hi = lane >> 5;
    const int hh = wid & 3, ch = wid >> 2, h = g * 4 + hh;
    const int tl = 32 * ch + r32, t = 64 * c + tl;
    const size_t row = (size_t)b * SEQ + t;
    LAS char* V_l = lds + L_V; LAS char* K_l = lds + L_K;
    LAS float* impw = (LAS float*)(lds + L_IMP) + wid * 1056;
    LAS float* simp = (LAS float*)(lds + L_SIMP);
    LAS unsigned* maskw = (LAS unsigned*)(lds + L_MASK);
    LAS float* li_l = (LAS float*)(lds + L_WS) + wid * 64; LAS float* al_l = li_l + 32;
    bf16x8 qr[8];
    { const bf16_t* Qw = T + (size_t)(4 + (h >> 1)) * TS + row * 256 + (h & 1) * 128 + hi * 8;
#pragma unroll
      for (int d0 = 0; d0 < 8; ++d0) qr[d0] = *(const bf16x8*)(Qw + d0 * 16); }
    const int vb0 = (int)(uintptr_t)V_l + v_rd_base(lane);
    const float g0 = gates[row * 24 + h * 3 + 0], g1 = gates[row * 24 + h * 3 + 1], g2 = gates[row * 24 + h * 3 + 2];
    float* scrp = scr + ((size_t)b * SEQ + 64 * c + 32 * ch) * 1024 + h * 128;
    float* scrq = scr2 + ((size_t)b * SEQ + 64 * c + 32 * ch) * 1024 + h * 128;
    bf16_t* catp = cat + ((size_t)b * SEQ + 64 * c + 32 * ch) * DM + 1024 + h * 128;
    if (tid == 0) maskw[64] = 0u;
    float m_reg = NEGB, l_reg = 0.f; f32x16 o[4];
#pragma unroll
    for (int d = 0; d < 4; ++d) o[d] = f32x16{};
    { const bf16_t* Kb = T + (size_t)12 * TS + (size_t)b * SEQ * 256 + g * 128; const bf16_t* Vb = T + (size_t)13 * TS + (size_t)b * SEQ * 256 + g * 128;
      const int lo = c >= 8 ? c - 8 : 0; const unsigned wt = (c == 31 ? 0xffffffffu : ((1u << (c + 1)) - 1u)) & ~((1u << lo) - 1u);
#ifndef ATT_SKIP_B2
      run_branch<true>(K_l, V_l, Kb, Vb, wt, 0xffffffffu, c, tl, qr, m_reg, l_reg, o, al_l, r32, hi, wid, lane, vb0);
#endif
      finalize<0>(o, l_reg, g2, li_l, r32, hi, scrp, scrq, catp);
    }
    wait_count(cmp_cnt, 128u);
    m_reg = NEGB; l_reg = 0.f;
#pragma unroll
    for (int d = 0; d < 4; ++d) o[d] = f32x16{};
    {
        const bf16_t* Kb = kcmp + (size_t)(b * 2 + g) * 128 * 128; const bf16_t* Vb = vcmp + (size_t)(b * 2 + g) * 128 * 128;
        const int nmax = (t >= 31) ? ((t - 31) >> 4) : -1;
        bf16x8 pa0, pa1, pa2, pa3; float alA, alB;
        float inn[4][4], lst[4][4];
        __syncthreads();
        tile_dma(K_l, V_l, Kb, Vb, 128, 0, wid, lane); tile_dma(K_l + 32768, V_l + 32768, Kb, Vb, 128, 64, wid, lane);
        asm volatile("s_waitcnt vmcnt(0)" ::: "memory"); __syncthreads();
        {
            f32x16 a0, a1;
            qkt(a0, a1, K_l, qr, r32, hi);
#pragma unroll
            for (int r = 0; r < 16; ++r) { const int n = crow(r, hi); a0[r] = (n <= nmax) ? a0[r] : NEGB; a1[r] = (n + 32 <= nmax) ? a1[r] : NEGB; }
            sm_step(a0, a1, true, m_reg, l_reg, o, al_l, r32, hi, pa0, pa1, pa2, pa3, alA);
#pragma unroll
            for (int c4 = 0; c4 < 4; ++c4) { inn[0][c4] = (a0[4 * c4] + a0[4 * c4 + 1]) + (a0[4 * c4 + 2] + a0[4 * c4 + 3]); lst[0][c4] = a0[4 * c4 + 3];
                                             inn[1][c4] = (a1[4 * c4] + a1[4 * c4 + 1]) + (a1[4 * c4 + 2] + a1[4 * c4 + 3]); lst[1][c4] = a1[4 * c4 + 3]; }
        }
        pv_d0(o, vb0, pa0, pa1, pa2, pa3);
        {
            f32x16 b0, b1;
            qkt(b0, b1, K_l + 32768, qr, r32, hi);
#pragma unroll
            for (int r = 0; r < 16; ++r) { const int n = 64 + crow(r, hi); b0[r] = (n <= nmax) ? b0[r] : NEGB; b1[r] = (n + 32 <= nmax) ? b1[r] : NEGB; }
            sm_step(b0, b1, true, m_reg, l_reg, o, al_l, r32, hi, pa0, pa1, pa2, pa3, alB);
#pragma unroll
            for (int c4 = 0; c4 < 4; ++c4) { inn[2][c4] = (b0[4 * c4] + b0[4 * c4 + 1]) + (b0[4 * c4 + 2] + b0[4 * c4 + 3]); lst[2][c4] = b0[4 * c4 + 3];
                                             inn[3][c4] = (b1[4 * c4] + b1[4 * c4 + 1]) + (b1[4 * c4 + 2] + b1[4 * c4 + 3]); lst[3][c4] = b1[4 * c4 + 3]; }
        }
        pv_d0(o, vb0 + 32768, pa0, pa1, pa2, pa3);
        const float inv = l_reg > 0.f ? 1.f / l_reg : 0.f; const float fa = alB * inv, fb = inv;
        float x[4][4];
#pragma unroll
        for (int TT = 0; TT < 4; ++TT)
#pragma unroll
            for (int c4 = 0; c4 < 4; ++c4) { const float f = TT < 2 ? fa : fb; inn[TT][c4] *= f; lst[TT][c4] *= f; x[TT][c4] = __shfl_xor(lst[TT][c4], 32); }
#pragma unroll
        for (int TT = 0; TT < 4; ++TT)
#pragma unroll
            for (int c4 = 0; c4 < 4; ++c4) {
                const float plo = c4 >= 1 ? x[TT][c4 >= 1 ? c4 - 1 : 0] : (TT >= 1 ? x[TT >= 1 ? TT - 1 : 0][3] : 0.f);
                const float prev = hi ? x[TT][c4] : plo;
                impw[r32 * 33 + 8 * TT + 2 * c4 + hi] = inn[TT][c4] + prev;
            }
#ifndef ATT_SKIP_FIN
        finalize<1>(o, l_reg, g0, li_l, r32, hi, scrp, scrq, catp);
#endif
    }
    __syncthreads();
    {
        const int pidx = tid >> 3, sub = tid & 7;
        const LAS float* ib = (const LAS float*)(lds + L_IMP) + ((pidx >> 5) * 4) * 1056 + (pidx & 31) * 33;
#pragma unroll
        for (int jj = 0; jj < 4; ++jj) { const int j = 4 * sub + jj; float sv = (ib[j] + ib[1056 + j]) + (ib[2112 + j] + ib[3168 + j]);
            if (j > c) sv = -1.f; else if (j == 0 || j == c || j == c - 1) sv = 3.0e38f;
            simp[pidx * 33 + j] = sv; }
        __syncthreads();
        float vj[4]; int rk[4];
#pragma unroll
        for (int jj = 0; jj < 4; ++jj) { vj[jj] = simp[pidx * 33 + 4 * sub + jj]; rk[jj] = 0; }
#pragma unroll 1
        for (int i = 0; i < 32; ++i) { const float vi = simp[pidx * 33 + i];
#pragma unroll
            for (int jj = 0; jj < 4; ++jj) rk[jj] += (vi > vj[jj] || (vi == vj[jj] && i < 4 * sub + jj)) ? 1 : 0; }
        unsigned bits = 0u;
#pragma unroll
        for (int jj = 0; jj < 4; ++jj) { const int j = 4 * sub + jj; if (rk[jj] < 16 && j <= c) bits |= 1u << j; }
        bits |= __shfl_xor(bits, 1); bits |= __shfl_xor(bits, 2); bits |= __shfl_xor(bits, 4);
        if (sub == 0) maskw[pidx] = bits;
        bits |= __shfl_xor(bits, 8); bits |= __shfl_xor(bits, 16); bits |= __shfl_xor(bits, 32);
        if (lane == 0) atomicOr((unsigned*)(maskw + 64), bits);
    }
    __syncthreads();
    const unsigned umask = __builtin_amdgcn_readfirstlane(maskw[64]);
    const unsigned mymask = maskw[tl];
    m_reg = NEGB; l_reg = 0.f;
#pragma unroll
    for (int d = 0; d < 4; ++d) o[d] = f32x16{};
    { const bf16_t* Kb = T + (size_t)10 * TS + (size_t)b * SEQ * 256 + g * 128; const bf16_t* Vb = T + (size_t)11 * TS + (size_t)b * SEQ * 256 + g * 128;
#ifndef ATT_SKIP_B1
      run_branch<false>(K_l, V_l, Kb, Vb, umask, mymask, c, tl, qr, m_reg, l_reg, o, al_l, r32, hi, wid, lane, vb0);
#endif
#ifndef ATT_SKIP_FIN
      finalize<2>(o, l_reg, g1, li_l, r32, hi, scrp, scrq, catp);
#endif
    }
    __syncthreads();
}
}

template <int W>
__device__ __forceinline__ void pool_rows16(const float* __restrict__ Z, const float* __restrict__ scale, bf16_t* cat, int base, int q) {
    const int seq0 = base & ~(SEQ - 1);
    f32x4 v[15 + W];
#pragma unroll
    for (int i = 0; i < 15 + W; ++i) { const int r = base - (W - 1) + i; v[i] = (r >= seq0) ? *((const f32x4*)Z + (size_t)r * 256 + q) : (f32x4){0.f, 0.f, 0.f, 0.f}; }
    const f32x4 sv = ((const f32x4*)scale)[q];
#pragma unroll
    for (int j = 0; j < 16; ++j) { f32x4 s = v[j + W - 1];
#pragma unroll
        for (int k = 1; k < W; ++k) s += v[j + W - 1 - k];
        const int t = (base + j) & (SEQ - 1); const int n = min(W, t + 1); const float rc = 1.0f / (float)n;
        const f32x4 y = (s * rc - v[j + W - 1]) * sv;
        u32x2 wv; wv.x = cvt_pk_bf16(y[0], y[1]); wv.y = cvt_pk_bf16(y[2], y[3]);
        *(u32x2*)(cat + (size_t)(base + j) * DM + 4 * q) = wv; }
}
__device__ __forceinline__ void pool_finalize(const float* __restrict__ Z, const float* __restrict__ scale, bf16_t* cat, int row_begin, int nrows) {
    const int q = threadIdx.x & 255, grp = __builtin_amdgcn_readfirstlane((int)(threadIdx.x & 255) >> 6);
    for (int base = row_begin + 16 * (int)(threadIdx.x >> 8); base < row_begin + nrows; base += 32) {
        if (grp == 0) pool_rows16<2>(Z, scale, cat, base, q); else if (grp == 1) pool_rows16<4>(Z, scale, cat, base, q);
        else if (grp == 2) pool_rows16<8>(Z, scale, cat, base, q); else pool_rows16<16>(Z, scale, cat, base, q);
    }
}

#define XB_TMO      128
#define XB_XCNT(j)  (256  + 64 * (j))
#define XB_XSUB(j)  (1280 + 64 * (j))
#define XB_XGEN(j)  (2304 + 64 * (j))
#define XB_TOP      3328
#define XB_TOPGEN   3392
#define XCD_BAR_WORDS 3456
#define XB_SPIN_CAP (1u << 18)

__device__ __forceinline__ unsigned xb_ld(unsigned* p)              { return __hip_atomic_load(p, __ATOMIC_RELAXED, __HIP_MEMORY_SCOPE_AGENT); }
__device__ __forceinline__ unsigned xb_add(unsigned* p, unsigned v) { return __hip_atomic_fetch_add(p, v, __ATOMIC_RELAXED, __HIP_MEMORY_SCOPE_AGENT); }
__device__ __forceinline__ unsigned xb_xcc_id() { return (unsigned)__builtin_amdgcn_s_getreg((3 << 11) | 20) & 0xFu; }
#define XB_SPIN(cond, bar) do { unsigned _sp = 0; while (cond) { __builtin_amdgcn_s_sleep(1); \
    if ((++_sp & 255u) == 0u) { if (xb_ld(&(bar)[XB_TMO])) break; if (_sp > XB_SPIN_CAP) { atomicAdd(&(bar)[XB_TMO], 1u); break; } } } } while (0)

struct XcdBarrier {
    unsigned* bar; unsigned x;
    volatile LAS unsigned* st;
};

__device__ __forceinline__ XcdBarrier xcd_barrier_post(unsigned* bar, volatile LAS unsigned* st) {
    XcdBarrier b; b.bar = bar; b.x = xb_xcc_id(); b.st = st;
    if (threadIdx.x == 0) (void)xb_add(&bar[XB_XCNT(b.x)], 1u);
    return b;
}
__device__ __forceinline__ void xcd_barrier_complete(unsigned* bar, unsigned x, unsigned& nloc, unsigned& nx) {
    const unsigned G = gridDim.x * gridDim.y * gridDim.z;
    unsigned sum, cnt, mine, sp = 0u;
    for (;;) {
        sum = 0u; cnt = 0u; mine = 0u;
#pragma unroll
        for (unsigned j = 0; j < 16; ++j) { const unsigned c = xb_ld(&bar[XB_XCNT(j)]); sum += c; cnt += (c > 0u) ? 1u : 0u; mine = (j == x) ? c : mine; }
        if (sum == G) break;
        __builtin_amdgcn_s_sleep(1);
        if ((++sp & 255u) == 0u) { if (xb_ld(&bar[XB_TMO])) break; if (sp > XB_SPIN_CAP) { atomicAdd(&bar[XB_TMO], 1u); break; } }
    }
    nloc = mine > 0u ? mine : 1u; nx = cnt > 0u ? cnt : 1u;
}

__device__ __forceinline__ void xcd_barrier(const XcdBarrier& b) {
    asm volatile("s_waitcnt vmcnt(0)" ::: "memory");
    __syncthreads();
    if (threadIdx.x == 0) {
        unsigned* bar = b.bar;
        __builtin_amdgcn_s_waitcnt(0);
        unsigned nloc = b.st[0], nx = b.st[1];
        if (nloc == 0u) { xcd_barrier_complete(bar, b.x, nloc, nx); b.st[0] = nloc; b.st[1] = nx; }
        const unsigned old = xb_add(&bar[XB_XSUB(b.x)], 1u);
        const unsigned gen = old / nloc;
        if (old + 1u == (gen + 1u) * nloc) {
            __builtin_amdgcn_fence(__ATOMIC_RELEASE, "agent");
            asm volatile("s_waitcnt vmcnt(0)" ::: "memory");
            const unsigned og = xb_add(&bar[XB_TOP], 1u);
            const unsigned tg = og / nx;
            if (og + 1u == (tg + 1u) * nx) xb_add(&bar[XB_TOPGEN], 1u);
            else XB_SPIN(xb_ld(&bar[XB_TOPGEN]) == tg, bar);
            __builtin_amdgcn_fence(__ATOMIC_ACQUIRE, "agent");
            xb_add(&bar[XB_XGEN(b.x)], 1u);
            asm volatile("s_waitcnt vmcnt(0)" ::: "memory");
        } else {
            XB_SPIN(xb_ld(&bar[XB_XGEN(b.x)]) == gen, bar);
            __builtin_amdgcn_fence(__ATOMIC_ACQUIRE, "agent");
            asm volatile("s_waitcnt vmcnt(0)" ::: "memory");
        }
    }
    __syncthreads();
}

#ifndef REPF
#define REPF 1
#endif
struct Args { const float* in[21]; float* out; unsigned char* ws; int ph_lo, ph_hi; };
#ifndef MK_PER_PHASE
#define MK_PER_PHASE 0
#endif
__global__ void __launch_bounds__(NTHREADS, 2) hymba_fwd(Args a) {
    extern __shared__ __attribute__((aligned(16))) unsigned char lds_raw[];
    LAS unsigned char* lds = (LAS unsigned char*)lds_raw;
    unsigned* xbar_words = (unsigned*)(a.ws + 262144);
    volatile LAS unsigned* xb_st = (volatile LAS unsigned*)(lds + 131072 + 64);
    if (threadIdx.x < 2) xb_st[threadIdx.x] = 0u;
    __syncthreads();
    XcdBarrier xb = xcd_barrier_post(xbar_words, xb_st);
    unsigned* ctl = (unsigned*)(a.ws + 262144 + 16384);
#define PHASE_IDS() int tid_ = threadIdx.x; asm volatile("" : "+v"(tid_)); const int tid = tid_, lane = tid & 63, wave = __builtin_amdgcn_readfirstlane(tid >> 6); \
    const int gw = bid * 8 + wave, NGW = G * 8, gtid = bid * NTHREADS + tid, GT = G * NTHREADS; (void)lane; (void)gw; (void)NGW; (void)gtid; (void)GT;
    const int G = gridDim.x, bid = blockIdx.x;
    unsigned char* ws = a.ws;
    const float* x = a.in[0]; float* hbuf = a.out;
    bf16_t* Win_t = (bf16_t*)(ws + WS_WIN); bf16_t* Wout_t = (bf16_t*)(ws + WS_WOUT); bf16_t* Wpg_t = (bf16_t*)(ws + WS_WPG); bf16_t* Wd_t = (bf16_t*)(ws + WS_WD);
    bf16_t* Wgu_t = (bf16_t*)(ws + WS_WGU); bf16_t* Wpp_t = (bf16_t*)(ws + WS_WPP); bf16_t* poolw_t = (bf16_t*)(ws + WS_POOLW);
    bf16_t* W1k = (bf16_t*)(ws + WS_W1K); bf16_t* W1v = (bf16_t*)(ws + WS_W1V); bf16_t* W2k = (bf16_t*)(ws + WS_W2K); bf16_t* W2v = (bf16_t*)(ws + WS_W2V);
    bf16_t* PBF = (bf16_t*)(ws + WS_PBF); bf16_t* XN = (bf16_t*)(ws + WS_XN); bf16_t* T = (bf16_t*)(ws + WS_T); float* Z = (float*)(ws + WS_Z);
    float* SCR = (float*)(ws + WS_SCR); bf16_t* ACT = (bf16_t*)(ws + WS_ACT); bf16_t* PP = (bf16_t*)a.out;
    float* rowss1 = (float*)(ws + 65536); float* rowss2 = (float*)(ws + 131072); float* rowss3 = (float*)(ws + 196608); bf16_t* HB1 = (bf16_t*)(ws + WS_SCR);
    float* cosT = (float*)(ws + WS_COS); float* sinT = (float*)(ws + WS_SIN); float* gatesb = (float*)(ws + WS_GATES);
    bf16_t* kcmp = (bf16_t*)(ws + WS_KCMP); bf16_t* vcmp = (bf16_t*)(ws + WS_VCMP); float* biasp = (float*)(ws + WS_BIASK);

#ifndef SKIP_P0
#ifndef REP0
#define REP0 1
#endif
    if (a.ph_lo <= 0 && 0 < a.ph_hi) for (int rep0 = 0; rep0 < REP0; ++rep0) {
        if (rep0) xcd_barrier(xb);
    {
        PHASE_IDS();
        LAS float* scr = (LAS float*)(lds + wave * 16384);
        constexpr int I_IN = 32 * 120, I_SQ = 32 * 64, I_GU = 32 * 176, I_DN = 88 * 64, I_PP = 4 * 64, I_PW = 4 * 8, I_W1 = 64 * 4, I_W2 = 2 * 4;
        constexpr int NITEMS = I_IN + 2 * I_SQ + 2 * I_GU + I_DN + I_PP + 4 * I_PW + 2 * I_W1 + 2 * I_W2;
        for (int it = gw; it < NITEMS; it += NGW) {
            int r = it; const float* Wsrc; const float* gain = nullptr; bf16_t* dst; int Kk, Nn, nv, nblk, mode = 0;
            if (r < I_GU) { Wsrc = a.in[14]; Kk = DM; Nn = DFF; nv = DFF; nblk = 176; dst = Wgu_t; mode = 1; gain = a.in[13]; }
            else if ((r -= I_GU) < I_GU) { Wsrc = a.in[15]; Kk = DM; Nn = DFF; nv = DFF; nblk = 176; dst = Wgu_t; mode = 2; gain = a.in[13]; }
            else if ((r -= I_GU) < I_DN) { Wsrc = a.in[16]; Kk = DFF; Nn = DM; nv = DM; nblk = 64; dst = Wd_t; }
            else if ((r -= I_DN) < I_IN) { Wsrc = a.in[3]; Kk = DM; Nn = INW; nv = INW; nblk = 120; dst = Win_t; }
            else if ((r -= I_IN) < I_SQ) { Wsrc = a.in[12]; Kk = DM; Nn = DM; nv = DM; nblk = 64; dst = Wout_t; }
            else if ((r -= I_SQ) < I_SQ) { Wsrc = a.in[18]; Kk = DM; Nn = DM; nv = DM; nblk = 64; dst = Wpg_t; gain = a.in[17]; }
            else if ((r -= I_SQ) < I_PP) { Wsrc = a.in[19]; Kk = PLE; Nn = DM; nv = DM; nblk = 64; dst = Wpp_t; }
            else if ((r -= I_PP) < 4 * I_PW) { const int gq = r / I_PW; r -= gq * I_PW; Wsrc = a.in[4] + gq * 65536; Kk = 256; Nn = 256; nv = 256; nblk = 8; dst = poolw_t + gq * 65536; }
            else if ((r -= 4 * I_PW) < I_W1) { Wsrc = a.in[7]; Kk = 4096; Nn = 128; nv = 128; nblk = 4; dst = W1k; }
            else if ((r -= I_W1) < I_W1) { Wsrc = a.in[10]; Kk = 4096; Nn = 128; nv = 128; nblk = 4; dst = W1v; }
            else if ((r -= I_W1) < I_W2) { Wsrc = a.in[8]; Kk = 128; Nn = 128; nv = 128; nblk = 4; dst = W2k; }
            else { r -= I_W2; Wsrc = a.in[11]; Kk = 128; Nn = 128; nv = 128; nblk = 4; dst = W2v; }
            const int grp = r >> 3, wq = r & 7, gpr = nblk >> 2, gkb = grp / gpr, gnb = grp - gkb * gpr; const int kb = gkb * 2 + (wq >> 2), nb = gnb * 4 + (wq & 3), n0 = nb * 32;
            const int drow = mode == 0 ? n0 : ((n0 >> 7) * 256 + (n0 & 127) + (mode == 2 ? 128 : 0));
            tr_item(Wsrc, Kk, Nn, nv, dst, drow, scr, kb * 64, n0, lane, gain);
        }
        for (int m = gw; m < MROWS; m += NGW) rms_row<true>(x + (size_t)m * DM, a.in[2], XN + (size_t)m * DM, lane);
        for (int i = gtid; i < MROWS * PLE / 4; i += GT) { const f32x4 v = ((const f32x4*)a.in[1])[i]; u32x2 w; w.x = cvt_pk_bf16(v[0], v[1]); w.y = cvt_pk_bf16(v[2], v[3]); ((u32x2*)PBF)[i] = w; }
        for (int i = gtid; i < 3 * MROWS; i += GT) { if (i < MROWS) rowss1[i] = 0.f; else if (i < 2 * MROWS) rowss2[i - MROWS] = 0.f; else rowss3[i - 2 * MROWS] = 0.f; }
        for (int i = (G == 256 ? (tid < 128 ? bid * 128 + tid : SEQ * 16) : gtid); i < SEQ * 16; i += GT) { const int pos = i >> 4, fi = i & 15; const float inv = exp2f(-(float)fi * (18.931568569324174f / 16.f)); const float ang = (float)pos * inv;
            cosT[i] = cosf(ang); sinT[i] = sinf(ang); }
        __syncthreads();
        for (int tsk = (G == 256 ? bid - 192 : bid); tsk < 64; tsk += G) { if (tsk < 0) break;
            const int kv = tsk >> 5, l = tsk & 31; const float* pe = a.in[kv == 0 ? 6 : 9] + l * 128; const float* w1 = a.in[kv == 0 ? 7 : 10] + (size_t)l * 128 * 128;
            const int cc = tid & 127, part = tid >> 7; float s = 0.f;
#pragma unroll 8
            for (int k = part * 32; k < part * 32 + 32; ++k) s += pe[k] * w1[(size_t)k * 128 + cc];
            LAS float* red = (LAS float*)lds; red[part * 128 + cc] = s; __syncthreads();
            if (tid < 128) biasp[(size_t)tsk * 128 + tid] = (red[tid] + red[128 + tid]) + (red[256 + tid] + red[384 + tid]);
            __syncthreads();
        }
    }
    }
#endif
    if (a.ph_lo <= 0 && 1 < a.ph_hi) xcd_barrier(xb);
#ifndef SKIP_P1
#ifndef REP1
#define REP1 1
#endif
    if (a.ph_lo <= 1 && 1 < a.ph_hi) for (int rep1 = 0; rep1 < REP1; ++rep1) {
        if (rep1) xcd_barrier(xb);
    {
        pg8::Gemm g{XN, Win_t, MROWS, INWP, DM}; pg8::StaticOrder S; S.init(MROWS, INWP, G, bid);
        EpiInProj E{T, gatesb, cosT, sinT};
        pg8::gemm_phase<EpiInProj, pg8::StaticOrder, true, true>(lds, g, S, E);
    }
    }
#endif
    if (a.ph_lo <= 1 && 2 < a.ph_hi) xcd_barrier(xb);
#ifndef SKIP_P2
#ifndef REP2
#define REP2 1
#endif
    if (a.ph_lo <= 2 && 2 < a.ph_hi) for (int rep2 = 0; rep2 < REP2; ++rep2) {
        if (rep2) xcd_barrier(xb);
    {
        pg8::Gemm g{T, poolw_t, 4 * MROWS, 1024, 256}; PoolOrder S{G, bid}; EpiPoolZ E{Z};
        pg8::gemm_phase<EpiPoolZ, PoolOrder, true, true>(lds, g, S, E);
        signal_done<false>(ctl + 64, bid < 128 ? (unsigned)((127 - bid) / G + 1) : 0u);
        unsigned njobs = 0;
        for (int job = G - 1 - bid; job < 128; job += G) {
            const int kv = job >> 6, b = (job >> 4) & 3, gg = (job >> 3) & 1, n0 = (job & 7) * 16;
            compress_job(lds, T + (size_t)(8 + kv) * TS, kv ? W1v : W1k, kv ? W2v : W2k, biasp + (size_t)kv * 32 * 128, kv ? vcmp : kcmp, b, gg, n0);
            ++njobs;
        }
        signal_done<false>(ctl, njobs);
    }
    }
#endif
#ifndef SKIP_P3
#ifndef REP3
#define REP3 1
#endif
    if (a.ph_lo <= 3 && 3 < a.ph_hi) for (int rep3 = 0; rep3 < REP3; ++rep3) {
        if (rep3) xcd_barrier(xb);
    {
        bf16_t* CAT = XN;
        for (int u = bid; u < 256; u += G) { const int bg = u & 7, c = (u < 128) ? 16 + (u >> 3) : 15 - ((u - 128) >> 3); att::attn_unit(lds, T, kcmp, vcmp, gatesb, SCR, hbuf, CAT, bg >> 1, bg & 1, c, ctl); }
        wait_count(ctl + 64, 128u);
        { const int per = (MROWS + G - 1) / G; const int r0 = bid * per; const int nr = min(per, MROWS - r0); if (nr > 0) for (int repf = 0; repf < REPF; ++repf) pool_finalize(Z, a.in[5], CAT, r0, nr); }
    }
    }
#endif
    if (a.ph_lo <= 3 && 4 < a.ph_hi) xcd_barrier(xb);
#ifndef SKIP_P4
    if (a.ph_lo <= 4 && 4 < a.ph_hi) {
    {
        pg8::Gemm g{XN, Wout_t, MROWS, DM, DM}; pg8::StaticOrder S; S.init(MROWS, DM, G, bid); EpiResidNorm E{x, nullptr, HB1, rowss1};
        pg8::gemm_phase<EpiResidNorm, pg8::StaticOrder, true, true>(lds, g, S, E);
    }
    }
#endif
    if (a.ph_lo <= 4 && 5 < a.ph_hi) xcd_barrier(xb);
#ifndef SKIP_P5
    if (a.ph_lo <= 5 && 5 < a.ph_hi) {
    { }
    }
#endif
#ifndef SKIP_P6
#ifndef REP6
#define REP6 1
#endif
    if (a.ph_lo <= 6 && 6 < a.ph_hi) for (int rep6 = 0; rep6 < REP6; ++rep6) {
        if (rep6) xcd_barrier(xb);
    {
        pg8::Gemm g{HB1, Wgu_t, MROWS, 2 * DFF, DM}; pg8::StaticOrder S; S.init(MROWS, 2 * DFF, G, bid); EpiSwiglu E{ACT, rowss1};
        pg8::gemm_phase<EpiSwiglu, pg8::StaticOrder, true, true>(lds, g, S, E);
        if (G == 256) {
            pg8::Gemm g2{PBF, Wpp_t, MROWS, DM, PLE}; UpperOrder S2; S2.S.init(MROWS, DM, 1, 0); S2.lo = 128; S2.nup = 128; S2.c = bid; EpiStoreBf16 E2{PP, DM};
            pg8::gemm_phase<EpiStoreBf16, UpperOrder, true, true>(lds, g2, S2, E2);
        } else { pg8::Gemm g2{PBF, Wpp_t, MROWS, DM, PLE}; pg8::StaticOrder S2; S2.init(MROWS, DM, G, bid); EpiStoreBf16 E2{PP, DM}; pg8::gemm_phase<EpiStoreBf16, pg8::StaticOrder, true, true>(lds, g2, S2, E2); }
    }
    }
#endif
    if (a.ph_lo <= 6 && 7 < a.ph_hi) xcd_barrier(xb);
#ifndef SKIP_P7
    if (a.ph_lo <= 7 && 7 < a.ph_hi) {
    {
        pg8::Gemm g{ACT, Wd_t, MROWS, DM, DFF}; pg8::StaticOrder S; S.init(MROWS, DM, G, bid); EpiResidNorm E{nullptr, HB1, XN, rowss2};
        pg8::gemm_phase<EpiResidNorm, pg8::StaticOrder, true, true>(lds, g, S, E);
    }
    }
#endif
    if (a.ph_lo <= 7 && 8 < a.ph_hi) xcd_barrier(xb);
#ifndef SKIP_P8
    if (a.ph_lo <= 8 && 8 < a.ph_hi) {
    {
    }
    }
#endif
    __syncthreads();
#ifndef SKIP_P9
    if (a.ph_lo <= 9 && 9 < a.ph_hi) {
    {
        pg8::Gemm g{XN, Wpg_t, MROWS, DM, DM}; pg8::StaticOrder S; S.init(MROWS, DM, G, bid); EpiPle E{XN, PP, rowss2, HB1, rowss3};
        pg8::gemm_phase<EpiPle, pg8::StaticOrder, true, true>(lds, g, S, E);
    }
    }
#endif
    if (a.ph_lo <= 9 && 10 < a.ph_hi) xcd_barrier(xb);
#ifdef EXTRA_SYNCS
    for (int es = 0; es < EXTRA_SYNCS; ++es) xcd_barrier(xb);
#endif
#ifndef SKIP_P10
    if (a.ph_lo <= 10 && 10 < a.ph_hi) {
#ifdef DBG_STOP
        { PHASE_IDS(); const bf16_t* dbg = (const bf16_t*)(ws + (size_t)DBG_OFF * MiB);
          for (size_t i = gtid; i < (size_t)MROWS * DM; i += GT) {
#ifdef DBG_NANDET
              const float bv = __uint_as_float((unsigned)((const bf16_t*)(ws + WS_KCMP))[i % 131072] << 16); const float wv = __uint_as_float((unsigned)((const bf16_t*)(ws + WS_VCMP))[i % 131072] << 16);
              const bool bad1 = !(fabsf(bv) < 1e30f), bad2 = !(fabsf(wv) < 1e30f);
              hbuf[i] = x[i] + (bad1 ? 1000.f : 0.f) + (bad2 ? 3000.f : 0.f);
#else
              float dv = __uint_as_float((unsigned)dbg[i % ((size_t)DBG_ELEMS)] << 16); if (!(fabsf(dv) < 1e30f)) dv = 1000.f; hbuf[i] = x[i] + DBG_SCALE * dv;
#endif
          } }
        xcd_barrier(xb);
#endif
    { PHASE_IDS();
      for (int m = gw; m < MROWS; m += NGW) { const float rstd = 1.0f / sqrtf(rowss3[m] * (1.f / DM) + 1e-6f); const u32x2* hr = (const u32x2*)(HB1 + (size_t)m * DM); f32x4* orow = (f32x4*)(hbuf + (size_t)m * DM);
#pragma unroll
          for (int j = 0; j < 8; ++j) { const u32x2 w = hr[lane + 64 * j]; const f32x4 gv = ((const f32x4*)a.in[20])[lane + 64 * j];
              const f32x4 v = {__uint_as_float(w.x << 16), __uint_as_float(w.x & 0xffff0000u), __uint_as_float(w.y << 16), __uint_as_float(w.y & 0xffff0000u)};
              orow[lane + 64 * j] = v * rstd * gv; } } }
    }
#endif
}

extern "C" void kernel_launch(void* const* d_in, const int* in_sizes, int n_in, void* d_out, int out_size, void* d_ws, size_t ws_size, hipStream_t stream) {
    static int grid = 0;
    if (grid == 0) {
        if (n_in != 21 || in_sizes[0] != MROWS * DM || out_size != MROWS * DM || ws_size < WS_END) {
            fprintf(stderr, "kernel_launch: unexpected shapes (n_in %d, in0 %d, out %d, ws %zu < %zu)\n", n_in, n_in > 0 ? in_sizes[0] : -1, out_size, ws_size, (size_t)WS_END); grid = -1; return; }
        int dev = 0, cus = 0, per_cu = 0;
        hipGetDevice(&dev); hipDeviceGetAttribute(&cus, hipDeviceAttributeMultiprocessorCount, dev);
        if (hipFuncSetAttribute((const void*)hymba_fwd, hipFuncAttributeMaxDynamicSharedMemorySize, LDS_BYTES) != hipSuccess) { fprintf(stderr, "kernel_launch: hipFuncSetAttribute failed\n"); grid = -1; return; }
        if (hipOccupancyMaxActiveBlocksPerMultiprocessor(&per_cu, (const void*)hymba_fwd, NTHREADS, LDS_BYTES) != hipSuccess || per_cu < 1) { fprintf(stderr, "kernel_launch: occupancy query failed (%d)\n", per_cu); grid = -1; return; }
        grid = cus * per_cu;
        fprintf(stderr, "kernel_launch: %d CUs x %d blocks/CU -> grid %d\n", cus, per_cu, grid);
    }
    if (grid < 0) return;
    Args a{};
    for (int i = 0; i < 21; ++i) a.in[i] = (const float*)d_in[i];
    a.out = (float*)d_out; a.ws = (unsigned char*)d_ws;
#if MK_PER_PHASE
    hipError_t e = hipSuccess;
#ifdef DBG_STOP
    for (int k = 0; k <= DBG_STOP; ++k) { a.ph_lo = k; a.ph_hi = k + 1; hipLaunchKernelGGL(hymba_fwd, dim3(grid), dim3(NTHREADS), LDS_BYTES, stream, a); }
    { a.ph_lo = 10; a.ph_hi = 11; void* args[] = {&a}; (void)hipLaunchCooperativeKernel((const void*)hymba_fwd, dim3(grid), dim3(NTHREADS), args, LDS_BYTES, stream); }
#else
    for (int k = 0; k < 11; ++k) { a.ph_lo = k; a.ph_hi = k + 1; hipLaunchKernelGGL(hymba_fwd, dim3(grid), dim3(NTHREADS), LDS_BYTES, stream, a); }
#endif
    e = hipPeekAtLastError();
#else
    a.ph_lo = 0; a.ph_hi = 11;
    if (hipMemsetAsync((char*)d_ws + 262144, 0, 32768, stream) != hipSuccess) { fprintf(stderr, "kernel_launch: hipMemsetAsync failed\n"); return; }
    void* args[] = {&a};
    hipError_t e = hipLaunchCooperativeKernel((const void*)hymba_fwd, dim3(grid), dim3(NTHREADS), args, LDS_BYTES, stream);
#endif
    if (e != hipSuccess) fprintf(stderr, "kernel_launch: cooperative launch failed: %s (grid %d)\n", hipGetErrorString(e), grid);
}
```

```cpp
#include <hip/hip_runtime.h>
#include <cstdio>
#include <cstdint>
#include <cmath>
#define ATT_NOANY 1
namespace pg8 {
#define PG8_LAS __attribute__((address_space(3)))
typedef unsigned short bf16_t;
typedef short bf16x8 __attribute__((ext_vector_type(8)));
typedef float f32x4 __attribute__((ext_vector_type(4)));
typedef unsigned u32x4 __attribute__((ext_vector_type(4)));
constexpr int BM = 256, BK = 64, HALF = 128, HTB = HALF * BK * 2  , STAGE_BYTES = 8 * HTB, NXCD = 8, WGM = 8;

__host__ __device__ __forceinline__ int lds_byte(int r, int c) { const int st = (r >> 4) * 2 + (c >> 5), rr = r & 15, cc = c & 31, ob = rr * 64 + cc * 2; return st * 1024 + (ob ^ (((ob >> 9) & 1) << 5)); }
__host__ __device__ __forceinline__ void stage_rc(int b, int& R, int& C) { const int st = b / 1024, sb = b % 1024, swz = sb ^ (((sb >> 9) & 1) << 5); R = (st >> 1) * 16 + swz / 64; C = (st & 1) * 32 + (swz % 64) / 2; }
__host__ __device__ __forceinline__ int perm32(int rho) { const int n = rho >> 4, i = rho & 15; return 8 * (i >> 2) + 4 * n + (i & 3); }

struct Unit { int pm, pn; };
struct Gemm { const bf16_t* A; const bf16_t* Bt; int M, N, K; };

struct StaticOrder {
    int nM, nN, nwg, G, c;
    __host__ __device__ void init(int M, int N, int G_, int c_) { nM = M / BM; nN = N / BM; nwg = nM * nN; G = G_; c = c_; }
    __host__ __device__ bool next(int i, Unit& u) const {
        const long L = (long)i * G + c; if (L >= nwg) return false;
        int wgid = (int)L; { const int q = nwg / NXCD, r = nwg % NXCD, xcd = wgid % NXCD, off = wgid / NXCD; wgid = (xcd < r ? xcd * (q + 1) : r * (q + 1) + (xcd - r) * q) + off; }
        const int nig = WGM * nN, gid = wgid / nig, fm = gid * WGM, gsz = (nM - fm) < WGM ? (nM - fm) : WGM;
        u.pm = fm + ((wgid % nig) % gsz); u.pn = (wgid % nig) / gsz; return true;
    }
    __host__ __device__ bool next_linear(long L, Unit& u) const {
        if (L >= nwg) return false;
        int wgid = (int)L; { const int q = nwg / NXCD, r = nwg % NXCD, xcd = wgid % NXCD, off = wgid / NXCD; wgid = (xcd < r ? xcd * (q + 1) : r * (q + 1) + (xcd - r) * q) + off; }
        const int nig = WGM * nN, gid = wgid / nig, fm = gid * WGM, gsz = (nM - fm) < WGM ? (nM - fm) : WGM;
        u.pm = fm + ((wgid % nig) % gsz); u.pn = (wgid % nig) / gsz; return true;
    }
    __device__ __forceinline__ void a_ready(const Unit&) const {}
    __device__ __forceinline__ void done(const Unit&) const {}
};

typedef float f32x2_cv __attribute__((ext_vector_type(2))); typedef __bf16 bf16x2_cv __attribute__((ext_vector_type(2)));
__device__ __forceinline__ unsigned cvt_pk_bf16(float lo, float hi) { f32x2_cv v = {lo, hi}; bf16x2_cv b = __builtin_convertvector(v, bf16x2_cv); return __builtin_bit_cast(unsigned, b); }
template <class Epi, class Sched, bool ALIGN_EPI = false, bool SP2 = false>
__device__ __forceinline__ void gemm_phase(PG8_LAS unsigned char* lds, const Gemm g, const Sched& S, const Epi& E) {
    int tid_ = threadIdx.x; asm volatile("" : "+v"(tid_));
    const int tid = tid_, wid = __builtin_amdgcn_readfirstlane(tid >> 6), lane = tid & 63, wr = wid >> 2, wc = wid & 3, fr = lane & 15, fq = lane >> 4;
    const int K = g.K, nt = K / BK;
    unsigned voffA[2], voffB[2];
#pragma unroll
    for (int i = 0; i < 2; ++i) { int R, C; stage_rc(tid * 16 + i * 8192, R, C); const int Rb = Epi::PERM ? ((R & ~31) + perm32(R & 31)) : R;
        voffA[i] = (unsigned)(R * K + C) * 2u; voffB[i] = (unsigned)(Rb * K + C) * 2u; }
    const size_t kstep = (size_t)(BK * 2);
    const size_t hstep = (size_t)HALF * K * 2;
    const size_t tstep = 2 * hstep;
    const unsigned ldsw = (unsigned)wid * 1024u;
    const int aoff = lds_byte(wr * 64 + fr, fq * 8), boff = lds_byte(wc * 32 + fr, fq * 8);
#define PG8_SA(b, h) (((b) * 2 + (h)) * HTB)
#define PG8_SB(b, h) ((4 + (b) * 2 + (h)) * HTB)
#define PG8_STAGE(bufoff, gbase, voff) do { _Pragma("unroll") for (int _i = 0; _i < 2; ++_i) \
        __builtin_amdgcn_global_load_lds((const unsigned*)((const char*)(gbase) + (voff)[_i]), (PG8_LAS unsigned*)(lds + (bufoff) + ldsw + _i * 8192), 16, 0, 0); } while (0)
#define PG8_LDA(dst, b, h) do { _Pragma("unroll") for (int m = 0; m < 4; ++m) _Pragma("unroll") for (int k = 0; k < 2; ++k) dst[m][k] = *(const PG8_LAS bf16x8*)(lds + PG8_SA(b, h) + aoff + m * 2048 + k * 1024); } while (0)
#define PG8_LDB(dst, b, h) do { _Pragma("unroll") for (int n = 0; n < 2; ++n) _Pragma("unroll") for (int k = 0; k < 2; ++k) dst[n][k] = *(const PG8_LAS bf16x8*)(lds + PG8_SB(b, h) + boff + n * 2048 + k * 1024); } while (0)
#define PG8_MMA(ai, bj, At, Bt) do { __builtin_amdgcn_s_setprio(1); _Pragma("unroll") for (int m = 0; m < 4; ++m) _Pragma("unroll") for (int n = 0; n < 2; ++n) _Pragma("unroll") for (int k = 0; k < 2; ++k) \
        acc[ai][bj][m][n] = __builtin_amdgcn_mfma_f32_16x16x32_bf16(Bt[n][k], At[m][k], acc[ai][bj][m][n], 0, 0, 0); __builtin_amdgcn_s_setprio(0); } while (0)
#define PG8_WAIT_V(n) asm volatile("s_waitcnt vmcnt(" #n ")" ::: "memory")
#define PG8_WAIT_L(n) asm volatile("s_waitcnt lgkmcnt(" #n ")" ::: "memory")
#define PG8_BAR __builtin_amdgcn_s_barrier()
#define PG8_SCHED __builtin_amdgcn_sched_barrier(0)
    Unit cur, nxt; int ui = 0;
    if (!S.next(0, cur)) return;
    f32x4 acc[2][2][4][2];
#pragma unroll
    for (int a = 0; a < 2; ++a)
#pragma unroll
        for (int b = 0; b < 2; ++b)
#pragma unroll
            for (int m = 0; m < 4; ++m)
#pragma unroll
                for (int n = 0; n < 2; ++n) acc[a][b][m][n] = (f32x4){0.f, 0.f, 0.f, 0.f};
    bf16x8 At[4][2], B0[2][2], B1[2][2];
    const char* cA = (const char*)g.A + (size_t)cur.pm * tstep; const char* cB = (const char*)g.Bt + (size_t)cur.pn * tstep;
    S.a_ready(cur);
    if constexpr (SP2) {
        PG8_STAGE(PG8_SB(0, 0), cB, voffB); PG8_STAGE(PG8_SB(0, 1), cB + hstep, voffB); PG8_STAGE(PG8_SA(0, 0), cA, voffA); PG8_STAGE(PG8_SA(0, 1), cA + hstep, voffA);
        if (wr == 1) PG8_BAR;
        PG8_WAIT_V(2); PG8_BAR;
        PG8_STAGE(PG8_SB(1, 0), cB + kstep, voffB); PG8_STAGE(PG8_SA(1, 0), cA + kstep, voffA); PG8_STAGE(PG8_SB(1, 1), cB + hstep + kstep, voffB);
        PG8_WAIT_V(6); PG8_BAR;
    } else {
        PG8_STAGE(PG8_SB(0, 0), cB, voffB); PG8_STAGE(PG8_SA(0, 0), cA, voffA); PG8_STAGE(PG8_SB(0, 1), cB + hstep, voffB); PG8_STAGE(PG8_SA(0, 1), cA + hstep, voffA);
        if (wr == 1) PG8_BAR;
        PG8_WAIT_V(4); PG8_BAR;
        PG8_STAGE(PG8_SB(1, 0), cB + kstep, voffB); PG8_STAGE(PG8_SA(1, 0), cA + kstep, voffA); PG8_STAGE(PG8_SB(1, 1), cB + hstep + kstep, voffB);
        PG8_WAIT_V(6); PG8_BAR;
    }
    for (;;) {
        const bool has_next = S.next(ui + 1, nxt);
        const char* nA = has_next ? (const char*)g.A + (size_t)nxt.pm * tstep : cA; const char* nB = has_next ? (const char*)g.Bt + (size_t)nxt.pn * tstep : cB;
        for (int t = 0; t < nt; t += 2) {
            const bool last = (t == nt - 2);
            const char* a1 = cA + (size_t)(t + 1) * kstep;
            const char* a2 = last ? nA : cA + (size_t)(t + 2) * kstep; const char* b2 = last ? nB : cB + (size_t)(t + 2) * kstep;
            const char* a3 = a2 + kstep; const char* b3 = b2 + kstep;
            if (last && has_next) S.a_ready(nxt);
            if constexpr (SP2) {
            PG8_LDB(B0, 0, 0); PG8_LDB(B1, 0, 1); PG8_SCHED; PG8_LDA(At, 0, 0); PG8_STAGE(PG8_SA(1, 1), a1 + hstep, voffA);
            PG8_WAIT_V(8); PG8_WAIT_L(0); PG8_BAR; PG8_MMA(0, 0, At, B0); PG8_MMA(0, 1, At, B1); PG8_BAR; PG8_SCHED;
            PG8_LDA(At, 0, 1); PG8_STAGE(PG8_SB(0, 0), b2, voffB); PG8_STAGE(PG8_SB(0, 1), b2 + hstep, voffB); PG8_STAGE(PG8_SA(0, 0), a2, voffA);
            PG8_WAIT_V(8); PG8_WAIT_L(0); PG8_BAR; PG8_MMA(1, 0, At, B0); PG8_MMA(1, 1, At, B1); PG8_BAR; PG8_SCHED;
            PG8_LDB(B0, 1, 0); PG8_LDB(B1, 1, 1); PG8_SCHED; PG8_LDA(At, 1, 0); PG8_STAGE(PG8_SA(0, 1), a2 + hstep, voffA);
            PG8_WAIT_V(8); PG8_WAIT_L(0); PG8_BAR; PG8_MMA(0, 0, At, B0); PG8_MMA(0, 1, At, B1); PG8_BAR; PG8_SCHED;
            PG8_LDA(At, 1, 1); PG8_STAGE(PG8_SB(1, 0), b3, voffB); PG8_STAGE(PG8_SB(1, 1), b3 + hstep, voffB); PG8_STAGE(PG8_SA(1, 0), a3, voffA);
            PG8_WAIT_V(8); PG8_WAIT_L(0); PG8_BAR; PG8_MMA(1, 0, At, B0); PG8_MMA(1, 1, At, B1); PG8_BAR; PG8_SCHED;
            } else {
            PG8_LDB(B0, 0, 0); PG8_SCHED; PG8_LDA(At, 0, 0); PG8_STAGE(PG8_SA(1, 1), a1 + hstep, voffA);
            PG8_WAIT_L(8); PG8_BAR; PG8_WAIT_L(0); PG8_MMA(0, 0, At, B0); PG8_BAR; PG8_SCHED;
            PG8_LDB(B1, 0, 1); PG8_STAGE(PG8_SB(0, 0), b2, voffB);
            PG8_BAR; PG8_WAIT_L(0); PG8_MMA(0, 1, At, B1); PG8_BAR;
            PG8_LDA(At, 0, 1); PG8_STAGE(PG8_SA(0, 0), a2, voffA);
            PG8_BAR; PG8_WAIT_L(0); PG8_MMA(1, 0, At, B0); PG8_BAR; PG8_SCHED;
            PG8_STAGE(PG8_SB(0, 1), b2 + hstep, voffB);
            PG8_WAIT_V(6); PG8_BAR; PG8_MMA(1, 1, At, B1); PG8_BAR;
            PG8_LDB(B0, 1, 0); PG8_SCHED; PG8_LDA(At, 1, 0); PG8_STAGE(PG8_SA(0, 1), a2 + hstep, voffA);
            PG8_WAIT_L(8); PG8_BAR; PG8_WAIT_L(0); PG8_MMA(0, 0, At, B0); PG8_BAR; PG8_SCHED;
            PG8_LDB(B1, 1, 1); PG8_STAGE(PG8_SB(1, 0), b3, voffB);
            PG8_BAR; PG8_WAIT_L(0); PG8_MMA(0, 1, At, B1); PG8_BAR;
            PG8_LDA(At, 1, 1); PG8_STAGE(PG8_SA(1, 0), a3, voffA);
            PG8_BAR; PG8_WAIT_L(0); PG8_MMA(1, 0, At, B0); PG8_BAR; PG8_SCHED;
            PG8_STAGE(PG8_SB(1, 1), b3 + hstep, voffB);
            PG8_WAIT_V(6); PG8_BAR; PG8_MMA(1, 1, At, B1); PG8_BAR;
            }
        }
        if constexpr (ALIGN_EPI) { if (wr == 0) PG8_BAR; }
        if constexpr (!Epi::AFTER_DRAIN) { E(acc, cur, wr, wc, fr, fq); S.done(cur); }
        if (!has_next) break;
#pragma unroll
        for (int a = 0; a < 2; ++a)
#pragma unroll
            for (int b = 0; b < 2; ++b)
#pragma unroll
                for (int m = 0; m < 4; ++m)
#pragma unroll
                    for (int n = 0; n < 2; ++n) acc[a][b][m][n] = (f32x4){0.f, 0.f, 0.f, 0.f};
        cur = nxt; cA = nA; cB = nB; ++ui;
        if constexpr (ALIGN_EPI) { if (wr == 1) PG8_BAR; }
    }
    PG8_WAIT_V(0);
    if constexpr (!ALIGN_EPI) { if (wr == 0) PG8_BAR; }
    PG8_BAR;
    if constexpr (Epi::AFTER_DRAIN) { E.fused(acc, cur, wr, wc, fr, fq, lds, wid, lane); S.done(cur); }
#undef PG8_SA
#undef PG8_SB
#undef PG8_STAGE
#undef PG8_LDA
#undef PG8_LDB
#undef PG8_MMA
#undef PG8_WAIT_V
#undef PG8_WAIT_L
#undef PG8_BAR
#undef PG8_SCHED
}
}

using pg8::bf16_t; using pg8::bf16x8; using pg8::f32x4; using pg8::u32x4; using pg8::Unit; using pg8::cvt_pk_bf16;
#define LAS __attribute__((address_space(3)))
typedef short s16x4 __attribute__((ext_vector_type(4)));
typedef float f32x16 __attribute__((ext_vector_type(16)));
typedef unsigned u32x2 __attribute__((ext_vector_type(2)));

constexpr int DM = 2048, SEQ = 2048, MROWS = 8192, PLE = 256, INW = 3608, INWP = 3840, DFF = 5632;
constexpr int NTHREADS = 512;
constexpr size_t MiB = (size_t)1 << 20;
constexpr size_t TS = (size_t)MROWS * 256;
constexpr size_t WS_BIASK = 0, WS_BIASV = 512;
constexpr size_t WS_COS = 1 * MiB, WS_SIN = 1 * MiB + 131072, WS_GATES = 1 * MiB + 262144;
constexpr size_t WS_KCMP = 2 * MiB, WS_VCMP = 2 * MiB + 262144, WS_W2K = 2 * MiB + 524288, WS_W2V = WS_W2K + 32768;
constexpr size_t WS_W1K = 3 * MiB, WS_W1V = 4 * MiB, WS_POOLW = 5 * MiB, WS_WPP = 6 * MiB, WS_WIN = 7 * MiB, WS_WOUT = 22 * MiB;
constexpr size_t WS_WPG = 30 * MiB, WS_WD = 38 * MiB, WS_WGU = 60 * MiB, WS_PBF = 104 * MiB, WS_XN = 108 * MiB;
constexpr size_t WS_T = 140 * MiB, WS_Z = 196 * MiB, WS_SCR = 228 * MiB, WS_ACT = 140 * MiB, WS_PP = 140 * MiB, WS_END = 260 * MiB;
constexpr int LDS_BYTES = 147456;

#define LDS_WAIT() asm volatile("s_waitcnt lgkmcnt(0)" ::: "memory")
__device__ __forceinline__ float wave_sum(float v) {
#pragma unroll
    for (int o = 1; o < 64; o <<= 1) v += __shfl_xor(v, o);
    return v;
}
__device__ __forceinline__ float sigmoidf_(float x) { return __builtin_amdgcn_rcpf(1.f + __expf(-x)); }

struct EpiInProj {
    static constexpr bool PERM = true, AFTER_DRAIN = false;
    bf16_t* T; float* gates; const float* cosT; const float* sinT;
    __device__ __forceinline__ void operator()(const f32x4 (&acc)[2][2][4][2], const Unit& u, int wr, int wc, int fr, int fq) const {
        const int pn = u.pn; const int row0 = u.pm * 256 + wr * 64 + fr;
        if (pn < 14) {
            const bool rope = (wc == 0) && (pn >= 4) && (pn < 8 || ((pn & 1) == 0));
            bf16_t* base = T + (size_t)pn * TS;
#pragma unroll
            for (int ai = 0; ai < 2; ++ai)
#pragma unroll
                for (int m = 0; m < 4; ++m) {
                    const int row = row0 + ai * 128 + m * 16; const int pos = row & (SEQ - 1);
                    f32x4 cs0 = {1.f, 1.f, 1.f, 1.f}, cs1 = cs0, sn0 = {0.f, 0.f, 0.f, 0.f}, sn1 = sn0;
                    if (rope) { const float* ct = cosT + pos * 16 + 8 * (fq & 1); const float* st = sinT + pos * 16 + 8 * (fq & 1);
                        cs0 = *(const f32x4*)ct; cs1 = *(const f32x4*)(ct + 4); sn0 = *(const f32x4*)st; sn1 = *(const f32x4*)(st + 4);
                        if (fq < 2) { sn0 = -sn0; sn1 = -sn1; } }
#pragma unroll
                    for (int bj = 0; bj < 2; ++bj) {
                        f32x4 v0 = acc[ai][bj][m][0], v1 = acc[ai][bj][m][1];
                        if (rope) { f32x4 o0, o1;
#pragma unroll
                            for (int j = 0; j < 4; ++j) { o0[j] = __shfl_xor(v0[j], 32); o1[j] = __shfl_xor(v1[j], 32); }
                            v0 = v0 * cs0 + o0 * sn0; v1 = v1 * cs1 + o1 * sn1; }
                        u32x4 w; w.x = cvt_pk_bf16(v0[0], v0[1]); w.y = cvt_pk_bf16(v0[2], v0[3]); w.z = cvt_pk_bf16(v1[0], v1[1]); w.w = cvt_pk_bf16(v1[2], v1[3]);
                        *(u32x4*)(base + (size_t)row * 256 + bj * 128 + wc * 32 + 8 * fq) = w;
                    }
                }
        } else if (wc == 0 && fq < 3) {
#pragma unroll
            for (int ai = 0; ai < 2; ++ai)
#pragma unroll
                for (int m = 0; m < 4; ++m) {
                    const int row = row0 + ai * 128 + m * 16;
                    const f32x4 v0 = acc[ai][0][m][0], v1 = acc[ai][0][m][1];
                    const f32x4 s0 = {sigmoidf_(v0[0]), sigmoidf_(v0[1]), sigmoidf_(v0[2]), sigmoidf_(v0[3])}, s1 = {sigmoidf_(v1[0]), sigmoidf_(v1[1]), sigmoidf_(v1[2]), sigmoidf_(v1[3])};
                    *(f32x4*)(gates + (size_t)row * 24 + 8 * fq) = s0; *(f32x4*)(gates + (size_t)row * 24 + 8 * fq + 4) = s1;
                }
        }
    }
};
struct PoolOrder {
    int G, c;
    __device__ bool next(int i, Unit& u) const { const int L = i * G + c; if (L >= 128) return false; u.pm = L; u.pn = L >> 5; return true; }
    __device__ __forceinline__ void a_ready(const Unit&) const {}
    __device__ __forceinline__ void done(const Unit&) const {}
};
struct EpiPoolZ {
    static constexpr bool PERM = false, AFTER_DRAIN = false;
    float* Z;
    __device__ __forceinline__ void operator()(const f32x4 (&acc)[2][2][4][2], const Unit& u, int wr, int wc, int fr, int fq) const {
        const int row0 = (u.pm & 31) * 256 + wr * 64 + fr; const int col0 = u.pn * 256 + wc * 32 + 4 * fq;
        const __amdgpu_buffer_rsrc_t zr = __builtin_amdgcn_make_buffer_rsrc(Z, 0, MROWS * 1024 * 4, 0x00020000);
#pragma unroll
        for (int ai = 0; ai < 2; ++ai)
#pragma unroll
            for (int m = 0; m < 4; ++m)
#pragma unroll
                for (int bj = 0; bj < 2; ++bj)
#pragma unroll
                    for (int n = 0; n < 2; ++n) __builtin_amdgcn_raw_buffer_store_b128(__builtin_bit_cast(u32x4, acc[ai][bj][m][n]), zr, (unsigned)(((row0 + ai * 128 + m * 16) * 1024 + col0 + bj * 128 + n * 16) * 4), 0, 16);
    }
};
struct EpiStoreBf16 {
    static constexpr bool PERM = false, AFTER_DRAIN = false;
    bf16_t* O; int ldc;
    __device__ __forceinline__ void operator()(const f32x4 (&acc)[2][2][4][2], const Unit& u, int wr, int wc, int fr, int fq) const {
        const int row0 = u.pm * 256 + wr * 64 + fr; const int col0 = u.pn * 256 + wc * 32 + 4 * fq;
#pragma unroll
        for (int ai = 0; ai < 2; ++ai)
#pragma unroll
            for (int m = 0; m < 4; ++m)
#pragma unroll
                for (int bj = 0; bj < 2; ++bj)
#pragma unroll
                    for (int n = 0; n < 2; ++n) { const f32x4 v = acc[ai][bj][m][n]; u32x2 w; w.x = cvt_pk_bf16(v[0], v[1]); w.y = cvt_pk_bf16(v[2], v[3]);
                        *(u32x2*)(O + (size_t)(row0 + ai * 128 + m * 16) * ldc + col0 + bj * 128 + n * 16) = w; }
    }
};
struct EpiResid {
    static constexpr bool PERM = false, AFTER_DRAIN = false;
    const float* base; float* out;
    __device__ __forceinline__ void operator()(const f32x4 (&acc)[2][2][4][2], const Unit& u, int wr, int wc, int fr, int fq) const {
        const int row0 = u.pm * 256 + wr * 64 + fr; const int col0 = u.pn * 256 + wc * 32 + 4 * fq;
#pragma unroll
        for (int ai = 0; ai < 2; ++ai)
#pragma unroll
            for (int m = 0; m < 4; ++m)
#pragma unroll
                for (int bj = 0; bj < 2; ++bj)
#pragma unroll
                    for (int n = 0; n < 2; ++n) { const size_t off = (size_t)(row0 + ai * 128 + m * 16) * DM + col0 + bj * 128 + n * 16;
                        const f32x4 b = *(const f32x4*)(base + off); *(f32x4*)(out + off) = b + acc[ai][bj][m][n]; }
    }
};
struct EpiResidNorm {
    static constexpr bool PERM = true, AFTER_DRAIN = false;
    const float* basef; const bf16_t* baseb; bf16_t* hb; float* rowss;
    __device__ __forceinline__ void operator()(const f32x4 (&acc)[2][2][4][2], const Unit& u, int wr, int wc, int fr, int fq) const {
        const int row0 = u.pm * 256 + wr * 64 + fr; const int col0 = u.pn * 256 + wc * 32 + 8 * fq;
#pragma unroll
        for (int ai = 0; ai < 2; ++ai)
#pragma unroll
            for (int m = 0; m < 4; ++m) { const int row = row0 + ai * 128 + m * 16; float ss = 0.f;
#pragma unroll
                for (int bj = 0; bj < 2; ++bj) { const size_t off = (size_t)row * DM + col0 + bj * 128;
                    f32x4 b0, b1;
                    if (basef) { b0 = *(const f32x4*)(basef + off); b1 = *(const f32x4*)(basef + off + 4); }
                    else { const u32x4 bw = *(const u32x4*)(baseb + off);
                        b0 = (f32x4){__uint_as_float(bw.x << 16), __uint_as_float(bw.x & 0xffff0000u), __uint_as_float(bw.y << 16), __uint_as_float(bw.y & 0xffff0000u)};
                        b1 = (f32x4){__uint_as_float(bw.z << 16), __uint_as_float(bw.z & 0xffff0000u), __uint_as_float(bw.w << 16), __uint_as_float(bw.w & 0xffff0000u)}; }
                    const f32x4 o0 = b0 + acc[ai][bj][m][0], o1 = b1 + acc[ai][bj][m][1];
                    u32x4 w; w.x = cvt_pk_bf16(o0[0], o0[1]); w.y = cvt_pk_bf16(o0[2], o0[3]); w.z = cvt_pk_bf16(o1[0], o1[1]); w.w = cvt_pk_bf16(o1[2], o1[3]);
                    *(u32x4*)(hb + off) = w;
                    ss += ((o0[0] * o0[0] + o0[1] * o0[1]) + (o0[2] * o0[2] + o0[3] * o0[3])) + ((o1[0] * o1[0] + o1[1] * o1[1]) + (o1[2] * o1[2] + o1[3] * o1[3])); }
                ss += __shfl_xor(ss, 16); ss += __shfl_xor(ss, 32);
                if (fq == 0) unsafeAtomicAdd(rowss + row, ss); }
    }
};
struct UpperOrder {
    pg8::StaticOrder S; int lo, nup, c;
    __device__ bool next(int i, Unit& u) const { if (c < lo) return false; return S.next_linear((long)i * nup + (c - lo), u); }
    __device__ __forceinline__ void a_ready(const Unit&) const {}
    __device__ __forceinline__ void done(const Unit&) const {}
};
struct EpiSwiglu {
    static constexpr bool PERM = true, AFTER_DRAIN = false;
    bf16_t* O; const float* rowss;
    __device__ __forceinline__ void operator()(const f32x4 (&acc)[2][2][4][2], const Unit& u, int wr, int wc, int fr, int fq) const {
        const int row0 = u.pm * 256 + wr * 64 + fr; const int col0 = u.pn * 128 + wc * 32 + 8 * fq;
#pragma unroll
        for (int ai = 0; ai < 2; ++ai)
#pragma unroll
            for (int m = 0; m < 4; ++m) {
                const float rs = 1.0f / sqrtf(rowss[row0 + ai * 128 + m * 16] * (1.f / DM) + 1e-6f);
                float r[8];
#pragma unroll
                for (int n = 0; n < 2; ++n)
#pragma unroll
                    for (int j = 0; j < 4; ++j) { const float g = acc[ai][0][m][n][j] * rs, up = acc[ai][1][m][n][j] * rs; r[n * 4 + j] = g * sigmoidf_(g) * up; }
                u32x4 w; w.x = cvt_pk_bf16(r[0], r[1]); w.y = cvt_pk_bf16(r[2], r[3]); w.z = cvt_pk_bf16(r[4], r[5]); w.w = cvt_pk_bf16(r[6], r[7]);
                *(u32x4*)(O + (size_t)(row0 + ai * 128 + m * 16) * DFF + col0) = w;
            }
    }
};
struct EpiPle {
    static constexpr bool PERM = true, AFTER_DRAIN = false;
    const bf16_t* h; const bf16_t* pp; const float* rowss; bf16_t* hb3; float* rowss_out;
    __device__ __forceinline__ void operator()(const f32x4 (&acc)[2][2][4][2], const Unit& u, int wr, int wc, int fr, int fq) const {
        const int row0 = u.pm * 256 + wr * 64 + fr; const int col0 = u.pn * 256 + wc * 32 + 8 * fq;
#pragma unroll
        for (int ai = 0; ai < 2; ++ai)
#pragma unroll
            for (int m = 0; m < 4; ++m) { const int row = row0 + ai * 128 + m * 16; const float rs = 1.0f / sqrtf(rowss[row] * (1.f / DM) + 1e-6f); float ss = 0.f;
#pragma unroll
                for (int bj = 0; bj < 2; ++bj) { const size_t off = (size_t)row * DM + col0 + bj * 128;
                    const u32x4 bw = *(const u32x4*)(h + off); const u32x4 pw = *(const u32x4*)(pp + off);
                    const unsigned bwa[4] = {bw.x, bw.y, bw.z, bw.w}, pwa[4] = {pw.x, pw.y, pw.z, pw.w};
                    float o[8];
#pragma unroll
                    for (int e = 0; e < 8; ++e) { const float a_ = acc[ai][bj][m][e >> 2][e & 3] * rs;
                        const float bv = (e & 1) ? __uint_as_float(bwa[e >> 1] & 0xffff0000u) : __uint_as_float(bwa[e >> 1] << 16);
                        const float pv = (e & 1) ? __uint_as_float(pwa[e >> 1] & 0xffff0000u) : __uint_as_float(pwa[e >> 1] << 16);
                        o[e] = bv + pv * sigmoidf_(a_); ss += o[e] * o[e]; }
                    u32x4 w; w.x = cvt_pk_bf16(o[0], o[1]); w.y = cvt_pk_bf16(o[2], o[3]); w.z = cvt_pk_bf16(o[4], o[5]); w.w = cvt_pk_bf16(o[6], o[7]);
                    *(u32x4*)(hb3 + off) = w; }
                ss += __shfl_xor(ss, 16); ss += __shfl_xor(ss, 32);
                if (fq == 0) unsafeAtomicAdd(rowss_out + row, ss); }
    }
};

__device__ __forceinline__ void tr_item(const float* __restrict__ W, int K, int N, int nvalid, bf16_t* __restrict__ WT, int drow0, LAS float*, int k0, int n0, int lane, const float* __restrict__ gain = nullptr) {
    const int ko = lane & 7, nq = lane >> 3; const int n = n0 + 4 * nq; const bool ok = n < nvalid;
    const float* src = W + (size_t)(k0 + 8 * ko) * N + n;
    f32x4 v[8];
#pragma unroll
    for (int i = 0; i < 8; ++i) v[i] = ok ? __builtin_nontemporal_load((const f32x4*)(src + (size_t)i * N)) : (f32x4){0.f, 0.f, 0.f, 0.f};
    if (gain) { const f32x4 g0 = *(const f32x4*)(gain + k0 + 8 * ko), g1 = *(const f32x4*)(gain + k0 + 8 * ko + 4);
#pragma unroll
        for (int i = 0; i < 4; ++i) { v[i] = v[i] * g0[i]; v[4 + i] = v[4 + i] * g1[i]; } }
#pragma unroll
    for (int j = 0; j < 4; ++j) { u32x4 o; o.x = cvt_pk_bf16(v[0][j], v[1][j]); o.y = cvt_pk_bf16(v[2][j], v[3][j]); o.z = cvt_pk_bf16(v[4][j], v[5][j]); o.w = cvt_pk_bf16(v[6][j], v[7][j]);
        __builtin_nontemporal_store(o, (u32x4*)(WT + (size_t)(drow0 + 4 * nq + j) * K + k0 + 8 * ko)); }
}
template <bool OUT_BF16>
__device__ __forceinline__ void rms_row(const float* src, const float* __restrict__ g, void* dst, int lane) {
    const f32x4* xr = (const f32x4*)src + lane; f32x4 v[8]; float s = 0.f;
#pragma unroll
    for (int j = 0; j < 8; ++j) { v[j] = xr[64 * j]; s += (v[j][0] * v[j][0] + v[j][1] * v[j][1]) + (v[j][2] * v[j][2] + v[j][3] * v[j][3]); }
    const float rstd = 1.0f / sqrtf(wave_sum(s) * (1.f / DM) + 1e-6f);
#pragma unroll
    for (int j = 0; j < 8; ++j) { const f32x4 gv = ((const f32x4*)g)[lane + 64 * j]; const f32x4 y = v[j] * rstd * gv;
        if (OUT_BF16) { u32x2 w; w.x = cvt_pk_bf16(y[0], y[1]); w.y = cvt_pk_bf16(y[2], y[3]); ((u32x2*)dst)[lane + 64 * j] = w; }
        else ((f32x4*)dst)[lane + 64 * j] = y; }
}

__device__ __forceinline__ float gelu_tanh(float x) { const float y = 0.7978845608028654f * (x + 0.044715f * x * x * x); const float e = __expf(2.f * y); return 0.5f * x * (2.f - 2.f * __builtin_amdgcn_rcpf(e + 1.f)); }
__device__ __forceinline__ void compress_job(LAS unsigned char* lds, const bf16_t* __restrict__ X, const bf16_t* __restrict__ W1t, const bf16_t* __restrict__ W2t,
                                             const float* __restrict__ bias, bf16_t* outc, int b, int g, int n0) {
    int tid_ = threadIdx.x; asm volatile("" : "+v"(tid_));
    const int tid = tid_, wid = __builtin_amdgcn_readfirstlane(tid >> 6), lane = tid & 63, fr = lane & 15, fq = lane >> 4;
    const int nn = min(n0 + fr, 126);
    const bf16_t* Ab = X + ((size_t)b * SEQ + 16 * nn) * 256 + g * 128 + 16 * fq;
    const bf16_t* Bb = W1t + (size_t)fr * 4096 + 16 * fq;
    f32x4 acc[8];
#pragma unroll
    for (int ct = 0; ct < 8; ++ct) acc[ct] = (f32x4){0.f, 0.f, 0.f, 0.f};
#pragma unroll 1
    for (int i = 0; i < 8; i += 2) {
        bf16x8 av[2][2], bv[2][8][2];
#pragma unroll
        for (int u = 0; u < 2; ++u) { const int pp = 8 * wid + i + u; const bf16_t* ap = Ab + (pp >> 1) * 256 + (pp & 1) * 64;
            av[u][0] = *(const bf16x8*)ap; av[u][1] = *(const bf16x8*)(ap + 8);
#pragma unroll
            for (int ct = 0; ct < 8; ++ct) { const bf16_t* bp = Bb + (size_t)ct * 16 * 4096 + 64 * pp; bv[u][ct][0] = *(const bf16x8*)bp; bv[u][ct][1] = *(const bf16x8*)(bp + 8); } }
        __builtin_amdgcn_sched_barrier(0);
#pragma unroll
        for (int u = 0; u < 2; ++u)
#pragma unroll
            for (int hh = 0; hh < 2; ++hh)
#pragma unroll
                for (int ct = 0; ct < 8; ++ct) acc[ct] = __builtin_amdgcn_mfma_f32_16x16x32_bf16(av[u][hh], bv[u][ct][hh], acc[ct], 0, 0, 0);
    }
    LAS float* part = (LAS float*)lds;
#pragma unroll
    for (int ct = 0; ct < 8; ++ct)
#pragma unroll
        for (int r = 0; r < 4; ++r) part[(wid * 16 + 4 * fq + r) * 132 + 16 * ct + fr] = acc[ct][r];
    __syncthreads();
    LAS bf16_t* hid = (LAS bf16_t*)(lds + 67584);
    { const int row = tid >> 5, c4 = (tid & 31) * 4; f32x4 s = *(const f32x4*)(bias + c4);
#pragma unroll 8
      for (int l = 1; l < 32; ++l) s += *(const f32x4*)(bias + l * 128 + c4);
#pragma unroll
      for (int w = 0; w < 8; ++w) s += *(const LAS f32x4*)(part + (w * 16 + row) * 132 + c4);
      u32x2 hw; hw.x = cvt_pk_bf16(gelu_tanh(s[0]), gelu_tanh(s[1])); hw.y = cvt_pk_bf16(gelu_tanh(s[2]), gelu_tanh(s[3]));
      *(LAS u32x2*)(hid + row * 136 + c4) = hw; }
    __syncthreads();
    f32x4 acc2 = {0.f, 0.f, 0.f, 0.f};
    const __amdgpu_buffer_rsrc_t orsrc = __builtin_amdgcn_make_buffer_rsrc(outc, 0, 8 * 128 * 128 * 2, 0x00020000);
#pragma unroll
    for (int s = 0; s < 4; ++s) { const bf16x8 a = *(const LAS bf16x8*)(hid + fr * 136 + 32 * s + 8 * fq);
        const bf16x8 bb = *(const bf16x8*)(W2t + (size_t)(16 * wid + fr) * 128 + 32 * s + 8 * fq); acc2 = __builtin_amdgcn_mfma_f32_16x16x32_bf16(a, bb, acc2, 0, 0, 0); }
#pragma unroll
    for (int r = 0; r < 4; ++r) { const int n = n0 + 4 * fq + r; const float v = (n == 127) ? 0.f : acc2[r];
        __builtin_amdgcn_raw_buffer_store_b16((short)(cvt_pk_bf16(v, v) & 0xffffu), orsrc, (unsigned)((((b * 2 + g) * 128 + n) * 128 + 16 * wid + fr) * 2), 0, 16); }
    __syncthreads();
}


template <bool FENCE>
__device__ __forceinline__ void signal_done(unsigned* cnt, unsigned n) {
    asm volatile("s_waitcnt vmcnt(0)" ::: "memory"); __syncthreads();
    if (threadIdx.x == 0 && n) { if (FENCE) { __builtin_amdgcn_fence(__ATOMIC_RELEASE, "agent"); asm volatile("s_waitcnt vmcnt(0)" ::: "memory"); }
        (void)__hip_atomic_fetch_add(cnt, n, __ATOMIC_RELAXED, __HIP_MEMORY_SCOPE_AGENT); }
}
__device__ __forceinline__ void wait_count(unsigned* cnt, unsigned want) {
    if (threadIdx.x == 0) { unsigned spins = 0;
        while (__hip_atomic_load(cnt, __ATOMIC_RELAXED, __HIP_MEMORY_SCOPE_AGENT) < want && ++spins < (1u << 22)) __builtin_amdgcn_s_sleep(2);
        __builtin_amdgcn_fence(__ATOMIC_ACQUIRE, "agent"); asm volatile("s_waitcnt vmcnt(0)" ::: "memory"); }
    __syncthreads();
}
namespace att {
constexpr float SCALE = 0.08838834764831845f, CL2 = SCALE * 1.4426950408889634f, NEGB = -1e30f;
#define KSWZ(row, colB) ((row) * 256 + ((colB) ^ (((row) & 7) << 4)))
#define SBAR() __builtin_amdgcn_sched_barrier(0)
__device__ __forceinline__ int crow(int r, int hi) { return (r & 3) + 8 * (r >> 2) + 4 * hi; }
__device__ __forceinline__ int v_st(int k, int c) { const int kk = (k & ~0xC) | ((k & 4) << 1) | ((k & 8) >> 1); return ((kk >> 3) * 4 + (c >> 5)) * 512 + ((kk & 7) * 32 + (c & 31)) * 2; }
__device__ __forceinline__ int v_rd_base(int lane) { return ((lane & 3) << 3) | (((lane >> 2) & 3) << 6) | (((lane >> 4) & 1) << 5) | (((lane >> 5) & 1) << 8); }
constexpr int v_rd_off(int d0, int ks, int half) { return d0 * 512 + ks * 4096 + half * 2048; }
template <int OFF> __device__ __forceinline__ s16x4 tr_read(int vb) { s16x4 r; asm volatile("ds_read_b64_tr_b16 %0, %1 offset:%2" : "=&v"(r) : "v"(vb), "i"(OFF) : "memory"); return r; }
template <int D0> __device__ __forceinline__ void pv_one(f32x16& od, int vb, bf16x8 pa0, bf16x8 pa1, bf16x8 pa2, bf16x8 pa3) {
    const s16x4 l0 = tr_read<v_rd_off(D0, 0, 0)>(vb), h0 = tr_read<v_rd_off(D0, 0, 1)>(vb), l1 = tr_read<v_rd_off(D0, 1, 0)>(vb), h1 = tr_read<v_rd_off(D0, 1, 1)>(vb);
    const s16x4 l2 = tr_read<v_rd_off(D0, 2, 0)>(vb), h2 = tr_read<v_rd_off(D0, 2, 1)>(vb), l3 = tr_read<v_rd_off(D0, 3, 0)>(vb), h3 = tr_read<v_rd_off(D0, 3, 1)>(vb);
    asm volatile("s_waitcnt lgkmcnt(0)" ::: "memory"); SBAR();
#define PK(L, H) (bf16x8){L[0], L[1], L[2], L[3], H[0], H[1], H[2], H[3]}
    __builtin_amdgcn_s_setprio(1);
    od = __builtin_amdgcn_mfma_f32_32x32x16_bf16(pa0, PK(l0, h0), od, 0, 0, 0);
    od = __builtin_amdgcn_mfma_f32_32x32x16_bf16(pa1, PK(l1, h1), od, 0, 0, 0);
    od = __builtin_amdgcn_mfma_f32_32x32x16_bf16(pa2, PK(l2, h2), od, 0, 0, 0);
    od = __builtin_amdgcn_mfma_f32_32x32x16_bf16(pa3, PK(l3, h3), od, 0, 0, 0);
    __builtin_amdgcn_s_setprio(0);
#undef PK
}
__device__ __forceinline__ void pv_d0(f32x16* o, int vb, bf16x8 pa0, bf16x8 pa1, bf16x8 pa2, bf16x8 pa3) {
    pv_one<0>(o[0], vb, pa0, pa1, pa2, pa3); pv_one<1>(o[1], vb, pa0, pa1, pa2, pa3); pv_one<2>(o[2], vb, pa0, pa1, pa2, pa3); pv_one<3>(o[3], vb, pa0, pa1, pa2, pa3);
}
__device__ __forceinline__ void qkt(f32x16& p0, f32x16& p1, const LAS char* Ks, const bf16x8* qr, int r32, int hi) {
    p0 = f32x16{}; p1 = f32x16{};
    __builtin_amdgcn_s_setprio(1);
#pragma unroll
    for (int d0 = 0; d0 < 8; ++d0) { const int cb = (d0 * 16 + hi * 8) * 2;
        const bf16x8 b0 = *(const LAS bf16x8*)(Ks + KSWZ(r32, cb));
        const bf16x8 b1 = *(const LAS bf16x8*)(Ks + KSWZ(32 + r32, cb));
        p0 = __builtin_amdgcn_mfma_f32_32x32x16_bf16(b0, qr[d0], p0, 0, 0, 0);
        p1 = __builtin_amdgcn_mfma_f32_32x32x16_bf16(b1, qr[d0], p1, 0, 0, 0);
#ifdef QKT_SBAR
        if ((d0 & (QKT_SBAR - 1)) == QKT_SBAR - 1) SBAR();
#endif
    }
    __builtin_amdgcn_s_setprio(0);
}
__device__ __forceinline__ void sm_step(f32x16& p0, f32x16& p1, bool lane_on, float& m_reg, float& l_reg, f32x16* o, LAS float* al_l, int r32, int hi,
                                        bf16x8& pa0, bf16x8& pa1, bf16x8& pa2, bf16x8& pa3, float& alpha_out) {
    float pmax = p0[0];
#pragma unroll
    for (int r = 1; r < 16; ++r) pmax = fmaxf(pmax, p0[r]);
#pragma unroll
    for (int r = 0; r < 16; ++r) pmax = fmaxf(pmax, p1[r]);
    pmax = lane_on ? pmax : NEGB;
    { auto rr = __builtin_amdgcn_permlane32_swap(__float_as_uint(pmax), __float_as_uint(pmax), false, false);
      pmax = fmaxf(__uint_as_float(rr[0]), __uint_as_float(rr[1])); }
    float mn, alpha;
    if (__all(pmax - m_reg <= 8.0f / SCALE)) { mn = m_reg; alpha = 1.f; }
    else { mn = fmaxf(m_reg, pmax); alpha = __builtin_amdgcn_exp2f((m_reg - mn) * CL2); }
    m_reg = mn; alpha_out = alpha;
    const float mnC = (!lane_on || mn < -1e29f) ? -INFINITY : -mn * CL2;
#pragma unroll
    for (int r = 0; r < 16; ++r) p0[r] = __builtin_amdgcn_exp2f(fmaf(p0[r], CL2, mnC));
#pragma unroll
    for (int r = 0; r < 16; ++r) p1[r] = __builtin_amdgcn_exp2f(fmaf(p1[r], CL2, mnC));
    float ps = 0.f;
#pragma unroll
    for (int r = 0; r < 16; ++r) ps += p0[r];
#pragma unroll
    for (int r = 0; r < 16; ++r) ps += p1[r];
    { auto rr = __builtin_amdgcn_permlane32_swap(__float_as_uint(ps), __float_as_uint(ps), false, false);
      ps = __uint_as_float(rr[0]) + __uint_as_float(rr[1]); }
    l_reg = l_reg * alpha + ps;
    if (__any(alpha < 1.f)) { if (hi == 0) al_l[r32] = alpha; LDS_WAIT();
#pragma unroll
        for (int d = 0; d < 4; ++d)
#pragma unroll
            for (int r = 0; r < 16; ++r) o[d][r] *= al_l[crow(r, hi)];
    }
#define PK4(P, BASE, OUT) do { unsigned a0_ = cvt_pk_bf16(P[BASE + 0], P[BASE + 1]), a1_ = cvt_pk_bf16(P[BASE + 2], P[BASE + 3]);   \
    unsigned b0_ = cvt_pk_bf16(P[BASE + 4], P[BASE + 5]), b1_ = cvt_pk_bf16(P[BASE + 6], P[BASE + 7]);                              \
    auto r0_ = __builtin_amdgcn_permlane32_swap(a0_, b0_, false, false); auto r1_ = __builtin_amdgcn_permlane32_swap(a1_, b1_, false, false); \
    u32x4 w_ = {r0_[0], r1_[0], r0_[1], r1_[1]}; OUT = __builtin_bit_cast(bf16x8, w_); } while (0)
    PK4(p0, 0, pa0); PK4(p0, 8, pa1); PK4(p1, 0, pa2); PK4(p1, 8, pa3);
#undef PK4
}
struct Stg { bf16x8 k0, k1, v0, v1; };
__device__ __forceinline__ void tile_load(Stg& s, const bf16_t* Kb, const bf16_t* Vb, int pitch, int key0, int sr, int sc) {
    s.k0 = *(const bf16x8*)(Kb + (size_t)(key0 + sr) * pitch + sc); s.k1 = *(const bf16x8*)(Kb + (size_t)(key0 + 32 + sr) * pitch + sc);
    s.v0 = *(const bf16x8*)(Vb + (size_t)(key0 + sr) * pitch + sc); s.v1 = *(const bf16x8*)(Vb + (size_t)(key0 + 32 + sr) * pitch + sc);
}
__device__ __forceinline__ void tile_write(LAS char* Kl, LAS char* Vl, const Stg& s, int sr, int sc) {
    *(LAS bf16x8*)(Vl + v_st(sr, sc)) = s.v0; *(LAS bf16x8*)(Vl + v_st(32 + sr, sc)) = s.v1;
    *(LAS bf16x8*)(Kl + KSWZ(sr, sc * 2)) = s.k0; *(LAS bf16x8*)(Kl + KSWZ(32 + sr, sc * 2)) = s.k1;
}
__device__ __forceinline__ void tile_dma(LAS char* Kl, LAS char* Vl, const bf16_t* Kb, const bf16_t* Vb, int pitch, int key0, int wid, int lane) {
#pragma unroll
    for (int h = 0; h < 2; ++h) {
        const int ch = wid * 2 + h; const int L = ch * 1024 + lane * 16;
        { const int row = L >> 8, c16 = ((L >> 4) & 15) ^ (row & 7);
          __builtin_amdgcn_global_load_lds((const unsigned*)(Kb + (size_t)(key0 + row) * pitch + c16 * 8), (LAS unsigned*)(Kl + ch * 1024), 16, 0, 0); }
        { const int sub = L >> 9, kk = (sub >> 2) * 8 + ((L >> 6) & 7), c8 = (sub & 3) * 4 + ((L >> 4) & 3);
          const int k = (kk & ~0xC) | ((kk & 4) << 1) | ((kk & 8) >> 1);
          __builtin_amdgcn_global_load_lds((const unsigned*)(Vb + (size_t)(key0 + k) * pitch + c8 * 8), (LAS unsigned*)(Vl + ch * 1024), 16, 0, 0); }
    }
}
template <int MODE>
__device__ __forceinline__ void finalize(const f32x16* o, float l_reg, float gate, LAS float* li_l, int r32, int hi, float* scrA, float* scrB, bf16_t* catp) {
    if (hi == 0) li_l[r32] = l_reg > 0.f ? gate / l_reg : 0.f;
    LDS_WAIT();
#pragma unroll
    for (int r = 0; r < 16; ++r) {
        const int rc = (r & 3) + 8 * (r >> 2);
        unsigned lo = (unsigned)(4 * hi) * 1024u + (unsigned)r32, lc = (unsigned)(4 * hi) * 2048u + (unsigned)r32;
        asm volatile("" : "+v"(lo), "+v"(lc));
        const float f = li_l[rc + 4 * hi];
        if (MODE == 2) {
            float va[4], vb[4];
#pragma unroll
            for (int d0 = 0; d0 < 4; ++d0) { va[d0] = scrA[lo + rc * 1024 + 32 * d0]; vb[d0] = scrB[lo + rc * 1024 + 32 * d0]; }
#pragma unroll
            for (int d0 = 0; d0 < 4; ++d0) { const float v = o[d0][r] * f + (va[d0] + vb[d0]); catp[lc + rc * 2048 + 32 * d0] = (bf16_t)(cvt_pk_bf16(v, v) & 0xffffu); }
            if (r & 1) asm volatile("" ::: "memory");
        } else {
#pragma unroll
            for (int d0 = 0; d0 < 4; ++d0) { const float v = o[d0][r] * f; if (MODE == 0) scrA[lo + rc * 1024 + 32 * d0] = v; else scrB[lo + rc * 1024 + 32 * d0] = v; }
        }
    }
    LDS_WAIT();
}
template <bool WIN>
__device__ __forceinline__ void run_branch(LAS char* K_l, LAS char* V_l, const bf16_t* Kb, const bf16_t* Vb, unsigned tiles, unsigned lanemask, int c, int tl,
                                           const bf16x8* qr, float& m_reg, float& l_reg, f32x16* o, LAS float* al_l, int r32, int hi, int wid, int lane, int vb0) {
    unsigned rem = tiles; int j = __builtin_ctz(rem); rem &= rem - 1;
    __syncthreads();
    tile_dma(K_l, V_l, Kb, Vb, 256, 64 * j, wid, lane);
    asm volatile("s_waitcnt vmcnt(0)" ::: "memory"); __syncthreads();
    int cur = 0;
    for (;;) {
        const int jn = rem ? __builtin_ctz(rem) : -1;
        if (jn >= 0) { rem &= rem - 1; tile_dma(K_l + (cur ^ 1) * 32768, V_l + (cur ^ 1) * 32768, Kb, Vb, 256, 64 * jn, wid, lane); }
        const bool lane_on = (lanemask >> j) & 1u;
#ifdef ATT_NOANY
        {
#else
        if (__any(lane_on)) {
#endif
            f32x16 p0, p1; qkt(p0, p1, K_l + cur * 32768, qr, r32, hi);
            if (j == c) {
                int tlv = tl - 4 * hi; asm volatile("" : "+v"(tlv));
#pragma unroll
                for (int r = 0; r < 16; ++r) { const int kk = (r & 3) + 8 * (r >> 2); p0[r] = (kk > tlv) ? NEGB : p0[r]; p1[r] = (kk + 32 > tlv) ? NEGB : p1[r]; }
            }
            if (WIN && j == c - 8) {
                int tlv = tl - 4 * hi; asm volatile("" : "+v"(tlv));
#pragma unroll
                for (int r = 0; r < 16; ++r) { const int kk = (r & 3) + 8 * (r >> 2); p0[r] = (kk <= tlv) ? NEGB : p0[r]; p1[r] = (kk + 32 <= tlv) ? NEGB : p1[r]; }
            }
            bf16x8 pa0, pa1, pa2, pa3; float al;
            sm_step(p0, p1, lane_on, m_reg, l_reg, o, al_l, r32, hi, pa0, pa1, pa2, pa3, al);
            pv_d0(o, vb0 + cur * 32768, pa0, pa1, pa2, pa3);
        }
        if (jn < 0) break;
        asm volatile("s_waitcnt vmcnt(0)" ::: "memory"); __syncthreads();
        j = jn; cur ^= 1;
    }
}
constexpr int L_V = 0, L_K = 16384, L_IMP = 65536, L_SIMP = 99328, L_MASK = 107776, L_WS = 108288;
__device__ __forceinline__ void attn_unit(LAS unsigned char* ldsb, const bf16_t* __restrict__ T, const bf16_t* kcmp, const bf16_t* vcmp,
                                          const float* __restrict__ gates, float* scr, float* scr2, bf16_t* cat, int b, int g, int c, unsigned* cmp_cnt) {
    LAS char* lds = (LAS char*)ldsb;
    int tid_ = threadIdx.x; asm volatile("" : "+v"(tid_));
    const int tid = tid_, wid = __builtin_amdgcn_readfirstlane(tid >> 6), lane = tid & 63, r32 = lane & 31, hi = lane >> 5;
    const int hh = wid & 3, ch = wid >> 2, h = g * 4 + hh;
    const int tl = 32 * ch + r32, t = 64 * c + tl;
    const size_t row = (size_t)b * SEQ + t;
    LAS char* V_l = lds + L_V; LAS char* K_l = lds + L_K;
    LAS float* impw = (LAS float*)(lds + L_IMP) + wid * 1056;
    LAS float* simp = (LAS float*)(lds + L_SIMP);
    LAS unsigned* maskw = (LAS unsigned*)(lds + L_MASK);
    LAS float* li_l = (LAS float*)(lds + L_WS) + wid * 64; LAS float* al_l = li_l + 32;
    bf16x8 qr[8];
    { const bf16_t* Qw = T + (size_t)(4 + (h >> 1)) * TS + row * 256 + (h & 1) * 128 + hi * 8;
#pragma unroll
      for (int d0 = 0; d0 < 8; ++d0) qr[d0] = *(const bf16x8*)(Qw + d0 * 16); }
    const int vb0 = (int)(uintptr_t)V_l + v_rd_base(lane);
    const float g0 = gates[row * 24 + h * 3 + 0], g1 = gates[row * 24 + h * 3 + 1], g2 = gates[row * 24 + h * 3 + 2];
    float* scrp = scr + ((size_t)b * SEQ + 64 * c + 32 * ch) * 1024 + h * 128;
    float* scrq = scr2 + ((size_t)b * SEQ + 64 * c + 32 * ch) * 1024 + h * 128;
    bf16_t* catp = cat + ((size_t)b * SEQ + 64 * c + 32 * ch) * DM + 1024 + h * 128;
    if (tid == 0) maskw[64] = 0u;
    float m_reg = NEGB, l_reg = 0.f; f32x16 o[4];
#pragma unroll
    for (int d = 0; d < 4; ++d) o[d] = f32x16{};
    { const bf16_t* Kb = T + (size_t)12 * TS + (size_t)b * SEQ * 256 + g * 128; const bf16_t* Vb = T + (size_t)13 * TS + (size_t)b * SEQ * 256 + g * 128;
      const int lo = c >= 8 ? c - 8 : 0; const unsigned wt = (c == 31 ? 0xffffffffu : ((1u << (c + 1)) - 1u)) & ~((1u << lo) - 1u);
#ifndef ATT_SKIP_B2
      run_branch<true>(K_l, V_l, Kb, Vb, wt, 0xffffffffu, c, tl, qr, m_reg, l_reg, o, al_l, r32, hi, wid, lane, vb0);
#endif
      finalize<0>(o, l_reg, g2, li_l, r32, hi, scrp, scrq, catp);
    }
    wait_count(cmp_cnt, 128u);
    m_reg = NEGB; l_reg = 0.f;
#pragma unroll
    for (int d = 0; d < 4; ++d) o[d] = f32x16{};
    {
        const bf16_t* Kb = kcmp + (size_t)(b * 2 + g) * 128 * 128; const bf16_t* Vb = vcmp + (size_t)(b * 2 + g) * 128 * 128;
        const int nmax = (t >= 31) ? ((t - 31) >> 4) : -1;
        bf16x8 pa0, pa1, pa2, pa3; float alA, alB;
        float inn[4][4], lst[4][4];
        __syncthreads();
        tile_dma(K_l, V_l, Kb, Vb, 128, 0, wid, lane); tile_dma(K_l + 32768, V_l + 32768, Kb, Vb, 128, 64, wid, lane);
        asm volatile("s_waitcnt vmcnt(0)" ::: "memory"); __syncthreads();
        {
            f32x16 a0, a1;
            qkt(a0, a1, K_l, qr, r32, hi);
#pragma unroll
            for (int r = 0; r < 16; ++r) { const int n = crow(r, hi); a0[r] = (n <= nmax) ? a0[r] : NEGB; a1[r] = (n + 32 <= nmax) ? a1[r] : NEGB; }
            sm_step(a0, a1, true, m_reg, l_reg, o, al_l, r32, hi, pa0, pa1, pa2, pa3, alA);
#pragma unroll
            for (int c4 = 0; c4 < 4; ++c4) { inn[0][c4] = (a0[4 * c4] + a0[4 * c4 + 1]) + (a0[4 * c4 + 2] + a0[4 * c4 + 3]); lst[0][c4] = a0[4 * c4 + 3];
                                             inn[1][c4] = (a1[4 * c4] + a1[4 * c4 + 1]) + (a1[4 * c4 + 2] + a1[4 * c4 + 3]); lst[1][c4] = a1[4 * c4 + 3]; }
        }
        pv_d0(o, vb0, pa0, pa1, pa2, pa3);
        {
            f32x16 b0, b1;
            qkt(b0, b1, K_l + 32768, qr, r32, hi);
#pragma unroll
            for (int r = 0; r < 16; ++r) { const int n = 64 + crow(r, hi); b0[r] = (n <= nmax) ? b0[r] : NEGB; b1[r] = (n + 32 <= nmax) ? b1[r] : NEGB; }
            sm_step(b0, b1, true, m_reg, l_reg, o, al_l, r32, hi, pa0, pa1, pa2, pa3, alB);
#pragma unroll
            for (int c4 = 0; c4 < 4; ++c4) { inn[2][c4] = (b0[4 * c4] + b0[4 * c4 + 1]) + (b0[4 * c4 + 2] + b0[4 * c4 + 3]); lst[2][c4] = b0[4 * c4 + 3];
                                             inn[3][c4] = (b1[4 * c4] + b1[4 * c4 + 1]) + (b1[4 * c4 + 2] + b1[4 * c4 + 3]); lst[3][c4] = b1[4 * c4 + 3]; }
        }
        pv_d0(o, vb0 + 32768, pa0, pa1, pa2, pa3);
        const float inv = l_reg > 0.f ? 1.f / l_reg : 0.f; const float fa = alB * inv, fb = inv;
        float x[4][4];
#pragma unroll
        for (int TT = 0; TT < 4; ++TT)
#pragma unroll
            for (int c4 = 0; c4 < 4; ++c4) { const float f = TT < 2 ? fa : fb; inn[TT][c4] *= f; lst[TT][c4] *= f; x[TT][c4] = __shfl_xor(lst[TT][c4], 32); }
#pragma unroll
        for (int TT = 0; TT < 4; ++TT)
#pragma unroll
            for (int c4 = 0; c4 < 4; ++c4) {
                const float plo = c4 >= 1 ? x[TT][c4 >= 1 ? c4 - 1 : 0] : (TT >= 1 ? x[TT >= 1 ? TT - 1 : 0][3] : 0.f);
                const float prev = hi ? x[TT][c4] : plo;
                impw[r32 * 33 + 8 * TT + 2 * c4 + hi] = inn[TT][c4] + prev;
            }
#ifndef ATT_SKIP_FIN
        finalize<1>(o, l_reg, g0, li_l, r32, hi, scrp, scrq, catp);
#endif
    }
    __syncthreads();
    {
        const int pidx = tid >> 3, sub = tid & 7;
        const LAS float* ib = (const LAS float*)(lds + L_IMP) + ((pidx >> 5) * 4) * 1056 + (pidx & 31) * 33;
#pragma unroll
        for (int jj = 0; jj < 4; ++jj) { const int j = 4 * sub + jj; float sv = (ib[j] + ib[1056 + j]) + (ib[2112 + j] + ib[3168 + j]);
            if (j > c) sv = -1.f; else if (j == 0 || j == c || j == c - 1) sv = 3.0e38f;
            simp[pidx * 33 + j] = sv; }
        __syncthreads();
        float vj[4]; int rk[4];
#pragma unroll
        for (int jj = 0; jj < 4; ++jj) { vj[jj] = simp[pidx * 33 + 4 * sub + jj]; rk[jj] = 0; }
#pragma unroll 1
        for (int i = 0; i < 32; ++i) { const float vi = simp[pidx * 33 + i];
#pragma unroll
            for (int jj = 0; jj < 4; ++jj) rk[jj] += (vi > vj[jj] || (vi == vj[jj] && i < 4 * sub + jj)) ? 1 : 0; }
        unsigned bits = 0u;
#pragma unroll
        for (int jj = 0; jj < 4; ++jj) { const int j = 4 * sub + jj; if (rk[jj] < 16 && j <= c) bits |= 1u << j; }
        bits |= __shfl_xor(bits, 1); bits |= __shfl_xor(bits, 2); bits |= __shfl_xor(bits, 4);
        if (sub == 0) maskw[pidx] = bits;
        bits |= __shfl_xor(bits, 8); bits |= __shfl_xor(bits, 16); bits |= __shfl_xor(bits, 32);
        if (lane == 0) atomicOr((unsigned*)(maskw + 64), bits);
    }
    __syncthreads();
    const unsigned umask = __builtin_amdgcn_readfirstlane(maskw[64]);
    const unsigned mymask = maskw[tl];
    m_reg = NEGB; l_reg = 0.f;
#pragma unroll
    for (int d = 0; d < 4; ++d) o[d] = f32x16{};
    { const bf16_t* Kb = T + (size_t)10 * TS + (size_t)b * SEQ * 256 + g * 128; const bf16_t* Vb = T + (size_t)11 * TS + (size_t)b * SEQ * 256 + g * 128;
#ifndef ATT_SKIP_B1
      run_branch<false>(K_l, V_l, Kb, Vb, umask, mymask, c, tl, qr, m_reg, l_reg, o, al_l, r32, hi, wid, lane, vb0);
#endif
#ifndef ATT_SKIP_FIN
      finalize<2>(o, l_reg, g1, li_l, r32, hi, scrp, scrq, catp);
#endif
    }
    __syncthreads();
}
}

template <int W>
__device__ __forceinline__ void pool_rows16(const float* __restrict__ Z, const float* __restrict__ scale, bf16_t* cat, int base, int q) {
    const int seq0 = base & ~(SEQ - 1);
    f32x4 v[15 + W];
#pragma unroll
    for (int i = 0; i < 15 + W; ++i) { const int r = base - (W - 1) + i; v[i] = (r >= seq0) ? *((const f32x4*)Z + (size_t)r * 256 + q) : (f32x4){0.f, 0.f, 0.f, 0.f}; }
    const f32x4 sv = ((const f32x4*)scale)[q];
#pragma unroll
    for (int j = 0; j < 16; ++j) { f32x4 s = v[j + W - 1];
#pragma unroll
        for (int k = 1; k < W; ++k) s += v[j + W - 1 - k];
        const int t = (base + j) & (SEQ - 1); const int n = min(W, t + 1); const float rc = 1.0f / (float)n;
        const f32x4 y = (s * rc - v[j + W - 1]) * sv;
        u32x2 wv; wv.x = cvt_pk_bf16(y[0], y[1]); wv.y = cvt_pk_bf16(y[2], y[3]);
        *(u32x2*)(cat + (size_t)(base + j) * DM + 4 * q) = wv; }
}
__device__ __forceinline__ void pool_finalize(const float* __restrict__ Z, const float* __restrict__ scale, bf16_t* cat, int row_begin, int nrows) {
    const int q = threadIdx.x & 255, grp = __builtin_amdgcn_readfirstlane((int)(threadIdx.x & 255) >> 6);
    for (int base = row_begin + 16 * (int)(threadIdx.x >> 8); base < row_begin + nrows; base += 32) {
        if (grp == 0) pool_rows16<2>(Z, scale, cat, base, q); else if (grp == 1) pool_rows16<4>(Z, scale, cat, base, q);
        else if (grp == 2) pool_rows16<8>(Z, scale, cat, base, q); else pool_rows16<16>(Z, scale, cat, base, q);
    }
}

#define XB_TMO      128
#define XB_XCNT(j)  (256  + 64 * (j))
#define XB_XSUB(j)  (1280 + 64 * (j))
#define XB_XGEN(j)  (2304 + 64 * (j))
#define XB_TOP      3328
#define XB_TOPGEN   3392
#define XCD_BAR_WORDS 3456
#define XB_SPIN_CAP (1u << 18)

__device__ __forceinline__ unsigned xb_ld(unsigned* p)              { return __hip_atomic_load(p, __ATOMIC_RELAXED, __HIP_MEMORY_SCOPE_AGENT); }
__device__ __forceinline__ unsigned xb_add(unsigned* p, unsigned v) { return __hip_atomic_fetch_add(p, v, __ATOMIC_RELAXED, __HIP_MEMORY_SCOPE_AGENT); }
__device__ __forceinline__ unsigned xb_xcc_id() { return (unsigned)__builtin_amdgcn_s_getreg((3 << 11) | 20) & 0xFu; }
#define XB_SPIN(cond, bar) do { unsigned _sp = 0; while (cond) { __builtin_amdgcn_s_sleep(1); \
    if ((++_sp & 255u) == 0u) { if (xb_ld(&(bar)[XB_TMO])) break; if (_sp > XB_SPIN_CAP) { atomicAdd(&(bar)[XB_TMO], 1u); break; } } } } while (0)

struct XcdBarrier {
    unsigned* bar; unsigned x;
    volatile LAS unsigned* st;
};

__device__ __forceinline__ XcdBarrier xcd_barrier_post(unsigned* bar, volatile LAS unsigned* st) {
    XcdBarrier b; b.bar = bar; b.x = xb_xcc_id(); b.st = st;
    if (threadIdx.x == 0) (void)xb_add(&bar[XB_XCNT(b.x)], 1u);
    return b;
}
__device__ __forceinline__ void xcd_barrier_complete(unsigned* bar, unsigned x, unsigned& nloc, unsigned& nx) {
    const unsigned G = gridDim.x * gridDim.y * gridDim.z;
    unsigned sum, cnt, mine, sp = 0u;
    for (;;) {
        sum = 0u; cnt = 0u; mine = 0u;
#pragma unroll
        for (unsigned j = 0; j < 16; ++j) { const unsigned c = xb_ld(&bar[XB_XCNT(j)]); sum += c; cnt += (c > 0u) ? 1u : 0u; mine = (j == x) ? c : mine; }
        if (sum == G) break;
        __builtin_amdgcn_s_sleep(1);
        if ((++sp & 255u) == 0u) { if (xb_ld(&bar[XB_TMO])) break; if (sp > XB_SPIN_CAP) { atomicAdd(&bar[XB_TMO], 1u); break; } }
    }
    nloc = mine > 0u ? mine : 1u; nx = cnt > 0u ? cnt : 1u;
}

__device__ __forceinline__ void xcd_barrier(const XcdBarrier& b) {
    asm volatile("s_waitcnt vmcnt(0)" ::: "memory");
    __syncthreads();
    if (threadIdx.x == 0) {
        unsigned* bar = b.bar;
        __builtin_amdgcn_s_waitcnt(0);
        unsigned nloc = b.st[0], nx = b.st[1];
        if (nloc == 0u) { xcd_barrier_complete(bar, b.x, nloc, nx); b.st[0] = nloc; b.st[1] = nx; }
        const unsigned old = xb_add(&bar[XB_XSUB(b.x)], 1u);
        const unsigned gen = old / nloc;
        if (old + 1u == (gen + 1u) * nloc) {
            __builtin_amdgcn_fence(__ATOMIC_RELEASE, "agent");
            asm volatile("s_waitcnt vmcnt(0)" ::: "memory");
            const unsigned og = xb_add(&bar[XB_TOP], 1u);
            const unsigned tg = og / nx;
            if (og + 1u == (tg + 1u) * nx) xb_add(&bar[XB_TOPGEN], 1u);
            else XB_SPIN(xb_ld(&bar[XB_TOPGEN]) == tg, bar);
            __builtin_amdgcn_fence(__ATOMIC_ACQUIRE, "agent");
            xb_add(&bar[XB_XGEN(b.x)], 1u);
            asm volatile("s_waitcnt vmcnt(0)" ::: "memory");
        } else {
            XB_SPIN(xb_ld(&bar[XB_XGEN(b.x)]) == gen, bar);
            __builtin_amdgcn_fence(__ATOMIC_ACQUIRE, "agent");
            asm volatile("s_waitcnt vmcnt(0)" ::: "memory");
        }
    }
    __syncthreads();
}

#ifndef REPF
#define REPF 1
#endif
struct Args { const float* in[21]; float* out; unsigned char* ws; int ph_lo, ph_hi; };
#ifndef MK_PER_PHASE
#define MK_PER_PHASE 0
#endif
__global__ void __launch_bounds__(NTHREADS, 2) hymba_fwd(Args a) {
    extern __shared__ __attribute__((aligned(16))) unsigned char lds_raw[];
    LAS unsigned char* lds = (LAS unsigned char*)lds_raw;
    unsigned* xbar_words = (unsigned*)(a.ws + 262144);
    volatile LAS unsigned* xb_st = (volatile LAS unsigned*)(lds + 131072 + 64);
    if (threadIdx.x < 2) xb_st[threadIdx.x] = 0u;
    __syncthreads();
    XcdBarrier xb = xcd_barrier_post(xbar_words, xb_st);
    unsigned* ctl = (unsigned*)(a.ws + 262144 + 16384);
#define PHASE_IDS() int tid_ = threadIdx.x; asm volatile("" : "+v"(tid_)); const int tid = tid_, lane = tid & 63, wave = __builtin_amdgcn_readfirstlane(tid >> 6); \
    const int gw = bid * 8 + wave, NGW = G * 8, gtid = bid * NTHREADS + tid, GT = G * NTHREADS; (void)lane; (void)gw; (void)NGW; (void)gtid; (void)GT;
    const int G = gridDim.x, bid = blockIdx.x;
    unsigned char* ws = a.ws;
    const float* x = a.in[0]; float* hbuf = a.out;
    bf16_t* Win_t = (bf16_t*)(ws + WS_WIN); bf16_t* Wout_t = (bf16_t*)(ws + WS_WOUT); bf16_t* Wpg_t = (bf16_t*)(ws + WS_WPG); bf16_t* Wd_t = (bf16_t*)(ws + WS_WD);
    bf16_t* Wgu_t = (bf16_t*)(ws + WS_WGU); bf16_t* Wpp_t = (bf16_t*)(ws + WS_WPP); bf16_t* poolw_t = (bf16_t*)(ws + WS_POOLW);
    bf16_t* W1k = (bf16_t*)(ws + WS_W1K); bf16_t* W1v = (bf16_t*)(ws + WS_W1V); bf16_t* W2k = (bf16_t*)(ws + WS_W2K); bf16_t* W2v = (bf16_t*)(ws + WS_W2V);
    bf16_t* PBF = (bf16_t*)(ws + WS_PBF); bf16_t* XN = (bf16_t*)(ws + WS_XN); bf16_t* T = (bf16_t*)(ws + WS_T); float* Z = (float*)(ws + WS_Z);
    float* SCR = (float*)(ws + WS_SCR); bf16_t* ACT = (bf16_t*)(ws + WS_ACT); bf16_t* PP = (bf16_t*)a.out;
    float* rowss1 = (float*)(ws + 65536); float* rowss2 = (float*)(ws + 131072); float* rowss3 = (float*)(ws + 196608); bf16_t* HB1 = (bf16_t*)(ws + WS_SCR);
    float* cosT = (float*)(ws + WS_COS); float* sinT = (float*)(ws + WS_SIN); float* gatesb = (float*)(ws + WS_GATES);
    bf16_t* kcmp = (bf16_t*)(ws + WS_KCMP); bf16_t* vcmp = (bf16_t*)(ws + WS_VCMP); float* biasp = (float*)(ws + WS_BIASK);

#ifndef SKIP_P0
#ifndef REP0
#define REP0 1
#endif
    if (a.ph_lo <= 0 && 0 < a.ph_hi) for (int rep0 = 0; rep0 < REP0; ++rep0) {
        if (rep0) xcd_barrier(xb);
    {
        PHASE_IDS();
        LAS float* scr = (LAS float*)(lds + wave * 16384);
        constexpr int I_IN = 32 * 120, I_SQ = 32 * 64, I_GU = 32 * 176, I_DN = 88 * 64, I_PP = 4 * 64, I_PW = 4 * 8, I_W1 = 64 * 4, I_W2 = 2 * 4;
        constexpr int NITEMS = I_IN + 2 * I_SQ + 2 * I_GU + I_DN + I_PP + 4 * I_PW + 2 * I_W1 + 2 * I_W2;
        for (int it = gw; it < NITEMS; it += NGW) {
            int r = it; const float* Wsrc; const float* gain = nullptr; bf16_t* dst; int Kk, Nn, nv, nblk, mode = 0;
            if (r < I_GU) { Wsrc = a.in[14]; Kk = DM; Nn = DFF; nv = DFF; nblk = 176; dst = Wgu_t; mode = 1; gain = a.in[13]; }
            else if ((r -= I_GU) < I_GU) { Wsrc = a.in[15]; Kk = DM; Nn = DFF; nv = DFF; nblk = 176; dst = Wgu_t; mode = 2; gain = a.in[13]; }
            else if ((r -= I_GU) < I_DN) { Wsrc = a.in[16]; Kk = DFF; Nn = DM; nv = DM; nblk = 64; dst = Wd_t; }
            else if ((r -= I_DN) < I_IN) { Wsrc = a.in[3]; Kk = DM; Nn = INW; nv = INW; nblk = 120; dst = Win_t; }
            else if ((r -= I_IN) < I_SQ) { Wsrc = a.in[12]; Kk = DM; Nn = DM; nv = DM; nblk = 64; dst = Wout_t; }
            else if ((r -= I_SQ) < I_SQ) { Wsrc = a.in[18]; Kk = DM; Nn = DM; nv = DM; nblk = 64; dst = Wpg_t; gain = a.in[17]; }
            else if ((r -= I_SQ) < I_PP) { Wsrc = a.in[19]; Kk = PLE; Nn = DM; nv = DM; nblk = 64; dst = Wpp_t; }
            else if ((r -= I_PP) < 4 * I_PW) { const int gq = r / I_PW; r -= gq * I_PW; Wsrc = a.in[4] + gq * 65536; Kk = 256; Nn = 256; nv = 256; nblk = 8; dst = poolw_t + gq * 65536; }
            else if ((r -= 4 * I_PW) < I_W1) { Wsrc = a.in[7]; Kk = 4096; Nn = 128; nv = 128; nblk = 4; dst = W1k; }
            else if ((r -= I_W1) < I_W1) { Wsrc = a.in[10]; Kk = 4096; Nn = 128; nv = 128; nblk = 4; dst = W1v; }
            else if ((r -= I_W1) < I_W2) { Wsrc = a.in[8]; Kk = 128; Nn = 128; nv = 128; nblk = 4; dst = W2k; }
            else { r -= I_W2; Wsrc = a.in[11]; Kk = 128; Nn = 128; nv = 128; nblk = 4; dst = W2v; }
            const int grp = r >> 3, wq = r & 7, gpr = nblk >> 2, gkb = grp / gpr, gnb = grp - gkb * gpr; const int kb = gkb * 2 + (wq >> 2), nb = gnb * 4 + (wq & 3), n0 = nb * 32;
            const int drow = mode == 0 ? n0 : ((n0 >> 7) * 256 + (n0 & 127) + (mode == 2 ? 128 : 0));
            tr_item(Wsrc, Kk, Nn, nv, dst, drow, scr, kb * 64, n0, lane, gain);
        }
        for (int m = gw; m < MROWS; m += NGW) rms_row<true>(x + (size_t)m * DM, a.in[2], XN + (size_t)m * DM, lane);
        for (int i = gtid; i < MROWS * PLE / 4; i += GT) { const f32x4 v = ((const f32x4*)a.in[1])[i]; u32x2 w; w.x = cvt_pk_bf16(v[0], v[1]); w.y = cvt_pk_bf16(v[2], v[3]); ((u32x2*)PBF)[i] = w; }
        for (int i = gtid; i < 3 * MROWS; i += GT) { if (i < MROWS) rowss1[i] = 0.f; else if (i < 2 * MROWS) rowss2[i - MROWS] = 0.f; else rowss3[i - 2 * MROWS] = 0.f; }
        for (int i = (G == 256 ? (tid < 128 ? bid * 128 + tid : SEQ * 16) : gtid); i < SEQ * 16; i += GT) { const int pos = i >> 4, fi = i & 15; const float inv = exp2f(-(float)fi * (18.931568569324174f / 16.f)); const float ang = (float)pos * inv;
            cosT[i] = cosf(ang); sinT[i] = sinf(ang); }
        __syncthreads();
        for (int tsk = (G == 256 ? bid - 192 : bid); tsk < 64; tsk += G) { if (tsk < 0) break;
            const int kv = tsk >> 5, l = tsk & 31; const float* pe = a.in[kv == 0 ? 6 : 9] + l * 128; const float* w1 = a.in[kv == 0 ? 7 : 10] + (size_t)l * 128 * 128;
            const int cc = tid & 127, part = tid >> 7; float s = 0.f;
#pragma unroll 8
            for (int k = part * 32; k < part * 32 + 32; ++k) s += pe[k] * w1[(size_t)k * 128 + cc];
            LAS float* red = (LAS float*)lds; red[part * 128 + cc] = s; __syncthreads();
            if (tid < 128) biasp[(size_t)tsk * 128 + tid] = (red[tid] + red[128 + tid]) + (red[256 + tid] + red[384 + tid]);
            __syncthreads();
        }
    }
    }
#endif
    if (a.ph_lo <= 0 && 1 < a.ph_hi) xcd_barrier(xb);
#ifndef SKIP_P1
#ifndef REP1
#define REP1 1
#endif
    if (a.ph_lo <= 1 && 1 < a.ph_hi) for (int rep1 = 0; rep1 < REP1; ++rep1) {
        if (rep1) xcd_barrier(xb);
    {
        pg8::Gemm g{XN, Win_t, MROWS, INWP, DM}; pg8::StaticOrder S; S.init(MROWS, INWP, G, bid);
        EpiInProj E{T, gatesb, cosT, sinT};
        pg8::gemm_phase<EpiInProj, pg8::StaticOrder, true, true>(lds, g, S, E);
    }
    }
#endif
    if (a.ph_lo <= 1 && 2 < a.ph_hi) xcd_barrier(xb);
#ifndef SKIP_P2
#ifndef REP2
#define REP2 1
#endif
    if (a.ph_lo <= 2 && 2 < a.ph_hi) for (int rep2 = 0; rep2 < REP2; ++rep2) {
        if (rep2) xcd_barrier(xb);
    {
        pg8::Gemm g{T, poolw_t, 4 * MROWS, 1024, 256}; PoolOrder S{G, bid}; EpiPoolZ E{Z};
        pg8::gemm_phase<EpiPoolZ, PoolOrder, true, true>(lds, g, S, E);
        signal_done<false>(ctl + 64, bid < 128 ? (unsigned)((127 - bid) / G + 1) : 0u);
        unsigned njobs = 0;
        for (int job = G - 1 - bid; job < 128; job += G) {
            const int kv = job >> 6, b = (job >> 4) & 3, gg = (job >> 3) & 1, n0 = (job & 7) * 16;
            compress_job(lds, T + (size_t)(8 + kv) * TS, kv ? W1v : W1k, kv ? W2v : W2k, biasp + (size_t)kv * 32 * 128, kv ? vcmp : kcmp, b, gg, n0);
            ++njobs;
        }
        signal_done<false>(ctl, njobs);
    }
    }
#endif
#ifndef SKIP_P3
#ifndef REP3
#define REP3 1
#endif
    if (a.ph_lo <= 3 && 3 < a.ph_hi) for (int rep3 = 0; rep3 < REP3; ++rep3) {
        if (rep3) xcd_barrier(xb);
    {
        bf16_t* CAT = XN;
        for (int u = bid; u < 256; u += G) { const int bg = u & 7, c = (u < 128) ? 16 + (u >> 3) : 15 - ((u - 128) >> 3); att::attn_unit(lds, T, kcmp, vcmp, gatesb, SCR, hbuf, CAT, bg >> 1, bg & 1, c, ctl); }
        wait_count(ctl + 64, 128u);
        { const int per = (MROWS + G - 1) / G; const int r0 = bid * per; const int nr = min(per, MROWS - r0); if (nr > 0) for (int repf = 0; repf < REPF; ++repf) pool_finalize(Z, a.in[5], CAT, r0, nr); }
    }
    }
#endif
    if (a.ph_lo <= 3 && 4 < a.ph_hi) xcd_barrier(xb);
#ifndef SKIP_P4
    if (a.ph_lo <= 4 && 4 < a.ph_hi) {
    {
        pg8::Gemm g{XN, Wout_t, MROWS, DM, DM}; pg8::StaticOrder S; S.init(MROWS, DM, G, bid); EpiResidNorm E{x, nullptr, HB1, rowss1};
        pg8::gemm_phase<EpiResidNorm, pg8::StaticOrder, true, true>(lds, g, S, E);
    }
    }
#endif
    if (a.ph_lo <= 4 && 5 < a.ph_hi) xcd_barrier(xb);
#ifndef SKIP_P5
    if (a.ph_lo <= 5 && 5 < a.ph_hi) {
    { }
    }
#endif
#ifndef SKIP_P6
#ifndef REP6
#define REP6 1
#endif
    if (a.ph_lo <= 6 && 6 < a.ph_hi) for (int rep6 = 0; rep6 < REP6; ++rep6) {
        if (rep6) xcd_barrier(xb);
    {
        pg8::Gemm g{HB1, Wgu_t, MROWS, 2 * DFF, DM}; pg8::StaticOrder S; S.init(MROWS, 2 * DFF, G, bid); EpiSwiglu E{ACT, rowss1};
        pg8::gemm_phase<EpiSwiglu, pg8::StaticOrder, true, true>(lds, g, S, E);
        if (G == 256) {
            pg8::Gemm g2{PBF, Wpp_t, MROWS, DM, PLE}; UpperOrder S2; S2.S.init(MROWS, DM, 1, 0); S2.lo = 128; S2.nup = 128; S2.c = bid; EpiStoreBf16 E2{PP, DM};
            pg8::gemm_phase<EpiStoreBf16, UpperOrder, true, true>(lds, g2, S2, E2);
        } else { pg8::Gemm g2{PBF, Wpp_t, MROWS, DM, PLE}; pg8::StaticOrder S2; S2.init(MROWS, DM, G, bid); EpiStoreBf16 E2{PP, DM}; pg8::gemm_phase<EpiStoreBf16, pg8::StaticOrder, true, true>(lds, g2, S2, E2); }
    }
    }
#endif
    if (a.ph_lo <= 6 && 7 < a.ph_hi) xcd_barrier(xb);
#ifndef SKIP_P7
    if (a.ph_lo <= 7 && 7 < a.ph_hi) {
    {
        pg8::Gemm g{ACT, Wd_t, MROWS, DM, DFF}; pg8::StaticOrder S; S.init(MROWS, DM, G, bid); EpiResidNorm E{nullptr, HB1, XN, rowss2};
        pg8::gemm_phase<EpiResidNorm, pg8::StaticOrder, true, true>(lds, g, S, E);
    }
    }
#endif
    if (a.ph_lo <= 7 && 8 < a.ph_hi) xcd_barrier(xb);
#ifndef SKIP_P8
    if (a.ph_lo <= 8 && 8 < a.ph_hi) {
    {
    }
    }
#endif
    __syncthreads();
#ifndef SKIP_P9
    if (a.ph_lo <= 9 && 9 < a.ph_hi) {
    {
        pg8::Gemm g{XN, Wpg_t, MROWS, DM, DM}; pg8::StaticOrder S; S.init(MROWS, DM, G, bid); EpiPle E{XN, PP, rowss2, HB1, rowss3};
        pg8::gemm_phase<EpiPle, pg8::StaticOrder, true, true>(lds, g, S, E);
    }
    }
#endif
    if (a.ph_lo <= 9 && 10 < a.ph_hi) xcd_barrier(xb);
#ifdef EXTRA_SYNCS
    for (int es = 0; es < EXTRA_SYNCS; ++es) xcd_barrier(xb);
#endif
#ifndef SKIP_P10
    if (a.ph_lo <= 10 && 10 < a.ph_hi) {
#ifdef DBG_STOP
        { PHASE_IDS(); const bf16_t* dbg = (const bf16_t*)(ws + (size_t)DBG_OFF * MiB);
          for (size_t i = gtid; i < (size_t)MROWS * DM; i += GT) {
#ifdef DBG_NANDET
              const float bv = __uint_as_float((unsigned)((const bf16_t*)(ws + WS_KCMP))[i % 131072] << 16); const float wv = __uint_as_float((unsigned)((const bf16_t*)(ws + WS_VCMP))[i % 131072] << 16);
              const bool bad1 = !(fabsf(bv) < 1e30f), bad2 = !(fabsf(wv) < 1e30f);
              hbuf[i] = x[i] + (bad1 ? 1000.f : 0.f) + (bad2 ? 3000.f : 0.f);
#else
              float dv = __uint_as_float((unsigned)dbg[i % ((size_t)DBG_ELEMS)] << 16); if (!(fabsf(dv) < 1e30f)) dv = 1000.f; hbuf[i] = x[i] + DBG_SCALE * dv;
#endif
          } }
        xcd_barrier(xb);
#endif
    { PHASE_IDS();
      for (int m = gw; m < MROWS; m += NGW) { const float rstd = 1.0f / sqrtf(rowss3[m] * (1.f / DM) + 1e-6f); const u32x2* hr = (const u32x2*)(HB1 + (size_t)m * DM); f32x4* orow = (f32x4*)(hbuf + (size_t)m * DM);
#pragma unroll
          for (int j = 0; j < 8; ++j) { const u32x2 w = hr[lane + 64 * j]; const f32x4 gv = ((const f32x4*)a.in[20])[lane + 64 * j];
              const f32x4 v = {__uint_as_float(w.x << 16), __uint_as_float(w.x & 0xffff0000u), __uint_as_float(w.y << 16), __uint_as_float(w.y & 0xffff0000u)};
              orow[lane + 64 * j] = v * rstd * gv; } } }
    }
#endif
}

extern "C" void kernel_launch(void* const* d_in, const int* in_sizes, int n_in, void* d_out, int out_size, void* d_ws, size_t ws_size, hipStream_t stream) {
    static int grid = 0;
    if (grid == 0) {
        if (n_in != 21 || in_sizes[0] != MROWS * DM || out_size != MROWS * DM || ws_size < WS_END) {
            fprintf(stderr, "kernel_launch: unexpected shapes (n_in %d, in0 %d, out %d, ws %zu < %zu)\n", n_in, n_in > 0 ? in_sizes[0] : -1, out_size, ws_size, (size_t)WS_END); grid = -1; return; }
        int dev = 0, cus = 0, per_cu = 0;
        hipGetDevice(&dev); hipDeviceGetAttribute(&cus, hipDeviceAttributeMultiprocessorCount, dev);
        if (hipFuncSetAttribute((const void*)hymba_fwd, hipFuncAttributeMaxDynamicSharedMemorySize, LDS_BYTES) != hipSuccess) { fprintf(stderr, "kernel_launch: hipFuncSetAttribute failed\n"); grid = -1; return; }
        if (hipOccupancyMaxActiveBlocksPerMultiprocessor(&per_cu, (const void*)hymba_fwd, NTHREADS, LDS_BYTES) != hipSuccess || per_cu < 1) { fprintf(stderr, "kernel_launch: occupancy query failed (%d)\n", per_cu); grid = -1; return; }
        grid = cus * per_cu;
        fprintf(stderr, "kernel_launch: %d CUs x %d blocks/CU -> grid %d\n", cus, per_cu, grid);
    }
    if (grid < 0) return;
    Args a{};
    for (int i = 0; i < 21; ++i) a.in[i] = (const float*)d_in[i];
    a.out = (float*)d_out; a.ws = (unsigned char*)d_ws;
#if MK_PER_PHASE
    hipError_t e = hipSuccess;
#ifdef DBG_STOP
    for (int k = 0; k <= DBG_STOP; ++k) { a.ph_lo = k; a.ph_hi = k + 1; hipLaunchKernelGGL(hymba_fwd, dim3(grid), dim3(NTHREADS), LDS_BYTES, stream, a); }
    { a.ph_lo = 10; a.ph_hi = 11; void* args[] = {&a}; (void)hipLaunchCooperativeKernel((const void*)hymba_fwd, dim3(grid), dim3(NTHREADS), args, LDS_BYTES, stream); }
#else
    for (int k = 0; k < 11; ++k) { a.ph_lo = k; a.ph_hi = k + 1; hipLaunchKernelGGL(hymba_fwd, dim3(grid), dim3(NTHREADS), LDS_BYTES, stream, a); }
#endif
    e = hipPeekAtLastError();
#else
    a.ph_lo = 0; a.ph_hi = 11;
    if (hipMemsetAsync((char*)d_ws + 262144, 0, 32768, stream) != hipSuccess) { fprintf(stderr, "kernel_launch: hipMemsetAsync failed\n"); return; }
    void* args[] = {&a};
    hipError_t e = hipLaunchCooperativeKernel((const void*)hymba_fwd, dim3(grid), dim3(NTHREADS), args, LDS_BYTES, stream);
#endif
    if (e != hipSuccess) fprintf(stderr, "kernel_launch: cooperative launch failed: %s (grid %d)\n", hipGetErrorString(e), grid);
}
```

```cpp
#include <hip/hip_runtime.h>
#include <cstdio>
#include <cstdint>
#include <cmath>
#define ATT_NOANY 1
namespace pg8 {
#define PG8_LAS __attribute__((address_space(3)))
typedef unsigned short bf16_t;
typedef short bf16x8 __attribute__((ext_vector_type(8)));
typedef float f32x4 __attribute__((ext_vector_type(4)));
typedef unsigned u32x4 __attribute__((ext_vector_type(4)));
constexpr int BM = 256, BK = 64, HALF = 128, HTB = HALF * BK * 2  , STAGE_BYTES = 8 * HTB, NXCD = 8, WGM = 8;

__host__ __device__ __forceinline__ int lds_byte(int r, int c) { const int st = (r >> 4) * 2 + (c >> 5), rr = r & 15, cc = c & 31, ob = rr * 64 + cc * 2; return st * 1024 + (ob ^ (((ob >> 9) & 1) << 5)); }
__host__ __device__ __forceinline__ void stage_rc(int b, int& R, int& C) { const int st = b / 1024, sb = b % 1024, swz = sb ^ (((sb >> 9) & 1) << 5); R = (st >> 1) * 16 + swz / 64; C = (st & 1) * 32 + (swz % 64) / 2; }
__host__ __device__ __forceinline__ int perm32(int rho) { const int n = rho >> 4, i = rho & 15; return 8 * (i >> 2) + 4 * n + (i & 3); }

struct Unit { int pm, pn; };
struct Gemm { const bf16_t* A; const bf16_t* Bt; int M, N, K; };

struct StaticOrder {
    int nM, nN, nwg, G, c;
    __host__ __device__ void init(int M, int N, int G_, int c_) { nM = M / BM; nN = N / BM; nwg = nM * nN; G = G_; c = c_; }
    __host__ __device__ bool next(int i, Unit& u) const {
        const long L = (long)i * G + c; if (L >= nwg) return false;
        int wgid = (int)L; { const int q = nwg / NXCD, r = nwg % NXCD, xcd = wgid % NXCD, off = wgid / NXCD; wgid = (xcd < r ? xcd * (q + 1) : r * (q + 1) + (xcd - r) * q) + off; }
        const int nig = WGM * nN, gid = wgid / nig, fm = gid * WGM, gsz = (nM - fm) < WGM ? (nM - fm) : WGM;
        u.pm = fm + ((wgid % nig) % gsz); u.pn = (wgid % nig) / gsz; return true;
    }
    __host__ __device__ bool next_linear(long L, Unit& u) const {
        if (L >= nwg) return false;
        int wgid = (int)L; { const int q = nwg / NXCD, r = nwg % NXCD, xcd = wgid % NXCD, off = wgid / NXCD; wgid = (xcd < r ? xcd * (q + 1) : r * (q + 1) + (xcd - r) * q) + off; }
        const int nig = WGM * nN, gid = wgid / nig, fm = gid * WGM, gsz = (nM - fm) < WGM ? (nM - fm) : WGM;
        u.pm = fm + ((wgid % nig) % gsz); u.pn = (wgid % nig) / gsz; return true;
    }
    __device__ __forceinline__ void a_ready(const Unit&) const {}
    __device__ __forceinline__ void done(const Unit&) const {}
};

typedef float f32x2_cv __attribute__((ext_vector_type(2))); typedef __bf16 bf16x2_cv __attribute__((ext_vector_type(2)));
__device__ __forceinline__ unsigned cvt_pk_bf16(float lo, float hi) { f32x2_cv v = {lo, hi}; bf16x2_cv b = __builtin_convertvector(v, bf16x2_cv); return __builtin_bit_cast(unsigned, b); }
template <class Epi, class Sched, bool ALIGN_EPI = false, bool SP2 = false>
__device__ __forceinline__ void gemm_phase(PG8_LAS unsigned char* lds, const Gemm g, const Sched& S, const Epi& E) {
    int tid_ = threadIdx.x; asm volatile("" : "+v"(tid_));
    const int tid = tid_, wid = __builtin_amdgcn_readfirstlane(tid >> 6), lane = tid & 63, wr = wid >> 2, wc = wid & 3, fr = lane & 15, fq = lane >> 4;
    const int K = g.K, nt = K / BK;
    unsigned voffA[2], voffB[2];
#pragma unroll
    for (int i = 0; i < 2; ++i) { int R, C; stage_rc(tid * 16 + i * 8192, R, C); const int Rb = Epi::PERM ? ((R & ~31) + perm32(R & 31)) : R;
        voffA[i] = (unsigned)(R * K + C) * 2u; voffB[i] = (unsigned)(Rb * K + C) * 2u; }
    const size_t kstep = (size_t)(BK * 2);
    const size_t hstep = (size_t)HALF * K * 2;
    const size_t tstep = 2 * hstep;
    const unsigned ldsw = (unsigned)wid * 1024u;
    const int aoff = lds_byte(wr * 64 + fr, fq * 8), boff = lds_byte(wc * 32 + fr, fq * 8);
#define PG8_SA(b, h) (((b) * 2 + (h)) * HTB)
#define PG8_SB(b, h) ((4 + (b) * 2 + (h)) * HTB)
#define PG8_STAGE(bufoff, gbase, voff) do { _Pragma("unroll") for (int _i = 0; _i < 2; ++_i) \
        __builtin_amdgcn_global_load_lds((const unsigned*)((const char*)(gbase) + (voff)[_i]), (PG8_LAS unsigned*)(lds + (bufoff) + ldsw + _i * 8192), 16, 0, 0); } while (0)
#define PG8_LDA(dst, b, h) do { _Pragma("unroll") for (int m = 0; m < 4; ++m) _Pragma("unroll") for (int k = 0; k < 2; ++k) dst[m][k] = *(const PG8_LAS bf16x8*)(lds + PG8_SA(b, h) + aoff + m * 2048 + k * 1024); } while (0)
#define PG8_LDB(dst, b, h) do { _Pragma("unroll") for (int n = 0; n < 2; ++n) _Pragma("unroll") for (int k = 0; k < 2; ++k) dst[n][k] = *(const PG8_LAS bf16x8*)(lds + PG8_SB(b, h) + boff + n * 2048 + k * 1024); } while (0)
#define PG8_MMA(ai, bj, At, Bt) do { __builtin_amdgcn_s_setprio(1); _Pragma("unroll") for (int m = 0; m < 4; ++m) _Pragma("unroll") for (int n = 0; n < 2; ++n) _Pragma("unroll") for (int k = 0; k < 2; ++k) \
        acc[ai][bj][m][n] = __builtin_amdgcn_mfma_f32_16x16x32_bf16(Bt[n][k], At[m][k], acc[ai][bj][m][n], 0, 0, 0); __builtin_amdgcn_s_setprio(0); } while (0)
#define PG8_WAIT_V(n) asm volatile("s_waitcnt vmcnt(" #n ")" ::: "memory")
#define PG8_WAIT_L(n) asm volatile("s_waitcnt lgkmcnt(" #n ")" ::: "memory")
#define PG8_BAR __builtin_amdgcn_s_barrier()
#define PG8_SCHED __builtin_amdgcn_sched_barrier(0)
    Unit cur, nxt; int ui = 0;
    if (!S.next(0, cur)) return;
    f32x4 acc[2][2][4][2];
#pragma unroll
    for (int a = 0; a < 2; ++a)
#pragma unroll
        for (int b = 0; b < 2; ++b)
#pragma unroll
            for (int m = 0; m < 4; ++m)
#pragma unroll
                for (int n = 0; n < 2; ++n) acc[a][b][m][n] = (f32x4){0.f, 0.f, 0.f, 0.f};
    bf16x8 At[4][2], B0[2][2], B1[2][2];
    const char* cA = (const char*)g.A + (size_t)cur.pm * tstep; const char* cB = (const char*)g.Bt + (size_t)cur.pn * tstep;
    S.a_ready(cur);
    if constexpr (SP2) {
        PG8_STAGE(PG8_SB(0, 0), cB, voffB); PG8_STAGE(PG8_SB(0, 1), cB + hstep, voffB); PG8_STAGE(PG8_SA(0, 0), cA, voffA); PG8_STAGE(PG8_SA(0, 1), cA + hstep, voffA);
        if (wr == 1) PG8_BAR;
        PG8_WAIT_V(2); PG8_BAR;
        PG8_STAGE(PG8_SB(1, 0), cB + kstep, voffB); PG8_STAGE(PG8_SA(1, 0), cA + kstep, voffA); PG8_STAGE(PG8_SB(1, 1), cB + hstep + kstep, voffB);
        PG8_WAIT_V(6); PG8_BAR;
    } else {
        PG8_STAGE(PG8_SB(0, 0), cB, voffB); PG8_STAGE(PG8_SA(0, 0), cA, voffA); PG8_STAGE(PG8_SB(0, 1), cB + hstep, voffB); PG8_STAGE(PG8_SA(0, 1), cA + hstep, voffA);
        if (wr == 1) PG8_BAR;
        PG8_WAIT_V(4); PG8_BAR;
        PG8_STAGE(PG8_SB(1, 0), cB + kstep, voffB); PG8_STAGE(PG8_SA(1, 0), cA + kstep, voffA); PG8_STAGE(PG8_SB(1, 1), cB + hstep + kstep, voffB);
        PG8_WAIT_V(6); PG8_BAR;
    }
    for (;;) {
        const bool has_next = S.next(ui + 1, nxt);
        const char* nA = has_next ? (const char*)g.A + (size_t)nxt.pm * tstep : cA; const char* nB = has_next ? (const char*)g.Bt + (size_t)nxt.pn * tstep : cB;
        for (int t = 0; t < nt; t += 2) {
            const bool last = (t == nt - 2);
            const char* a1 = cA + (size_t)(t + 1) * kstep;
            const char* a2 = last ? nA : cA + (size_t)(t + 2) * kstep; const char* b2 = last ? nB : cB + (size_t)(t + 2) * kstep;
            const char* a3 = a2 + kstep; const char* b3 = b2 + kstep;
            if (last && has_next) S.a_ready(nxt);
            if constexpr (SP2) {
            PG8_LDB(B0, 0, 0); PG8_LDB(B1, 0, 1); PG8_SCHED; PG8_LDA(At, 0, 0); PG8_STAGE(PG8_SA(1, 1), a1 + hstep, voffA);
            PG8_WAIT_V(8); PG8_WAIT_L(0); PG8_BAR; PG8_MMA(0, 0, At, B0); PG8_MMA(0, 1, At, B1); PG8_BAR; PG8_SCHED;
            PG8_LDA(At, 0, 1); PG8_STAGE(PG8_SB(0, 0), b2, voffB); PG8_STAGE(PG8_SB(0, 1), b2 + hstep, voffB); PG8_STAGE(PG8_SA(0, 0), a2, voffA);
            PG8_WAIT_V(8); PG8_WAIT_L(0); PG8_BAR; PG8_MMA(1, 0, At, B0); PG8_MMA(1, 1, At, B1); PG8_BAR; PG8_SCHED;
            PG8_LDB(B0, 1, 0); PG8_LDB(B1, 1, 1); PG8_SCHED; PG8_LDA(At, 1, 0); PG8_STAGE(PG8_SA(0, 1), a2 + hstep, voffA);
            PG8_WAIT_V(8); PG8_WAIT_L(0); PG8_BAR; PG8_MMA(0, 0, At, B0); PG8_MMA(0, 1, At, B1); PG8_BAR; PG8_SCHED;
            PG8_LDA(At, 1, 1); PG8_STAGE(PG8_SB(1, 0), b3, voffB); PG8_STAGE(PG8_SB(1, 1), b3 + hstep, voffB); PG8_STAGE(PG8_SA(1, 0), a3, voffA);
            PG8_WAIT_V(8); PG8_WAIT_L(0); PG8_BAR; PG8_MMA(1, 0, At, B0); PG8_MMA(1, 1, At, B1); PG8_BAR; PG8_SCHED;
            } else {
            PG8_LDB(B0, 0, 0); PG8_SCHED; PG8_LDA(At, 0, 0); PG8_STAGE(PG8_SA(1, 1), a1 + hstep, voffA);
            PG8_WAIT_L(8); PG8_BAR; PG8_WAIT_L(0); PG8_MMA(0, 0, At, B0); PG8_BAR; PG8_SCHED;
            PG8_LDB(B1, 0, 1); PG8_STAGE(PG8_SB(0, 0), b2, voffB);
            PG8_BAR; PG8_WAIT_L(0); PG8_MMA(0, 1, At, B1); PG8_BAR;
            PG8_LDA(At, 0, 1); PG8_STAGE(PG8_SA(0, 0), a2, voffA);
            PG8_BAR; PG8_WAIT_L(0); PG8_MMA(1, 0, At, B0); PG8_BAR; PG8_SCHED;
            PG8_STAGE(PG8_SB(0, 1), b2 + hstep, voffB);
            PG8_WAIT_V(6); PG8_BAR; PG8_MMA(1, 1, At, B1); PG8_BAR;
            PG8_LDB(B0, 1, 0); PG8_SCHED; PG8_LDA(At, 1, 0); PG8_STAGE(PG8_SA(0, 1), a2 + hstep, voffA);
            PG8_WAIT_L(8); PG8_BAR; PG8_WAIT_L(0); PG8_MMA(0, 0, At, B0); PG8_BAR; PG8_SCHED;
            PG8_LDB(B1, 1, 1); PG8_STAGE(PG8_SB(1, 0), b3, voffB);
            PG8_BAR; PG8_WAIT_L(0); PG8_MMA(0, 1, At, B1); PG8_BAR;
            PG8_LDA(At, 1, 1); PG8_STAGE(PG8_SA(1, 0), a3, voffA);
            PG8_BAR; PG8_WAIT_L(0); PG8_MMA(1, 0, At, B0); PG8_BAR; PG8_SCHED;
            PG8_STAGE(PG8_SB(1, 1), b3 + hstep, voffB);
            PG8_WAIT_V(6); PG8_BAR; PG8_MMA(1, 1, At, B1); PG8_BAR;
            }
        }
        if constexpr (ALIGN_EPI) { if (wr == 0) PG8_BAR; }
        if constexpr (!Epi::AFTER_DRAIN) { E(acc, cur, wr, wc, fr, fq); S.done(cur); }
        if (!has_next) break;
#pragma unroll
        for (int a = 0; a < 2; ++a)
#pragma unroll
            for (int b = 0; b < 2; ++b)
#pragma unroll
                for (int m = 0; m < 4; ++m)
#pragma unroll
                    for (int n = 0; n < 2; ++n) acc[a][b][m][n] = (f32x4){0.f, 0.f, 0.f, 0.f};
        cur = nxt; cA = nA; cB = nB; ++ui;
        if constexpr (ALIGN_EPI) { if (wr == 1) PG8_BAR; }
    }
    PG8_WAIT_V(0);
    if constexpr (!ALIGN_EPI) { if (wr == 0) PG8_BAR; }
    PG8_BAR;
    if constexpr (Epi::AFTER_DRAIN) { E.fused(acc, cur, wr, wc, fr, fq, lds, wid, lane); S.done(cur); }
#undef PG8_SA
#undef PG8_SB
#undef PG8_STAGE
#undef PG8_LDA
#undef PG8_LDB
#undef PG8_MMA
#undef PG8_WAIT_V
#undef PG8_WAIT_L
#undef PG8_BAR
#undef PG8_SCHED
}
}

using pg8::bf16_t; using pg8::bf16x8; using pg8::f32x4; using pg8::u32x4; using pg8::Unit; using pg8::cvt_pk_bf16;
#define LAS __attribute__((address_space(3)))
typedef short s16x4 __attribute__((ext_vector_type(4)));
typedef float f32x16 __attribute__((ext_vector_type(16)));
typedef unsigned u32x2 __attribute__((ext_vector_type(2)));

constexpr int DM = 2048, SEQ = 2048, MROWS = 8192, PLE = 256, INW = 3608, INWP = 3840, DFF = 5632;
constexpr int NTHREADS = 512;
constexpr size_t MiB = (size_t)1 << 20;
constexpr size_t TS = (size_t)MROWS * 256;
constexpr size_t WS_BIASK = 0, WS_BIASV = 512;
constexpr size_t WS_COS = 1 * MiB, WS_SIN = 1 * MiB + 131072, WS_GATES = 1 * MiB + 262144;
constexpr size_t WS_KCMP = 2 * MiB, WS_VCMP = 2 * MiB + 262144, WS_W2K = 2 * MiB + 524288, WS_W2V = WS_W2K + 32768;
constexpr size_t WS_W1K = 3 * MiB, WS_W1V = 4 * MiB, WS_POOLW = 5 * MiB, WS_WPP = 6 * MiB, WS_WIN = 7 * MiB, WS_WOUT = 22 * MiB;
constexpr size_t WS_WPG = 30 * MiB, WS_WD = 38 * MiB, WS_WGU = 60 * MiB, WS_PBF = 104 * MiB, WS_XN = 108 * MiB;
constexpr size_t WS_T = 140 * MiB, WS_Z = 196 * MiB, WS_SCR = 228 * MiB, WS_ACT = 140 * MiB, WS_PP = 140 * MiB, WS_END = 260 * MiB;
constexpr int LDS_BYTES = 147456;

#define LDS_WAIT() asm volatile("s_waitcnt lgkmcnt(0)" ::: "memory")
__device__ __forceinline__ float wave_sum(float v) {
#pragma unroll
    for (int o = 1; o < 64; o <<= 1) v += __shfl_xor(v, o);
    return v;
}
__device__ __forceinline__ float sigmoidf_(float x) { return __builtin_amdgcn_rcpf(1.f + __expf(-x)); }

struct EpiInProj {
    static constexpr bool PERM = true, AFTER_DRAIN = false;
    bf16_t* T; float* gates; const float* cosT; const float* sinT;
    __device__ __forceinline__ void operator()(const f32x4 (&acc)[2][2][4][2], const Unit& u, int wr, int wc, int fr, int fq) const {
        const int pn = u.pn; const int row0 = u.pm * 256 + wr * 64 + fr;
        if (pn < 14) {
            const bool rope = (wc == 0) && (pn >= 4) && (pn < 8 || ((pn & 1) == 0));
            bf16_t* base = T + (size_t)pn * TS;
#pragma unroll
            for (int ai = 0; ai < 2; ++ai)
#pragma unroll
                for (int m = 0; m < 4; ++m) {
                    const int row = row0 + ai * 128 + m * 16; const int pos = row & (SEQ - 1);
                    f32x4 cs0 = {1.f, 1.f, 1.f, 1.f}, cs1 = cs0, sn0 = {0.f, 0.f, 0.f, 0.f}, sn1 = sn0;
                    if (rope) { const float* ct = cosT + pos * 16 + 8 * (fq & 1); const float* st = sinT + pos * 16 + 8 * (fq & 1);
                        cs0 = *(const f32x4*)ct; cs1 = *(const f32x4*)(ct + 4); sn0 = *(const f32x4*)st; sn1 = *(const f32x4*)(st + 4);
                        if (fq < 2) { sn0 = -sn0; sn1 = -sn1; } }
#pragma unroll
                    for (int bj = 0; bj < 2; ++bj) {
                        f32x4 v0 = acc[ai][bj][m][0], v1 = acc[ai][bj][m][1];
                        if (rope) { f32x4 o0, o1;
#pragma unroll
                            for (int j = 0; j < 4; ++j) { o0[j] = __shfl_xor(v0[j], 32); o1[j] = __shfl_xor(v1[j], 32); }
                            v0 = v0 * cs0 + o0 * sn0; v1 = v1 * cs1 + o1 * sn1; }
                        u32x4 w; w.x = cvt_pk_bf16(v0[0], v0[1]); w.y = cvt_pk_bf16(v0[2], v0[3]); w.z = cvt_pk_bf16(v1[0], v1[1]); w.w = cvt_pk_bf16(v1[2], v1[3]);
                        *(u32x4*)(base + (size_t)row * 256 + bj * 128 + wc * 32 + 8 * fq) = w;
                    }
                }
        } else if (wc == 0 && fq < 3) {
#pragma unroll
            for (int ai = 0; ai < 2; ++ai)
#pragma unroll
                for (int m = 0; m < 4; ++m) {
                    const int row = row0 + ai * 128 + m * 16;
                    const f32x4 v0 = acc[ai][0][m][0], v1 = acc[ai][0][m][1];
                    const f32x4 s0 = {sigmoidf_(v0[0]), sigmoidf_(v0[1]), sigmoidf_(v0[2]), sigmoidf_(v0[3])}, s1 = {sigmoidf_(v1[0]), sigmoidf_(v1[1]), sigmoidf_(v1[2]), sigmoidf_(v1[3])};
                    *(f32x4*)(gates + (size_t)row * 24 + 8 * fq) = s0; *(f32x4*)(gates + (size_t)row * 24 + 8 * fq + 4) = s1;
                }
        }
    }
};
struct PoolOrder {
    int G, c;
    __device__ bool next(int i, Unit& u) const { const int L = i * G + c; if (L >= 128) return false; u.pm = L; u.pn = L >> 5; return true; }
    __device__ __forceinline__ void a_ready(const Unit&) const {}
    __device__ __forceinline__ void done(const Unit&) const {}
};
struct EpiPoolZ {
    static constexpr bool PERM = false, AFTER_DRAIN = false;
    float* Z;
    __device__ __forceinline__ void operator()(const f32x4 (&acc)[2][2][4][2], const Unit& u, int wr, int wc, int fr, int fq) const {
        const int row0 = (u.pm & 31) * 256 + wr * 64 + fr; const int col0 = u.pn * 256 + wc * 32 + 4 * fq;
        const __amdgpu_buffer_rsrc_t zr = __builtin_amdgcn_make_buffer_rsrc(Z, 0, MROWS * 1024 * 4, 0x00020000);
#pragma unroll
        for (int ai = 0; ai < 2; ++ai)
#pragma unroll
            for (int m = 0; m < 4; ++m)
#pragma unroll
                for (int bj = 0; bj < 2; ++bj)
#pragma unroll
                    for (int n = 0; n < 2; ++n) __builtin_amdgcn_raw_buffer_store_b128(__builtin_bit_cast(u32x4, acc[ai][bj][m][n]), zr, (unsigned)(((row0 + ai * 128 + m * 16) * 1024 + col0 + bj * 128 + n * 16) * 4), 0, 16);
    }
};
struct EpiStoreBf16 {
    static constexpr bool PERM = false, AFTER_DRAIN = false;
    bf16_t* O; int ldc;
    __device__ __forceinline__ void operator()(const f32x4 (&acc)[2][2][4][2], const Unit& u, int wr, int wc, int fr, int fq) const {
        const int row0 = u.pm * 256 + wr * 64 + fr; const int col0 = u.pn * 256 + wc * 32 + 4 * fq;
#pragma unroll
        for (int ai = 0; ai < 2; ++ai)
#pragma unroll
            for (int m = 0; m < 4; ++m)
#pragma unroll
                for (int bj = 0; bj < 2; ++bj)
#pragma unroll
                    for (int n = 0; n < 2; ++n) { const f32x4 v = acc[ai][bj][m][n]; u32x2 w; w.x = cvt_pk_bf16(v[0], v[1]); w.y = cvt_pk_bf16(v[2], v[3]);
                        *(u32x2*)(O + (size_t)(row0 + ai * 128 + m * 16) * ldc + col0 + bj * 128 + n * 16) = w; }
    }
};
struct EpiResid {
    static constexpr bool PERM = false, AFTER_DRAIN = false;
    const float* base; float* out;
    __device__ __forceinline__ void operator()(const f32x4 (&acc)[2][2][4][2], const Unit& u, int wr, int wc, int fr, int fq) const {
        const int row0 = u.pm * 256 + wr * 64 + fr; const int col0 = u.pn * 256 + wc * 32 + 4 * fq;
#pragma unroll
        for (int ai = 0; ai < 2; ++ai)
#pragma unroll
            for (int m = 0; m < 4; ++m)
#pragma unroll
                for (int bj = 0; bj < 2; ++bj)
#pragma unroll
                    for (int n = 0; n < 2; ++n) { const size_t off = (size_t)(row0 + ai * 128 + m * 16) * DM + col0 + bj * 128 + n * 16;
                        const f32x4 b = *(const f32x4*)(base + off); *(f32x4*)(out + off) = b + acc[ai][bj][m][n]; }
    }
};
struct EpiResidNorm {
    static constexpr bool PERM = true, AFTER_DRAIN = false;
    const float* basef; const bf16_t* baseb; bf16_t* hb; float* rowss;
    __device__ __forceinline__ void operator()(const f32x4 (&acc)[2][2][4][2], const Unit& u, int wr, int wc, int fr, int fq) const {
        const int row0 = u.pm * 256 + wr * 64 + fr; const int col0 = u.pn * 256 + wc * 32 + 8 * fq;
#pragma unroll
        for (int ai = 0; ai < 2; ++ai)
#pragma unroll
            for (int m = 0; m < 4; ++m) { const int row = row0 + ai * 128 + m * 16; float ss = 0.f;
#pragma unroll
                for (int bj = 0; bj < 2; ++bj) { const size_t off = (size_t)row * DM + col0 + bj * 128;
                    f32x4 b0, b1;
                    if (basef) { b0 = *(const f32x4*)(basef + off); b1 = *(const f32x4*)(basef + off + 4); }
                    else { const u32x4 bw = *(const u32x4*)(baseb + off);
                        b0 = (f32x4){__uint_as_float(bw.x << 16), __uint_as_float(bw.x & 0xffff0000u), __uint_as_float(bw.y << 16), __uint_as_float(bw.y & 0xffff0000u)};
                        b1 = (f32x4){__uint_as_float(bw.z << 16), __uint_as_float(bw.z & 0xffff0000u), __uint_as_float(bw.w << 16), __uint_as_float(bw.w & 0xffff0000u)}; }
                    const f32x4 o0 = b0 + acc[ai][bj][m][0], o1 = b1 + acc[ai][bj][m][1];
                    u32x4 w; w.x = cvt_pk_bf16(o0[0], o0[1]); w.y = cvt_pk_bf16(o0[2], o0[3]); w.z = cvt_pk_bf16(o1[0], o1[1]); w.w = cvt_pk_bf16(o1[2], o1[3]);
                    *(u32x4*)(hb + off) = w;
                    ss += ((o0[0] * o0[0] + o0[1] * o0[1]) + (o0[2] * o0[2] + o0[3] * o0[3])) + ((o1[0] * o1[0] + o1[1] * o1[1]) + (o1[2] * o1[2] + o1[3] * o1[3])); }
                ss += __shfl_xor(ss, 16); ss += __shfl_xor(ss, 32);
                if (fq == 0) unsafeAtomicAdd(rowss + row, ss); }
    }
};
struct UpperOrder {
    pg8::StaticOrder S; int lo, nup, c;
    __device__ bool next(int i, Unit& u) const { if (c < lo) return false; return S.next_linear((long)i * nup + (c - lo), u); }
    __device__ __forceinline__ void a_ready(const Unit&) const {}
    __device__ __forceinline__ void done(const Unit&) const {}
};
struct EpiSwiglu {
    static constexpr bool PERM = true, AFTER_DRAIN = false;
    bf16_t* O; const float* rowss;
    __device__ __forceinline__ void operator()(const f32x4 (&acc)[2][2][4][2], const Unit& u, int wr, int wc, int fr, int fq) const {
        const int row0 = u.pm * 256 + wr * 64 + fr; const int col0 = u.pn * 128 + wc * 32 + 8 * fq;
#pragma unroll
        for (int ai = 0; ai < 2; ++ai)
#pragma unroll
            for (int m = 0; m < 4; ++m) {
                const float rs = 1.0f / sqrtf(rowss[row0 + ai * 128 + m * 16] * (1.f / DM) + 1e-6f);
                float r[8];
#pragma unroll
                for (int n = 0; n < 2; ++n)
#pragma unroll
                    for (int j = 0; j < 4; ++j) { const float g = acc[ai][0][m][n][j] * rs, up = acc[ai][1][m][n][j] * rs; r[n * 4 + j] = g * sigmoidf_(g) * up; }
                u32x4 w; w.x = cvt_pk_bf16(r[0], r[1]); w.y = cvt_pk_bf16(r[2], r[3]); w.z = cvt_pk_bf16(r[4], r[5]); w.w = cvt_pk_bf16(r[6], r[7]);
                *(u32x4*)(O + (size_t)(row0 + ai * 128 + m * 16) * DFF + col0) = w;
            }
    }
};
struct EpiPle {
    static constexpr bool PERM = true, AFTER_DRAIN = false;
    const bf16_t* h; const bf16_t* pp; const float* rowss; bf16_t* hb3; float* rowss_out;
    __device__ __forceinline__ void operator()(const f32x4 (&acc)[2][2][4][2], const Unit& u, int wr, int wc, int fr, int fq) const {
        const int row0 = u.pm * 256 + wr * 64 + fr; const int col0 = u.pn * 256 + wc * 32 + 8 * fq;
#pragma unroll
        for (int ai = 0; ai < 2; ++ai)
#pragma unroll
            for (int m = 0; m < 4; ++m) { const int row = row0 + ai * 128 + m * 16; const float rs = 1.0f / sqrtf(rowss[row] * (1.f / DM) + 1e-6f); float ss = 0.f;
#pragma unroll
                for (int bj = 0; bj < 2; ++bj) { const size_t off = (size_t)row * DM + col0 + bj * 128;
                    const u32x4 bw = *(const u32x4*)(h + off); const u32x4 pw = *(const u32x4*)(pp + off);
                    const unsigned bwa[4] = {bw.x, bw.y, bw.z, bw.w}, pwa[4] = {pw.x, pw.y, pw.z, pw.w};
                    float o[8];
#pragma unroll
                    for (int e = 0; e < 8; ++e) { const float a_ = acc[ai][bj][m][e >> 2][e & 3] * rs;
                        const float bv = (e & 1) ? __uint_as_float(bwa[e >> 1] & 0xffff0000u) : __uint_as_float(bwa[e >> 1] << 16);
                        const float pv = (e & 1) ? __uint_as_float(pwa[e >> 1] & 0xffff0000u) : __uint_as_float(pwa[e >> 1] << 16);
                        o[e] = bv + pv * sigmoidf_(a_); ss += o[e] * o[e]; }
                    u32x4 w; w.x = cvt_pk_bf16(o[0], o[1]); w.y = cvt_pk_bf16(o[2], o[3]); w.z = cvt_pk_bf16(o[4], o[5]); w.w = cvt_pk_bf16(o[6], o[7]);
                    *(u32x4*)(hb3 + off) = w; }
                ss += __shfl_xor(ss, 16); ss += __shfl_xor(ss, 32);
                if (fq == 0) unsafeAtomicAdd(rowss_out + row, ss); }
    }
};

__device__ __forceinline__ void tr_item(const float* __restrict__ W, int K, int N, int nvalid, bf16_t* __restrict__ WT, int drow0, LAS float*, int k0, int n0, int lane, const float* __restrict__ gain = nullptr) {
    const int ko = lane & 7, nq = lane >> 3; const int n = n0 + 4 * nq; const bool ok = n < nvalid;
    const float* src = W + (size_t)(k0 + 8 * ko) * N + n;
    f32x4 v[8];
#pragma unroll
    for (int i = 0; i < 8; ++i) v[i] = ok ? __builtin_nontemporal_load((const f32x4*)(src + (size_t)i * N)) : (f32x4){0.f, 0.f, 0.f, 0.f};
    if (gain) { const f32x4 g0 = *(const f32x4*)(gain + k0 + 8 * ko), g1 = *(const f32x4*)(gain + k0 + 8 * ko + 4);
#pragma unroll
        for (int i = 0; i < 4; ++i) { v[i] = v[i] * g0[i]; v[4 + i] = v[4 + i] * g1[i]; } }
#pragma unroll
    for (int j = 0; j < 4; ++j) { u32x4 o; o.x = cvt_pk_bf16(v[0][j], v[1][j]); o.y = cvt_pk_bf16(v[2][j], v[3][j]); o.z = cvt_pk_bf16(v[4][j], v[5][j]); o.w = cvt_pk_bf16(v[6][j], v[7][j]);
        __builtin_nontemporal_store(o, (u32x4*)(WT + (size_t)(drow0 + 4 * nq + j) * K + k0 + 8 * ko)); }
}
template <bool OUT_BF16>
__device__ __forceinline__ void rms_row(const float* src, const float* __restrict__ g, void* dst, int lane) {
    const f32x4* xr = (const f32x4*)src + 2 * lane; f32x4 v[8]; float s = 0.f;
#pragma unroll
    for (int j = 0; j < 4; ++j) { v[2 * j] = xr[128 * j]; v[2 * j + 1] = xr[128 * j + 1]; }
#pragma unroll
    for (int j = 0; j < 8; ++j) s += (v[j][0] * v[j][0] + v[j][1] * v[j][1]) + (v[j][2] * v[j][2] + v[j][3] * v[j][3]);
    const float rstd = 1.0f / sqrtf(wave_sum(s) * (1.f / DM) + 1e-6f);
#pragma unroll
    for (int j = 0; j < 4; ++j) { const f32x4 g0 = ((const f32x4*)g)[2 * lane + 128 * j], g1 = ((const f32x4*)g)[2 * lane + 128 * j + 1];
        const f32x4 y0 = v[2 * j] * rstd * g0, y1 = v[2 * j + 1] * rstd * g1;
        if (OUT_BF16) { u32x4 w; w.x = cvt_pk_bf16(y0[0], y0[1]); w.y = cvt_pk_bf16(y0[2], y0[3]); w.z = cvt_pk_bf16(y1[0], y1[1]); w.w = cvt_pk_bf16(y1[2], y1[3]); ((u32x4*)dst)[lane + 64 * j] = w; }
        else { ((f32x4*)dst)[2 * lane + 128 * j] = y0; ((f32x4*)dst)[2 * lane + 128 * j + 1] = y1; } }
}

__device__ __forceinline__ float gelu_tanh(float x) { const float y = 0.7978845608028654f * (x + 0.044715f * x * x * x); const float e = __expf(2.f * y); return 0.5f * x * (2.f - 2.f * __builtin_amdgcn_rcpf(e + 1.f)); }
__device__ __forceinline__ void compress_job(LAS unsigned char* lds, const bf16_t* __restrict__ X, const bf16_t* __restrict__ W1t, const bf16_t* __restrict__ W2t,
                                             const float* __restrict__ bias, bf16_t* outc, int b, int g, int n0) {
    int tid_ = threadIdx.x; asm volatile("" : "+v"(tid_));
    const int tid = tid_, wid = __builtin_amdgcn_readfirstlane(tid >> 6), lane = tid & 63, fr = lane & 15, fq = lane >> 4;
    const int nn = min(n0 + fr, 126);
    const bf16_t* Ab = X + ((size_t)b * SEQ + 16 * nn) * 256 + g * 128 + 16 * fq;
    const bf16_t* Bb = W1t + (size_t)fr * 4096 + 16 * fq;
    f32x4 acc[8];
#pragma unroll
    for (int ct = 0; ct < 8; ++ct) acc[ct] = (f32x4){0.f, 0.f, 0.f, 0.f};
#pragma unroll 1
    for (int i = 0; i < 8; i += 2) {
        bf16x8 av[2][2], bv[2][8][2];
#pragma unroll
        for (int u = 0; u < 2; ++u) { const int pp = 8 * wid + i + u; const bf16_t* ap = Ab + (pp >> 1) * 256 + (pp & 1) * 64;
            av[u][0] = *(const bf16x8*)ap; av[u][1] = *(const bf16x8*)(ap + 8);
#pragma unroll
            for (int ct = 0; ct < 8; ++ct) { const bf16_t* bp = Bb + (size_t)ct * 16 * 4096 + 64 * pp; bv[u][ct][0] = *(const bf16x8*)bp; bv[u][ct][1] = *(const bf16x8*)(bp + 8); } }
        __builtin_amdgcn_sched_barrier(0);
#pragma unroll
        for (int u = 0; u < 2; ++u)
#pragma unroll
            for (int hh = 0; hh < 2; ++hh)
#pragma unroll
                for (int ct = 0; ct < 8; ++ct) acc[ct] = __builtin_amdgcn_mfma_f32_16x16x32_bf16(av[u][hh], bv[u][ct][hh], acc[ct], 0, 0, 0);
    }
    LAS float* part = (LAS float*)lds;
#pragma unroll
    for (int ct = 0; ct < 8; ++ct)
#pragma unroll
        for (int r = 0; r < 4; ++r) part[(wid * 16 + 4 * fq + r) * 132 + 16 * ct + fr] = acc[ct][r];
    __syncthreads();
    LAS bf16_t* hid = (LAS bf16_t*)(lds + 67584);
    { const int row = tid >> 5, c4 = (tid & 31) * 4; f32x4 s = *(const f32x4*)(bias + c4);
#pragma unroll 8
      for (int l = 1; l < 32; ++l) s += *(const f32x4*)(bias + l * 128 + c4);
#pragma unroll
      for (int w = 0; w < 8; ++w) s += *(const LAS f32x4*)(part + (w * 16 + row) * 132 + c4);
      u32x2 hw; hw.x = cvt_pk_bf16(gelu_tanh(s[0]), gelu_tanh(s[1])); hw.y = cvt_pk_bf16(gelu_tanh(s[2]), gelu_tanh(s[3]));
      *(LAS u32x2*)(hid + row * 136 + c4) = hw; }
    __syncthreads();
    f32x4 acc2 = {0.f, 0.f, 0.f, 0.f};
    const __amdgpu_buffer_rsrc_t orsrc = __builtin_amdgcn_make_buffer_rsrc(outc, 0, 8 * 128 * 128 * 2, 0x00020000);
#pragma unroll
    for (int s = 0; s < 4; ++s) { const bf16x8 a = *(const LAS bf16x8*)(hid + fr * 136 + 32 * s + 8 * fq);
        const bf16x8 bb = *(const bf16x8*)(W2t + (size_t)(16 * wid + fr) * 128 + 32 * s + 8 * fq); acc2 = __builtin_amdgcn_mfma_f32_16x16x32_bf16(a, bb, acc2, 0, 0, 0); }
#pragma unroll
    for (int r = 0; r < 4; ++r) { const int n = n0 + 4 * fq + r; const float v = (n == 127) ? 0.f : acc2[r];
        __builtin_amdgcn_raw_buffer_store_b16((short)(cvt_pk_bf16(v, v) & 0xffffu), orsrc, (unsigned)((((b * 2 + g) * 128 + n) * 128 + 16 * wid + fr) * 2), 0, 16); }
    __syncthreads();
}


template <bool FENCE>
__device__ __forceinline__ void signal_done(unsigned* cnt, unsigned n) {
    asm volatile("s_waitcnt vmcnt(0)" ::: "memory"); __syncthreads();
    if (threadIdx.x == 0 && n) { if (FENCE) { __builtin_amdgcn_fence(__ATOMIC_RELEASE, "agent"); asm volatile("s_waitcnt vmcnt(0)" ::: "memory"); }
        (void)__hip_atomic_fetch_add(cnt, n, __ATOMIC_RELAXED, __HIP_MEMORY_SCOPE_AGENT); }
}
__device__ __forceinline__ void wait_count(unsigned* cnt, unsigned want) {
    if (threadIdx.x == 0) { unsigned spins = 0;
        while (__hip_atomic_load(cnt, __ATOMIC_RELAXED, __HIP_MEMORY_SCOPE_AGENT) < want && ++spins < (1u << 22)) __builtin_amdgcn_s_sleep(2);
        __builtin_amdgcn_fence(__ATOMIC_ACQUIRE, "agent"); asm volatile("s_waitcnt vmcnt(0)" ::: "memory"); }
    __syncthreads();
}
namespace att {
constexpr float SCALE = 0.08838834764831845f, CL2 = SCALE * 1.4426950408889634f, NEGB = -1e30f;
#define KSWZ(row, colB) ((row) * 256 + ((colB) ^ (((row) & 7) << 4)))
#define SBAR() __builtin_amdgcn_sched_barrier(0)
__device__ __forceinline__ int crow(int r, int hi) { return (r & 3) + 8 * (r >> 2) + 4 * hi; }
__device__ __forceinline__ int v_st(int k, int c) { const int kk = (k & ~0xC) | ((k & 4) << 1) | ((k & 8) >> 1); return ((kk >> 3) * 4 + (c >> 5)) * 512 + ((kk & 7) * 32 + (c & 31)) * 2; }
__device__ __forceinline__ int v_rd_base(int lane) { return ((lane & 3) << 3) | (((lane >> 2) & 3) << 6) | (((lane >> 4) & 1) << 5) | (((lane >> 5) & 1) << 8); }
constexpr int v_rd_off(int d0, int ks, int half) { return d0 * 512 + ks * 4096 + half * 2048; }
template <int OFF> __device__ __forceinline__ s16x4 tr_read(int vb) { s16x4 r; asm volatile("ds_read_b64_tr_b16 %0, %1 offset:%2" : "=&v"(r) : "v"(vb), "i"(OFF) : "memory"); return r; }
template <int D0> __device__ __forceinline__ void pv_one(f32x16& od, int vb, bf16x8 pa0, bf16x8 pa1, bf16x8 pa2, bf16x8 pa3) {
    const s16x4 l0 = tr_read<v_rd_off(D0, 0, 0)>(vb), h0 = tr_read<v_rd_off(D0, 0, 1)>(vb), l1 = tr_read<v_rd_off(D0, 1, 0)>(vb), h1 = tr_read<v_rd_off(D0, 1, 1)>(vb);
    const s16x4 l2 = tr_read<v_rd_off(D0, 2, 0)>(vb), h2 = tr_read<v_rd_off(D0, 2, 1)>(vb), l3 = tr_read<v_rd_off(D0, 3, 0)>(vb), h3 = tr_read<v_rd_off(D0, 3, 1)>(vb);
    asm volatile("s_waitcnt lgkmcnt(0)" ::: "memory"); SBAR();
#define PK(L, H) (bf16x8){L[0], L[1], L[2], L[3], H[0], H[1], H[2], H[3]}
    __builtin_amdgcn_s_setprio(1);
    od = __builtin_amdgcn_mfma_f32_32x32x16_bf16(pa0, PK(l0, h0), od, 0, 0, 0);
    od = __builtin_amdgcn_mfma_f32_32x32x16_bf16(pa1, PK(l1, h1), od, 0, 0, 0);
    od = __builtin_amdgcn_mfma_f32_32x32x16_bf16(pa2, PK(l2, h2), od, 0, 0, 0);
    od = __builtin_amdgcn_mfma_f32_32x32x16_bf16(pa3, PK(l3, h3), od, 0, 0, 0);
    __builtin_amdgcn_s_setprio(0);
#undef PK
}
__device__ __forceinline__ void pv_d0(f32x16* o, int vb, bf16x8 pa0, bf16x8 pa1, bf16x8 pa2, bf16x8 pa3) {
    pv_one<0>(o[0], vb, pa0, pa1, pa2, pa3); pv_one<1>(o[1], vb, pa0, pa1, pa2, pa3); pv_one<2>(o[2], vb, pa0, pa1, pa2, pa3); pv_one<3>(o[3], vb, pa0, pa1, pa2, pa3);
}
__device__ __forceinline__ void qkt(f32x16& p0, f32x16& p1, const LAS char* Ks, const bf16x8* qr, int r32, int hi) {
    p0 = f32x16{}; p1 = f32x16{};
    __builtin_amdgcn_s_setprio(1);
#pragma unroll
    for (int d0 = 0; d0 < 8; ++d0) { const int cb = (d0 * 16 + hi * 8) * 2;
        const bf16x8 b0 = *(const LAS bf16x8*)(Ks + KSWZ(r32, cb));
        const bf16x8 b1 = *(const LAS bf16x8*)(Ks + KSWZ(32 + r32, cb));
        p0 = __builtin_amdgcn_mfma_f32_32x32x16_bf16(b0, qr[d0], p0, 0, 0, 0);
        p1 = __builtin_amdgcn_mfma_f32_32x32x16_bf16(b1, qr[d0], p1, 0, 0, 0);
#ifdef QKT_SBAR
        if ((d0 & (QKT_SBAR - 1)) == QKT_SBAR - 1) SBAR();
#endif
    }
    __builtin_amdgcn_s_setprio(0);
}
__device__ __forceinline__ void sm_step(f32x16& p0, f32x16& p1, bool lane_on, float& m_reg, float& l_reg, f32x16* o, LAS float* al_l, int r32, int hi,
                                        bf16x8& pa0, bf16x8& pa1, bf16x8& pa2, bf16x8& pa3, float& alpha_out) {
    float pmax = p0[0];
#pragma unroll
    for (int r = 1; r < 16; ++r) pmax = fmaxf(pmax, p0[r]);
#pragma unroll
    for (int r = 0; r < 16; ++r) pmax = fmaxf(pmax, p1[r]);
    pmax = lane_on ? pmax : NEGB;
    { auto rr = __builtin_amdgcn_permlane32_swap(__float_as_uint(pmax), __float_as_uint(pmax), false, false);
      pmax = fmaxf(__uint_as_float(rr[0]), __uint_as_float(rr[1])); }
    float mn, alpha;
    if (__all(pmax - m_reg <= 8.0f / SCALE)) { mn = m_reg; alpha = 1.f; }
    else { mn = fmaxf(m_reg, pmax); alpha = __builtin_amdgcn_exp2f((m_reg - mn) * CL2); }
    m_reg = mn; alpha_out = alpha;
    const float mnC = (!lane_on || mn < -1e29f) ? -INFINITY : -mn * CL2;
#pragma unroll
    for (int r = 0; r < 16; ++r) p0[r] = __builtin_amdgcn_exp2f(fmaf(p0[r], CL2, mnC));
#pragma unroll
    for (int r = 0; r < 16; ++r) p1[r] = __builtin_amdgcn_exp2f(fmaf(p1[r], CL2, mnC));
    float ps = 0.f;
#pragma unroll
    for (int r = 0; r < 16; ++r) ps += p0[r];
#pragma unroll
    for (int r = 0; r < 16; ++r) ps += p1[r];
    { auto rr = __builtin_amdgcn_permlane32_swap(__float_as_uint(ps), __float_as_uint(ps), false, false);
      ps = __uint_as_float(rr[0]) + __uint_as_float(rr[1]); }
    l_reg = l_reg * alpha + ps;
    if (__any(alpha < 1.f)) { if (hi == 0) al_l[r32] = alpha; LDS_WAIT();
#pragma unroll
        for (int d = 0; d < 4; ++d)
#pragma unroll
            for (int r = 0; r < 16; ++r) o[d][r] *= al_l[crow(r, hi)];
    }
#define PK4(P, BASE, OUT) do { unsigned a0_ = cvt_pk_bf16(P[BASE + 0], P[BASE + 1]), a1_ = cvt_pk_bf16(P[BASE + 2], P[BASE + 3]);   \
    unsigned b0_ = cvt_pk_bf16(P[BASE + 4], P[BASE + 5]), b1_ = cvt_pk_bf16(P[BASE + 6], P[BASE + 7]);                              \
    auto r0_ = __builtin_amdgcn_permlane32_swap(a0_, b0_, false, false); auto r1_ = __builtin_amdgcn_permlane32_swap(a1_, b1_, false, false); \
    u32x4 w_ = {r0_[0], r1_[0], r0_[1], r1_[1]}; OUT = __builtin_bit_cast(bf16x8, w_); } while (0)
    PK4(p0, 0, pa0); PK4(p0, 8, pa1); PK4(p1, 0, pa2); PK4(p1, 8, pa3);
#undef PK4
}
struct Stg { bf16x8 k0, k1, v0, v1; };
__device__ __forceinline__ void tile_load(Stg& s, const bf16_t* Kb, const bf16_t* Vb, int pitch, int key0, int sr, int sc) {
    s.k0 = *(const bf16x8*)(Kb + (size_t)(key0 + sr) * pitch + sc); s.k1 = *(const bf16x8*)(Kb + (size_t)(key0 + 32 + sr) * pitch + sc);
    s.v0 = *(const bf16x8*)(Vb + (size_t)(key0 + sr) * pitch + sc); s.v1 = *(const bf16x8*)(Vb + (size_t)(key0 + 32 + sr) * pitch + sc);
}
__device__ __forceinline__ void tile_write(LAS char* Kl, LAS char* Vl, const Stg& s, int sr, int sc) {
    *(LAS bf16x8*)(Vl + v_st(sr, sc)) = s.v0; *(LAS bf16x8*)(Vl + v_st(32 + sr, sc)) = s.v1;
    *(LAS bf16x8*)(Kl + KSWZ(sr, sc * 2)) = s.k0; *(LAS bf16x8*)(Kl + KSWZ(32 + sr, sc * 2)) = s.k1;
}
__device__ __forceinline__ void tile_dma(LAS char* Kl, LAS char* Vl, const bf16_t* Kb, const bf16_t* Vb, int pitch, int key0, int wid, int lane) {
#pragma unroll
    for (int h = 0; h < 2; ++h) {
        const int ch = wid * 2 + h; const int L = ch * 1024 + lane * 16;
        { const int row = L >> 8, c16 = ((L >> 4) & 15) ^ (row & 7);
          __builtin_amdgcn_global_load_lds((const unsigned*)(Kb + (size_t)(key0 + row) * pitch + c16 * 8), (LAS unsigned*)(Kl + ch * 1024), 16, 0, 0); }
        { const int sub = L >> 9, kk = (sub >> 2) * 8 + ((L >> 6) & 7), c8 = (sub & 3) * 4 + ((L >> 4) & 3);
          const int k = (kk & ~0xC) | ((kk & 4) << 1) | ((kk & 8) >> 1);
          __builtin_amdgcn_global_load_lds((const unsigned*)(Vb + (size_t)(key0 + k) * pitch + c8 * 8), (LAS unsigned*)(Vl + ch * 1024), 16, 0, 0); }
    }
}
template <int MODE>
__device__ __forceinline__ void finalize(const f32x16* o, float l_reg, float gate, LAS float* li_l, int r32, int hi, float* scrA, float* scrB, bf16_t* catp) {
    if (hi == 0) li_l[r32] = l_reg > 0.f ? gate / l_reg : 0.f;
    LDS_WAIT();
#pragma unroll
    for (int r = 0; r < 16; ++r) {
        const int rc = (r & 3) + 8 * (r >> 2);
        unsigned lo = (unsigned)(4 * hi) * 1024u + (unsigned)r32, lc = (unsigned)(4 * hi) * 2048u + (unsigned)r32;
        asm volatile("" : "+v"(lo), "+v"(lc));
        const float f = li_l[rc + 4 * hi];
        if (MODE == 2) {
            float va[4], vb[4];
#pragma unroll
            for (int d0 = 0; d0 < 4; ++d0) { va[d0] = scrA[lo + rc * 1024 + 32 * d0]; vb[d0] = scrB[lo + rc * 1024 + 32 * d0]; }
#pragma unroll
            for (int d0 = 0; d0 < 4; ++d0) { const float v = o[d0][r] * f + (va[d0] + vb[d0]); catp[lc + rc * 2048 + 32 * d0] = (bf16_t)(cvt_pk_bf16(v, v) & 0xffffu); }
            if (r & 1) asm volatile("" ::: "memory");
        } else {
#pragma unroll
            for (int d0 = 0; d0 < 4; ++d0) { const float v = o[d0][r] * f; if (MODE == 0) scrA[lo + rc * 1024 + 32 * d0] = v; else scrB[lo + rc * 1024 + 32 * d0] = v; }
        }
    }
    LDS_WAIT();
}
template <bool WIN>
__device__ __forceinline__ void run_branch(LAS char* K_l, LAS char* V_l, const bf16_t* Kb, const bf16_t* Vb, unsigned tiles, unsigned lanemask, int c, int tl,
                                           const bf16x8* qr, float& m_reg, float& l_reg, f32x16* o, LAS float* al_l, int r32, int hi, int wid, int lane, int vb0) {
    unsigned rem = tiles; int j = __builtin_ctz(rem); rem &= rem - 1;
    __syncthreads();
    tile_dma(K_l, V_l, Kb, Vb, 256, 64 * j, wid, lane);
    asm volatile("s_waitcnt vmcnt(0)" ::: "memory"); __syncthreads();
    int cur = 0;
    for (;;) {
        const int jn = rem ? __builtin_ctz(rem) : -1;
        if (jn >= 0) { rem &= rem - 1; tile_dma(K_l + (cur ^ 1) * 32768, V_l + (cur ^ 1) * 32768, Kb, Vb, 256, 64 * jn, wid, lane); }
        const bool lane_on = (lanemask >> j) & 1u;
#ifdef ATT_NOANY
        {
#else
        if (__any(lane_on)) {
#endif
            f32x16 p0, p1; qkt(p0, p1, K_l + cur * 32768, qr, r32, hi);
            if (j == c) {
                int tlv = tl - 4 * hi; asm volatile("" : "+v"(tlv));
#pragma unroll
                for (int r = 0; r < 16; ++r) { const int kk = (r & 3) + 8 * (r >> 2); p0[r] = (kk > tlv) ? NEGB : p0[r]; p1[r] = (kk + 32 > tlv) ? NEGB : p1[r]; }
            }
            if (WIN && j == c - 8) {
                int tlv = tl - 4 * hi; asm volatile("" : "+v"(tlv));
#pragma unroll
                for (int r = 0; r < 16; ++r) { const int kk = (r & 3) + 8 * (r >> 2); p0[r] = (kk <= tlv) ? NEGB : p0[r]; p1[r] = (kk + 32 <= tlv) ? NEGB : p1[r]; }
            }
            bf16x8 pa0, pa1, pa2, pa3; float al;
            sm_step(p0, p1, lane_on, m_reg, l_reg, o, al_l, r32, hi, pa0, pa1, pa2, pa3, al);
            pv_d0(o, vb0 + cur * 32768, pa0, pa1, pa2, pa3);
        }
        if (jn < 0) break;
        asm volatile("s_waitcnt vmcnt(0)" ::: "memory"); __syncthreads();
        j = jn; cur ^= 1;
    }
}
constexpr int L_V = 0, L_K = 16384, L_IMP = 65536, L_SIMP = 99328, L_MASK = 107776, L_WS = 108288;
__device__ __forceinline__ void attn_unit(LAS unsigned char* ldsb, const bf16_t* __restrict__ T, const bf16_t* kcmp, const bf16_t* vcmp,
                                          const float* __restrict__ gates, float* scr, float* scr2, bf16_t* cat, int b, int g, int c, unsigned* cmp_cnt) {
    LAS char* lds = (LAS char*)ldsb;
    int tid_ = threadIdx.x; asm volatile("" : "+v"(tid_));
    const int tid = tid_, wid = __builtin_amdgcn_readfirstlane(tid >> 6), lane = tid & 63, r32 = lane & 31, hi = lane >> 5;
    const int hh = wid & 3, ch = wid >> 2, h = g * 4 + hh;
    const int tl = 32 * ch + r32, t = 64 * c + tl;
    const size_t row = (size_t)b * SEQ + t;
    LAS char* V_l = lds + L_V; LAS char* K_l = lds + L_K;
    LAS float* impw = (LAS float*)(lds + L_IMP) + wid * 1056;
    LAS float* simp = (LAS float*)(lds + L_SIMP);
    LAS unsigned* maskw = (LAS unsigned*)(lds + L_MASK);
    LAS float* li_l = (LAS float*)(lds + L_WS) + wid * 64; LAS float* al_l = li_l + 32;
    bf16x8 qr[8];
    { const bf16_t* Qw = T + (size_t)(4 + (h >> 1)) * TS + row * 256 + (h & 1) * 128 + hi * 8;
#pragma unroll
      for (int d0 = 0; d0 < 8; ++d0) qr[d0] = *(const bf16x8*)(Qw + d0 * 16); }
    const int vb0 = (int)(uintptr_t)V_l + v_rd_base(lane);
    const float g0 = gates[row * 24 + h * 3 + 0], g1 = gates[row * 24 + h * 3 + 1], g2 = gates[row * 24 + h * 3 + 2];
    float* scrp = scr + ((size_t)b * SEQ + 64 * c + 32 * ch) * 1024 + h * 128;
    float* scrq = scr2 + ((size_t)b * SEQ + 64 * c + 32 * ch) * 1024 + h * 128;
    bf16_t* catp = cat + ((size_t)b * SEQ + 64 * c + 32 * ch) * DM + 1024 + h * 128;
    if (tid == 0) maskw[64] = 0u;
    float m_reg = NEGB, l_reg = 0.f; f32x16 o[4];
#pragma unroll
    for (int d = 0; d < 4; ++d) o[d] = f32x16{};
    { const bf16_t* Kb = T + (size_t)12 * TS + (size_t)b * SEQ * 256 + g * 128; const bf16_t* Vb = T + (size_t)13 * TS + (size_t)b * SEQ * 256 + g * 128;
      const int lo = c >= 8 ? c - 8 : 0; const unsigned wt = (c == 31 ? 0xffffffffu : ((1u << (c + 1)) - 1u)) & ~((1u << lo) - 1u);
#ifndef ATT_SKIP_B2
      run_branch<true>(K_l, V_l, Kb, Vb, wt, 0xffffffffu, c, tl, qr, m_reg, l_reg, o, al_l, r32, hi, wid, lane, vb0);
#endif
      finalize<0>(o, l_reg, g2, li_l, r32, hi, scrp, scrq, catp);
    }
    wait_count(cmp_cnt, 128u);
    m_reg = NEGB; l_reg = 0.f;
#pragma unroll
    for (int d = 0; d < 4; ++d) o[d] = f32x16{};
    {
        const bf16_t* Kb = kcmp + (size_t)(b * 2 + g) * 128 * 128; const bf16_t* Vb = vcmp + (size_t)(b * 2 + g) * 128 * 128;
        const int nmax = (t >= 31) ? ((t - 31) >> 4) : -1;
        bf16x8 pa0, pa1, pa2, pa3; float alA, alB;
        float inn[4][4], lst[4][4];
        __syncthreads();
        tile_dma(K_l, V_l, Kb, Vb, 128, 0, wid, lane); tile_dma(K_l + 32768, V_l + 32768, Kb, Vb, 128, 64, wid, lane);
        asm volatile("s_waitcnt vmcnt(0)" ::: "memory"); __syncthreads();
        {
            f32x16 a0, a1;
            qkt(a0, a1, K_l, qr, r32, hi);
#pragma unroll
            for (int r = 0; r < 16; ++r) { const int n = crow(r, hi); a0[r] = (n <= nmax) ? a0[r] : NEGB; a1[r] = (n + 32 <= nmax) ? a1[r] : NEGB; }
            sm_step(a0, a1, true, m_reg, l_reg, o, al_l, r32, hi, pa0, pa1, pa2, pa3, alA);
#pragma unroll
            for (int c4 = 0; c4 < 4; ++c4) { inn[0][c4] = (a0[4 * c4] + a0[4 * c4 + 1]) + (a0[4 * c4 + 2] + a0[4 * c4 + 3]); lst[0][c4] = a0[4 * c4 + 3];
                                             inn[1][c4] = (a1[4 * c4] + a1[4 * c4 + 1]) + (a1[4 * c4 + 2] + a1[4 * c4 + 3]); lst[1][c4] = a1[4 * c4 + 3]; }
        }
        pv_d0(o, vb0, pa0, pa1, pa2, pa3);
        {
            f32x16 b0, b1;
            qkt(b0, b1, K_l + 32768, qr, r32, hi);
#pragma unroll
            for (int r = 0; r < 16; ++r) { const int n = 64 + crow(r, hi); b0[r] = (n <= nmax) ? b0[r] : NEGB; b1[r] = (n + 32 <= nmax) ? b1[r] : NEGB; }
            sm_step(b0, b1, true, m_reg, l_reg, o, al_l, r32, hi, pa0, pa1, pa2, pa3, alB);
#pragma unroll
            for (int c4 = 0; c4 < 4; ++c4) { inn[2][c4] = (b0[4 * c4] + b0[4 * c4 + 1]) + (b0[4 * c4 + 2] + b0[4 * c4 + 3]); lst[2][c4] = b0[4 * c4 + 3];
                                             inn[3][c4] = (b1[4 * c4] + b1[4 * c4 + 1]) + (b1[4 * c4 + 2] + b1[4 * c4 + 3]); lst[3][c4] = b1[4 * c4 + 3]; }
        }
        pv_d0(o, vb0 + 32768, pa0, pa1, pa2, pa3);
        const float inv = l_reg > 0.f ? 1.f / l_reg : 0.f; const float fa = alB * inv, fb = inv;
        float x[4][4];
#pragma unroll
        for (int TT = 0; TT < 4; ++TT)
#pragma unroll
            for (int c4 = 0; c4 < 4; ++c4) { const float f = TT < 2 ? fa : fb; inn[TT][c4] *= f; lst[TT][c4] *= f; x[TT][c4] = __shfl_xor(lst[TT][c4], 32); }
#pragma unroll
        for (int TT = 0; TT < 4; ++TT)
#pragma unroll
            for (int c4 = 0; c4 < 4; ++c4) {
                const float plo = c4 >= 1 ? x[TT][c4 >= 1 ? c4 - 1 : 0] : (TT >= 1 ? x[TT >= 1 ? TT - 1 : 0][3] : 0.f);
                const float prev = hi ? x[TT][c4] : plo;
                impw[r32 * 33 + 8 * TT + 2 * c4 + hi] = inn[TT][c4] + prev;
            }
#ifndef ATT_SKIP_FIN
        finalize<1>(o, l_reg, g0, li_l, r32, hi, scrp, scrq, catp);
#endif
    }
    __syncthreads();
    {
        const int pidx = tid >> 3, sub = tid & 7;
        const LAS float* ib = (const LAS float*)(lds + L_IMP) + ((pidx >> 5) * 4) * 1056 + (pidx & 31) * 33;
#pragma unroll
        for (int jj = 0; jj < 4; ++jj) { const int j = 4 * sub + jj; float sv = (ib[j] + ib[1056 + j]) + (ib[2112 + j] + ib[3168 + j]);
            if (j > c) sv = -1.f; else if (j == 0 || j == c || j == c - 1) sv = 3.0e38f;
            simp[pidx * 33 + j] = sv; }
        __syncthreads();
        float vj[4]; int rk[4];
#pragma unroll
        for (int jj = 0; jj < 4; ++jj) { vj[jj] = simp[pidx * 33 + 4 * sub + jj]; rk[jj] = 0; }
#pragma unroll 1
        for (int i = 0; i < 32; ++i) { const float vi = simp[pidx * 33 + i];
#pragma unroll
            for (int jj = 0; jj < 4; ++jj) rk[jj] += (vi > vj[jj] || (vi == vj[jj] && i < 4 * sub + jj)) ? 1 : 0; }
        unsigned bits = 0u;
#pragma unroll
        for (int jj = 0; jj < 4; ++jj) { const int j = 4 * sub + jj; if (rk[jj] < 16 && j <= c) bits |= 1u << j; }
        bits |= __shfl_xor(bits, 1); bits |= __shfl_xor(bits, 2); bits |= __shfl_xor(bits, 4);
        if (sub == 0) maskw[pidx] = bits;
        bits |= __shfl_xor(bits, 8); bits |= __shfl_xor(bits, 16); bits |= __shfl_xor(bits, 32);
        if (lane == 0) atomicOr((unsigned*)(maskw + 64), bits);
    }
    __syncthreads();
    const unsigned umask = __builtin_amdgcn_readfirstlane(maskw[64]);
    const unsigned mymask = maskw[tl];
    m_reg = NEGB; l_reg = 0.f;
#pragma unroll
    for (int d = 0; d < 4; ++d) o[d] = f32x16{};
    { const bf16_t* Kb = T + (size_t)10 * TS + (size_t)b * SEQ * 256 + g * 128; const bf16_t* Vb = T + (size_t)11 * TS + (size_t)b * SEQ * 256 + g * 128;
#ifndef ATT_SKIP_B1
      run_branch<false>(K_l, V_l, Kb, Vb, umask, mymask, c, tl, qr, m_reg, l_reg, o, al_l, r32, hi, wid, lane, vb0);
#endif
#ifndef ATT_SKIP_FIN
      finalize<2>(o, l_reg, g1, li_l, r32, hi, scrp, scrq, catp);
#endif
    }
    __syncthreads();
}
}

template <int W>
__device__ __forceinline__ void pool_rows16(const float* __restrict__ Z, const float* __restrict__ scale, bf16_t* cat, int base, int q) {
    const int seq0 = base & ~(SEQ - 1);
    f32x4 v[15 + W];
#pragma unroll
    for (int i = 0; i < 15 + W; ++i) { const int r = base - (W - 1) + i; v[i] = (r >= seq0) ? *((const f32x4*)Z + (size_t)r * 256 + q) : (f32x4){0.f, 0.f, 0.f, 0.f}; }
    const f32x4 sv = ((const f32x4*)scale)[q];
#pragma unroll
    for (int j = 0; j < 16; ++j) { f32x4 s = v[j + W - 1];
#pragma unroll
        for (int k = 1; k < W; ++k) s += v[j + W - 1 - k];
        const int t = (base + j) & (SEQ - 1); const int n = min(W, t + 1); const float rc = 1.0f / (float)n;
        const f32x4 y = (s * rc - v[j + W - 1]) * sv;
        u32x2 wv; wv.x = cvt_pk_bf16(y[0], y[1]); wv.y = cvt_pk_bf16(y[2], y[3]);
        *(u32x2*)(cat + (size_t)(base + j) * DM + 4 * q) = wv; }
}
__device__ __forceinline__ void pool_finalize(const float* __restrict__ Z, const float* __restrict__ scale, bf16_t* cat, int row_begin, int nrows) {
    const int q = threadIdx.x & 255, grp = __builtin_amdgcn_readfirstlane((int)(threadIdx.x & 255) >> 6);
    for (int base = row_begin + 16 * (int)(threadIdx.x >> 8); base < row_begin + nrows; base += 32) {
        if (grp == 0) pool_rows16<2>(Z, scale, cat, base, q); else if (grp == 1) pool_rows16<4>(Z, scale, cat, base, q);
        else if (grp == 2) pool_rows16<8>(Z, scale, cat, base, q); else pool_rows16<16>(Z, scale, cat, base, q);
    }
}

#define XB_TMO      128
#define XB_XCNT(j)  (256  + 64 * (j))
#define XB_XSUB(j)  (1280 + 64 * (j))
#define XB_XGEN(j)  (2304 + 64 * (j))
#define XB_TOP      3328
#define XB_TOPGEN   3392
#define XCD_BAR_WORDS 3456
#define XB_SPIN_CAP (1u << 18)

__device__ __forceinline__ unsigned xb_ld(unsigned* p)              { return __hip_atomic_load(p, __ATOMIC_RELAXED, __HIP_MEMORY_SCOPE_AGENT); }
__device__ __forceinline__ unsigned xb_add(unsigned* p, unsigned v) { return __hip_atomic_fetch_add(p, v, __ATOMIC_RELAXED, __HIP_MEMORY_SCOPE_AGENT); }
__device__ __forceinline__ unsigned xb_xcc_id() { return (unsigned)__builtin_amdgcn_s_getreg((3 << 11) | 20) & 0xFu; }
#define XB_SPIN(cond, bar) do { unsigned _sp = 0; while (cond) { __builtin_amdgcn_s_sleep(1); \
    if ((++_sp & 255u) == 0u) { if (xb_ld(&(bar)[XB_TMO])) break; if (_sp > XB_SPIN_CAP) { atomicAdd(&(bar)[XB_TMO], 1u); break; } } } } while (0)

struct XcdBarrier {
    unsigned* bar; unsigned x;
    volatile LAS unsigned* st;
};

__device__ __forceinline__ XcdBarrier xcd_barrier_post(unsigned* bar, volatile LAS unsigned* st) {
    XcdBarrier b; b.bar = bar; b.x = xb_xcc_id(); b.st = st;
    if (threadIdx.x == 0) (void)xb_add(&bar[XB_XCNT(b.x)], 1u);
    return b;
}
__device__ __forceinline__ void xcd_barrier_complete(unsigned* bar, unsigned x, unsigned& nloc, unsigned& nx) {
    const unsigned G = gridDim.x * gridDim.y * gridDim.z;
    unsigned sum, cnt, mine, sp = 0u;
    for (;;) {
        sum = 0u; cnt = 0u; mine = 0u;
#pragma unroll
        for (unsigned j = 0; j < 16; ++j) { const unsigned c = xb_ld(&bar[XB_XCNT(j)]); sum += c; cnt += (c > 0u) ? 1u : 0u; mine = (j == x) ? c : mine; }
        if (sum == G) break;
        __builtin_amdgcn_s_sleep(1);
        if ((++sp & 255u) == 0u) { if (xb_ld(&bar[XB_TMO])) break; if (sp > XB_SPIN_CAP) { atomicAdd(&bar[XB_TMO], 1u); break; } }
    }
    nloc = mine > 0u ? mine : 1u; nx = cnt > 0u ? cnt : 1u;
}

__device__ __forceinline__ void xcd_barrier(const XcdBarrier& b) {
    asm volatile("s_waitcnt vmcnt(0)" ::: "memory");
    __syncthreads();
    if (threadIdx.x == 0) {
        unsigned* bar = b.bar;
        __builtin_amdgcn_s_waitcnt(0);
        unsigned nloc = b.st[0], nx = b.st[1];
        if (nloc == 0u) { xcd_barrier_complete(bar, b.x, nloc, nx); b.st[0] = nloc; b.st[1] = nx; }
        const unsigned old = xb_add(&bar[XB_XSUB(b.x)], 1u);
        const unsigned gen = old / nloc;
        if (old + 1u == (gen + 1u) * nloc) {
            __builtin_amdgcn_fence(__ATOMIC_RELEASE, "agent");
            asm volatile("s_waitcnt vmcnt(0)" ::: "memory");
            const unsigned og = xb_add(&bar[XB_TOP], 1u);
            const unsigned tg = og / nx;
            if (og + 1u == (tg + 1u) * nx) xb_add(&bar[XB_TOPGEN], 1u);
            else XB_SPIN(xb_ld(&bar[XB_TOPGEN]) == tg, bar);
            __builtin_amdgcn_fence(__ATOMIC_ACQUIRE, "agent");
            xb_add(&bar[XB_XGEN(b.x)], 1u);
            asm volatile("s_waitcnt vmcnt(0)" ::: "memory");
        } else {
            XB_SPIN(xb_ld(&bar[XB_XGEN(b.x)]) == gen, bar);
            __builtin_amdgcn_fence(__ATOMIC_ACQUIRE, "agent");
            asm volatile("s_waitcnt vmcnt(0)" ::: "memory");
        }
    }
    __syncthreads();
}

#ifndef REPF
#define REPF 1
#endif
struct Args { const float* in[21]; float* out; unsigned char* ws; int ph_lo, ph_hi; };
#ifndef MK_PER_PHASE
#define MK_PER_PHASE 0
#endif
__global__ void __launch_bounds__(NTHREADS, 2) hymba_fwd(Args a) {
    extern __shared__ __attribute__((aligned(16))) unsigned char lds_raw[];
    LAS unsigned char* lds = (LAS unsigned char*)lds_raw;
    unsigned* xbar_words = (unsigned*)(a.ws + 262144);
    volatile LAS unsigned* xb_st = (volatile LAS unsigned*)(lds + 131072 + 64);
    if (threadIdx.x < 2) xb_st[threadIdx.x] = 0u;
    __syncthreads();
    XcdBarrier xb = xcd_barrier_post(xbar_words, xb_st);
    unsigned* ctl = (unsigned*)(a.ws + 262144 + 16384);
#define PHASE_IDS() int tid_ = threadIdx.x; asm volatile("" : "+v"(tid_)); const int tid = tid_, lane = tid & 63, wave = __builtin_amdgcn_readfirstlane(tid >> 6); \
    const int gw = bid * 8 + wave, NGW = G * 8, gtid = bid * NTHREADS + tid, GT = G * NTHREADS; (void)lane; (void)gw; (void)NGW; (void)gtid; (void)GT;
    const int G = gridDim.x, bid = blockIdx.x;
    unsigned char* ws = a.ws;
    const float* x = a.in[0]; float* hbuf = a.out;
    bf16_t* Win_t = (bf16_t*)(ws + WS_WIN); bf16_t* Wout_t = (bf16_t*)(ws + WS_WOUT); bf16_t* Wpg_t = (bf16_t*)(ws + WS_WPG); bf16_t* Wd_t = (bf16_t*)(ws + WS_WD);
    bf16_t* Wgu_t = (bf16_t*)(ws + WS_WGU); bf16_t* Wpp_t = (bf16_t*)(ws + WS_WPP); bf16_t* poolw_t = (bf16_t*)(ws + WS_POOLW);
    bf16_t* W1k = (bf16_t*)(ws + WS_W1K); bf16_t* W1v = (bf16_t*)(ws + WS_W1V); bf16_t* W2k = (bf16_t*)(ws + WS_W2K); bf16_t* W2v = (bf16_t*)(ws + WS_W2V);
    bf16_t* PBF = (bf16_t*)(ws + WS_PBF); bf16_t* XN = (bf16_t*)(ws + WS_XN); bf16_t* T = (bf16_t*)(ws + WS_T); float* Z = (float*)(ws + WS_Z);
    float* SCR = (float*)(ws + WS_SCR); bf16_t* ACT = (bf16_t*)(ws + WS_ACT); bf16_t* PP = (bf16_t*)a.out;
    float* rowss1 = (float*)(ws + 65536); float* rowss2 = (float*)(ws + 131072); float* rowss3 = (float*)(ws + 196608); bf16_t* HB1 = (bf16_t*)(ws + WS_SCR);
    float* cosT = (float*)(ws + WS_COS); float* sinT = (float*)(ws + WS_SIN); float* gatesb = (float*)(ws + WS_GATES);
    bf16_t* kcmp = (bf16_t*)(ws + WS_KCMP); bf16_t* vcmp = (bf16_t*)(ws + WS_VCMP); float* biasp = (float*)(ws + WS_BIASK);

#ifndef SKIP_P0
#ifndef REP0
#define REP0 1
#endif
    if (a.ph_lo <= 0 && 0 < a.ph_hi) for (int rep0 = 0; rep0 < REP0; ++rep0) {
        if (rep0) xcd_barrier(xb);
    {
        PHASE_IDS();
        LAS float* scr = (LAS float*)(lds + wave * 16384);
        constexpr int I_IN = 32 * 120, I_SQ = 32 * 64, I_GU = 32 * 176, I_DN = 88 * 64, I_PP = 4 * 64, I_PW = 4 * 8, I_W1 = 64 * 4, I_W2 = 2 * 4;
        constexpr int NITEMS = I_IN + 2 * I_SQ + 2 * I_GU + I_DN + I_PP + 4 * I_PW + 2 * I_W1 + 2 * I_W2;
        for (int it = gw; it < NITEMS; it += NGW) {
            int r = it; const float* Wsrc; const float* gain = nullptr; bf16_t* dst; int Kk, Nn, nv, nblk, mode = 0;
            if (r < I_GU) { Wsrc = a.in[14]; Kk = DM; Nn = DFF; nv = DFF; nblk = 176; dst = Wgu_t; mode = 1; gain = a.in[13]; }
            else if ((r -= I_GU) < I_GU) { Wsrc = a.in[15]; Kk = DM; Nn = DFF; nv = DFF; nblk = 176; dst = Wgu_t; mode = 2; gain = a.in[13]; }
            else if ((r -= I_GU) < I_DN) { Wsrc = a.in[16]; Kk = DFF; Nn = DM; nv = DM; nblk = 64; dst = Wd_t; }
            else if ((r -= I_DN) < I_IN) { Wsrc = a.in[3]; Kk = DM; Nn = INW; nv = INW; nblk = 120; dst = Win_t; }
            else if ((r -= I_IN) < I_SQ) { Wsrc = a.in[12]; Kk = DM; Nn = DM; nv = DM; nblk = 64; dst = Wout_t; }
            else if ((r -= I_SQ) < I_SQ) { Wsrc = a.in[18]; Kk = DM; Nn = DM; nv = DM; nblk = 64; dst = Wpg_t; gain = a.in[17]; }
            else if ((r -= I_SQ) < I_PP) { Wsrc = a.in[19]; Kk = PLE; Nn = DM; nv = DM; nblk = 64; dst = Wpp_t; }
            else if ((r -= I_PP) < 4 * I_PW) { const int gq = r / I_PW; r -= gq * I_PW; Wsrc = a.in[4] + gq * 65536; Kk = 256; Nn = 256; nv = 256; nblk = 8; dst = poolw_t + gq * 65536; }
            else if ((r -= 4 * I_PW) < I_W1) { Wsrc = a.in[7]; Kk = 4096; Nn = 128; nv = 128; nblk = 4; dst = W1k; }
            else if ((r -= I_W1) < I_W1) { Wsrc = a.in[10]; Kk = 4096; Nn = 128; nv = 128; nblk = 4; dst = W1v; }
            else if ((r -= I_W1) < I_W2) { Wsrc = a.in[8]; Kk = 128; Nn = 128; nv = 128; nblk = 4; dst = W2k; }
            else { r -= I_W2; Wsrc = a.in[11]; Kk = 128; Nn = 128; nv = 128; nblk = 4; dst = W2v; }
            const int grp = r >> 3, wq = r & 7, gpr = nblk >> 2, gkb = grp / gpr, gnb = grp - gkb * gpr; const int kb = gkb * 2 + (wq >> 2), nb = gnb * 4 + (wq & 3), n0 = nb * 32;
            const int drow = mode == 0 ? n0 : ((n0 >> 7) * 256 + (n0 & 127) + (mode == 2 ? 128 : 0));
            tr_item(Wsrc, Kk, Nn, nv, dst, drow, scr, kb * 64, n0, lane, gain);
        }
        for (int m = gw; m < MROWS; m += NGW) rms_row<true>(x + (size_t)m * DM, a.in[2], XN + (size_t)m * DM, lane);
        for (int i = gtid; i < MROWS * PLE / 8; i += GT) { const f32x4 v0 = ((const f32x4*)a.in[1])[2 * i], v1 = ((const f32x4*)a.in[1])[2 * i + 1]; u32x4 w; w.x = cvt_pk_bf16(v0[0], v0[1]); w.y = cvt_pk_bf16(v0[2], v0[3]); w.z = cvt_pk_bf16(v1[0], v1[1]); w.w = cvt_pk_bf16(v1[2], v1[3]); ((u32x4*)PBF)[i] = w; }
        for (int i = gtid; i < 3 * MROWS; i += GT) { if (i < MROWS) rowss1[i] = 0.f; else if (i < 2 * MROWS) rowss2[i - MROWS] = 0.f; else rowss3[i - 2 * MROWS] = 0.f; }
        for (int i = (G == 256 ? (tid < 128 ? bid * 128 + tid : SEQ * 16) : gtid); i < SEQ * 16; i += GT) { const int pos = i >> 4, fi = i & 15; const float inv = exp2f(-(float)fi * (18.931568569324174f / 16.f)); const float ang = (float)pos * inv;
            cosT[i] = cosf(ang); sinT[i] = sinf(ang); }
        __syncthreads();
        for (int tsk = (G == 256 ? bid - 192 : bid); tsk < 64; tsk += G) { if (tsk < 0) break;
            const int kv = tsk >> 5, l = tsk & 31; const float* pe = a.in[kv == 0 ? 6 : 9] + l * 128; const float* w1 = a.in[kv == 0 ? 7 : 10] + (size_t)l * 128 * 128;
            const int cc = tid & 127, part = tid >> 7; float s = 0.f;
#pragma unroll 8
            for (int k = part * 32; k < part * 32 + 32; ++k) s += pe[k] * w1[(size_t)k * 128 + cc];
            LAS float* red = (LAS float*)lds; red[part * 128 + cc] = s; __syncthreads();
            if (tid < 128) biasp[(size_t)tsk * 128 + tid] = (red[tid] + red[128 + tid]) + (red[256 + tid] + red[384 + tid]);
            __syncthreads();
        }
    }
    }
#endif
    if (a.ph_lo <= 0 && 1 < a.ph_hi) xcd_barrier(xb);
#ifndef SKIP_P1
#ifndef REP1
#define REP1 1
#endif
    if (a.ph_lo <= 1 && 1 < a.ph_hi) for (int rep1 = 0; rep1 < REP1; ++rep1) {
        if (rep1) xcd_barrier(xb);
    {
        pg8::Gemm g{XN, Win_t, MROWS, INWP, DM}; pg8::StaticOrder S; S.init(MROWS, INWP, G, bid);
        EpiInProj E{T, gatesb, cosT, sinT};
        pg8::gemm_phase<EpiInProj, pg8::StaticOrder, true, true>(lds, g, S, E);
    }
    }
#endif
    if (a.ph_lo <= 1 && 2 < a.ph_hi) xcd_barrier(xb);
#ifndef SKIP_P2
#ifndef REP2
#define REP2 1
#endif
    if (a.ph_lo <= 2 && 2 < a.ph_hi) for (int rep2 = 0; rep2 < REP2; ++rep2) {
        if (rep2) xcd_barrier(xb);
    {
        pg8::Gemm g{T, poolw_t, 4 * MROWS, 1024, 256}; PoolOrder S{G, bid}; EpiPoolZ E{Z};
        pg8::gemm_phase<EpiPoolZ, PoolOrder, true, true>(lds, g, S, E);
        signal_done<false>(ctl + 64, bid < 128 ? (unsigned)((127 - bid) / G + 1) : 0u);
        unsigned njobs = 0;
        for (int job = G - 1 - bid; job < 128; job += G) {
            const int kv = job >> 6, b = (job >> 4) & 3, gg = (job >> 3) & 1, n0 = (job & 7) * 16;
            compress_job(lds, T + (size_t)(8 + kv) * TS, kv ? W1v : W1k, kv ? W2v : W2k, biasp + (size_t)kv * 32 * 128, kv ? vcmp : kcmp, b, gg, n0);
            ++njobs;
        }
        signal_done<false>(ctl, njobs);
    }
    }
#endif
#ifndef SKIP_P3
#ifndef REP3
#define REP3 1
#endif
    if (a.ph_lo <= 3 && 3 < a.ph_hi) for (int rep3 = 0; rep3 < REP3; ++rep3) {
        if (rep3) xcd_barrier(xb);
    {
        bf16_t* CAT = XN;
        for (int u = bid; u < 256; u += G) { const int bg = u & 7, c = (u < 128) ? 16 + (u >> 3) : 15 - ((u - 128) >> 3); att::attn_unit(lds, T, kcmp, vcmp, gatesb, SCR, hbuf, CAT, bg >> 1, bg & 1, c, ctl); }
        wait_count(ctl + 64, 128u);
        { const int per = (MROWS + G - 1) / G; const int r0 = bid * per; const int nr = min(per, MROWS - r0); if (nr > 0) for (int repf = 0; repf < REPF; ++repf) pool_finalize(Z, a.in[5], CAT, r0, nr); }
    }
    }
#endif
    if (a.ph_lo <= 3 && 4 < a.ph_hi) xcd_barrier(xb);
#ifndef SKIP_P4
    if (a.ph_lo <= 4 && 4 < a.ph_hi) {
    {
        pg8::Gemm g{XN, Wout_t, MROWS, DM, DM}; pg8::StaticOrder S; S.init(MROWS, DM, G, bid); EpiResidNorm E{x, nullptr, HB1, rowss1};
        pg8::gemm_phase<EpiResidNorm, pg8::StaticOrder, true, true>(lds, g, S, E);
    }
    }
#endif
    if (a.ph_lo <= 4 && 5 < a.ph_hi) xcd_barrier(xb);
#ifndef SKIP_P5
    if (a.ph_lo <= 5 && 5 < a.ph_hi) {
    { }
    }
#endif
#ifndef SKIP_P6
#ifndef REP6
#define REP6 1
#endif
    if (a.ph_lo <= 6 && 6 < a.ph_hi) for (int rep6 = 0; rep6 < REP6; ++rep6) {
        if (rep6) xcd_barrier(xb);
    {
        pg8::Gemm g{HB1, Wgu_t, MROWS, 2 * DFF, DM}; pg8::StaticOrder S; S.init(MROWS, 2 * DFF, G, bid); EpiSwiglu E{ACT, rowss1};
        pg8::gemm_phase<EpiSwiglu, pg8::StaticOrder, true, true>(lds, g, S, E);
        if (G == 256) {
            pg8::Gemm g2{PBF, Wpp_t, MROWS, DM, PLE}; UpperOrder S2; S2.S.init(MROWS, DM, 1, 0); S2.lo = 128; S2.nup = 128; S2.c = bid; EpiStoreBf16 E2{PP, DM};
            pg8::gemm_phase<EpiStoreBf16, UpperOrder, true, true>(lds, g2, S2, E2);
        } else { pg8::Gemm g2{PBF, Wpp_t, MROWS, DM, PLE}; pg8::StaticOrder S2; S2.init(MROWS, DM, G, bid); EpiStoreBf16 E2{PP, DM}; pg8::gemm_phase<EpiStoreBf16, pg8::StaticOrder, true, true>(lds, g2, S2, E2); }
    }
    }
#endif
    if (a.ph_lo <= 6 && 7 < a.ph_hi) xcd_barrier(xb);
#ifndef SKIP_P7
    if (a.ph_lo <= 7 && 7 < a.ph_hi) {
    {
        pg8::Gemm g{ACT, Wd_t, MROWS, DM, DFF}; pg8::StaticOrder S; S.init(MROWS, DM, G, bid); EpiResidNorm E{nullptr, HB1, XN, rowss2};
        pg8::gemm_phase<EpiResidNorm, pg8::StaticOrder, true, true>(lds, g, S, E);
    }
    }
#endif
    if (a.ph_lo <= 7 && 8 < a.ph_hi) xcd_barrier(xb);
#ifndef SKIP_P8
    if (a.ph_lo <= 8 && 8 < a.ph_hi) {
    {
    }
    }
#endif
    __syncthreads();
#ifndef SKIP_P9
    if (a.ph_lo <= 9 && 9 < a.ph_hi) {
    {
        pg8::Gemm g{XN, Wpg_t, MROWS, DM, DM}; pg8::StaticOrder S; S.init(MROWS, DM, G, bid); EpiPle E{XN, PP, rowss2, HB1, rowss3};
        pg8::gemm_phase<EpiPle, pg8::StaticOrder, true, true>(lds, g, S, E);
    }
    }
#endif
    if (a.ph_lo <= 9 && 10 < a.ph_hi) xcd_barrier(xb);
#ifdef EXTRA_SYNCS
    for (int es = 0; es < EXTRA_SYNCS; ++es) xcd_barrier(xb);
#endif
#ifndef SKIP_P10
    if (a.ph_lo <= 10 && 10 < a.ph_hi) {
#ifdef DBG_STOP
        { PHASE_IDS(); const bf16_t* dbg = (const bf16_t*)(ws + (size_t)DBG_OFF * MiB);
          for (size_t i = gtid; i < (size_t)MROWS * DM; i += GT) {
#ifdef DBG_NANDET
              const float bv = __uint_as_float((unsigned)((const bf16_t*)(ws + WS_KCMP))[i % 131072] << 16); const float wv = __uint_as_float((unsigned)((const bf16_t*)(ws + WS_VCMP))[i % 131072] << 16);
              const bool bad1 = !(fabsf(bv) < 1e30f), bad2 = !(fabsf(wv) < 1e30f);
              hbuf[i] = x[i] + (bad1 ? 1000.f : 0.f) + (bad2 ? 3000.f : 0.f);
#else
              float dv = __uint_as_float((unsigned)dbg[i % ((size_t)DBG_ELEMS)] << 16); if (!(fabsf(dv) < 1e30f)) dv = 1000.f; hbuf[i] = x[i] + DBG_SCALE * dv;
#endif
          } }
        xcd_barrier(xb);
#endif
    { PHASE_IDS();
      for (int m = gw; m < MROWS; m += NGW) { const float rstd = 1.0f / sqrtf(rowss3[m] * (1.f / DM) + 1e-6f); const u32x4* hr = (const u32x4*)(HB1 + (size_t)m * DM); f32x4* orow = (f32x4*)(hbuf + (size_t)m * DM);
#pragma unroll
          for (int j = 0; j < 4; ++j) { const u32x4 w = hr[lane + 64 * j]; const f32x4 g0 = ((const f32x4*)a.in[20])[2 * lane + 128 * j], g1 = ((const f32x4*)a.in[20])[2 * lane + 128 * j + 1];
              const f32x4 v0 = {__uint_as_float(w.x << 16), __uint_as_float(w.x & 0xffff0000u), __uint_as_float(w.y << 16), __uint_as_float(w.y & 0xffff0000u)};
              const f32x4 v1 = {__uint_as_float(w.z << 16), __uint_as_float(w.z & 0xffff0000u), __uint_as_float(w.w << 16), __uint_as_float(w.w & 0xffff0000u)};
              orow[2 * lane + 128 * j] = v0 * rstd * g0; orow[2 * lane + 128 * j + 1] = v1 * rstd * g1; } } }
    }
#endif
}

extern "C" void kernel_launch(void* const* d_in, const int* in_sizes, int n_in, void* d_out, int out_size, void* d_ws, size_t ws_size, hipStream_t stream) {
    static int grid = 0;
    if (grid == 0) {
        if (n_in != 21 || in_sizes[0] != MROWS * DM || out_size != MROWS * DM || ws_size < WS_END) {
            fprintf(stderr, "kernel_launch: unexpected shapes (n_in %d, in0 %d, out %d, ws %zu < %zu)\n", n_in, n_in > 0 ? in_sizes[0] : -1, out_size, ws_size, (size_t)WS_END); grid = -1; return; }
        int dev = 0, cus = 0, per_cu = 0;
        hipGetDevice(&dev); hipDeviceGetAttribute(&cus, hipDeviceAttributeMultiprocessorCount, dev);
        if (hipFuncSetAttribute((const void*)hymba_fwd, hipFuncAttributeMaxDynamicSharedMemorySize, LDS_BYTES) != hipSuccess) { fprintf(stderr, "kernel_launch: hipFuncSetAttribute failed\n"); grid = -1; return; }
        if (hipOccupancyMaxActiveBlocksPerMultiprocessor(&per_cu, (const void*)hymba_fwd, NTHREADS, LDS_BYTES) != hipSuccess || per_cu < 1) { fprintf(stderr, "kernel_launch: occupancy query failed (%d)\n", per_cu); grid = -1; return; }
        grid = cus * per_cu;
        fprintf(stderr, "kernel_launch: %d CUs x %d blocks/CU -> grid %d\n", cus, per_cu, grid);
    }
    if (grid < 0) return;
    Args a{};
    for (int i = 0; i < 21; ++i) a.in[i] = (const float*)d_in[i];
    a.out = (float*)d_out; a.ws = (unsigned char*)d_ws;
#if MK_PER_PHASE
    hipError_t e = hipSuccess;
#ifdef DBG_STOP
    for (int k = 0; k <= DBG_STOP; ++k) { a.ph_lo = k; a.ph_hi = k + 1; hipLaunchKernelGGL(hymba_fwd, dim3(grid), dim3(NTHREADS), LDS_BYTES, stream, a); }
    { a.ph_lo = 10; a.ph_hi = 11; void* args[] = {&a}; (void)hipLaunchCooperativeKernel((const void*)hymba_fwd, dim3(grid), dim3(NTHREADS), args, LDS_BYTES, stream); }
#else
    for (int k = 0; k < 11; ++k) { a.ph_lo = k; a.ph_hi = k + 1; hipLaunchKernelGGL(hymba_fwd, dim3(grid), dim3(NTHREADS), LDS_BYTES, stream, a); }
#endif
    e = hipPeekAtLastError();
#else
    a.ph_lo = 0; a.ph_hi = 11;
    if (hipMemsetAsync((char*)d_ws + 262144, 0, 32768, stream) != hipSuccess) { fprintf(stderr, "kernel_launch: hipMemsetAsync failed\n"); return; }
    void* args[] = {&a};
    hipError_t e = hipLaunchCooperativeKernel((const void*)hymba_fwd, dim3(grid), dim3(NTHREADS), args, LDS_BYTES, stream);
#endif
    if (e != hipSuccess) fprintf(stderr, "kernel_launch: cooperative launch failed: %s (grid %d)\n", hipGetErrorString(e), grid);
}
```

```cpp
#include <hip/hip_runtime.h>
#include <cstdio>
#include <cstdint>
#include <cmath>
#define ATT_NOANY 1
namespace pg8 {
#define PG8_LAS __attribute__((address_space(3)))
typedef unsigned short bf16_t;
typedef short bf16x8 __attribute__((ext_vector_type(8)));
typedef float f32x4 __attribute__((ext_vector_type(4)));
typedef unsigned u32x4 __attribute__((ext_vector_type(4)));
constexpr int BM = 256, BK = 64, HALF = 128, HTB = HALF * BK * 2  , STAGE_BYTES = 8 * HTB, NXCD = 8, WGM = 8;

__host__ __device__ __forceinline__ int lds_byte(int r, int c) { const int st = (r >> 4) * 2 + (c >> 5), rr = r & 15, cc = c & 31, ob = rr * 64 + cc * 2; return st * 1024 + (ob ^ (((ob >> 9) & 1) << 5)); }
__host__ __device__ __forceinline__ void stage_rc(int b, int& R, int& C) { const int st = b / 1024, sb = b % 1024, swz = sb ^ (((sb >> 9) & 1) << 5); R = (st >> 1) * 16 + swz / 64; C = (st & 1) * 32 + (swz % 64) / 2; }
__host__ __device__ __forceinline__ int perm32(int rho) { const int n = rho >> 4, i = rho & 15; return 8 * (i >> 2) + 4 * n + (i & 3); }

struct Unit { int pm, pn; };
struct Gemm { const bf16_t* A; const bf16_t* Bt; int M, N, K; };

struct StaticOrder {
    int nM, nN, nwg, G, c;
    __host__ __device__ void init(int M, int N, int G_, int c_) { nM = M / BM; nN = N / BM; nwg = nM * nN; G = G_; c = c_; }
    __host__ __device__ bool next(int i, Unit& u) const {
        const long L = (long)i * G + c; if (L >= nwg) return false;
        int wgid = (int)L; { const int q = nwg / NXCD, r = nwg % NXCD, xcd = wgid % NXCD, off = wgid / NXCD; wgid = (xcd < r ? xcd * (q + 1) : r * (q + 1) + (xcd - r) * q) + off; }
        const int nig = WGM * nN, gid = wgid / nig, fm = gid * WGM, gsz = (nM - fm) < WGM ? (nM - fm) : WGM;
        u.pm = fm + ((wgid % nig) % gsz); u.pn = (wgid % nig) / gsz; return true;
    }
    __host__ __device__ bool next_linear(long L, Unit& u) const {
        if (L >= nwg) return false;
        int wgid = (int)L; { const int q = nwg / NXCD, r = nwg % NXCD, xcd = wgid % NXCD, off = wgid / NXCD; wgid = (xcd < r ? xcd * (q + 1) : r * (q + 1) + (xcd - r) * q) + off; }
        const int nig = WGM * nN, gid = wgid / nig, fm = gid * WGM, gsz = (nM - fm) < WGM ? (nM - fm) : WGM;
        u.pm = fm + ((wgid % nig) % gsz); u.pn = (wgid % nig) / gsz; return true;
    }
    __device__ __forceinline__ void a_ready(const Unit&) const {}
    __device__ __forceinline__ void done(const Unit&) const {}
};

typedef float f32x2_cv __attribute__((ext_vector_type(2))); typedef __bf16 bf16x2_cv __attribute__((ext_vector_type(2)));
__device__ __forceinline__ unsigned cvt_pk_bf16(float lo, float hi) { f32x2_cv v = {lo, hi}; bf16x2_cv b = __builtin_convertvector(v, bf16x2_cv); return __builtin_bit_cast(unsigned, b); }
template <class Epi, class Sched, bool ALIGN_EPI = false, bool SP2 = false>
__device__ __forceinline__ void gemm_phase(PG8_LAS unsigned char* lds, const Gemm g, const Sched& S, const Epi& E) {
    int tid_ = threadIdx.x; asm volatile("" : "+v"(tid_));
    const int tid = tid_, wid = __builtin_amdgcn_readfirstlane(tid >> 6), lane = tid & 63, wr = wid >> 2, wc = wid & 3, fr = lane & 15, fq = lane >> 4;
    const int K = g.K, nt = K / BK;
    unsigned voffA[2], voffB[2];
#pragma unroll
    for (int i = 0; i < 2; ++i) { int R, C; stage_rc(tid * 16 + i * 8192, R, C); const int Rb = Epi::PERM ? ((R & ~31) + perm32(R & 31)) : R;
        voffA[i] = (unsigned)(R * K + C) * 2u; voffB[i] = (unsigned)(Rb * K + C) * 2u; }
    const size_t kstep = (size_t)(BK * 2);
    const size_t hstep = (size_t)HALF * K * 2;
    const size_t tstep = 2 * hstep;
    const unsigned ldsw = (unsigned)wid * 1024u;
    const int aoff = lds_byte(wr * 64 + fr, fq * 8), boff = lds_byte(wc * 32 + fr, fq * 8);
#define PG8_SA(b, h) (((b) * 2 + (h)) * HTB)
#define PG8_SB(b, h) ((4 + (b) * 2 + (h)) * HTB)
#define PG8_STAGE(bufoff, gbase, voff) do { _Pragma("unroll") for (int _i = 0; _i < 2; ++_i) \
        __builtin_amdgcn_global_load_lds((const unsigned*)((const char*)(gbase) + (voff)[_i]), (PG8_LAS unsigned*)(lds + (bufoff) + ldsw + _i * 8192), 16, 0, 0); } while (0)
#define PG8_LDA(dst, b, h) do { _Pragma("unroll") for (int m = 0; m < 4; ++m) _Pragma("unroll") for (int k = 0; k < 2; ++k) dst[m][k] = *(const PG8_LAS bf16x8*)(lds + PG8_SA(b, h) + aoff + m * 2048 + k * 1024); } while (0)
#define PG8_LDB(dst, b, h) do { _Pragma("unroll") for (int n = 0; n < 2; ++n) _Pragma("unroll") for (int k = 0; k < 2; ++k) dst[n][k] = *(const PG8_LAS bf16x8*)(lds + PG8_SB(b, h) + boff + n * 2048 + k * 1024); } while (0)
#define PG8_MMA(ai, bj, At, Bt) do { __builtin_amdgcn_s_setprio(1); _Pragma("unroll") for (int m = 0; m < 4; ++m) _Pragma("unroll") for (int n = 0; n < 2; ++n) _Pragma("unroll") for (int k = 0; k < 2; ++k) \
        acc[ai][bj][m][n] = __builtin_amdgcn_mfma_f32_16x16x32_bf16(Bt[n][k], At[m][k], acc[ai][bj][m][n], 0, 0, 0); __builtin_amdgcn_s_setprio(0); } while (0)
#define PG8_WAIT_V(n) asm volatile("s_waitcnt vmcnt(" #n ")" ::: "memory")
#define PG8_WAIT_L(n) asm volatile("s_waitcnt lgkmcnt(" #n ")" ::: "memory")
#define PG8_BAR __builtin_amdgcn_s_barrier()
#define PG8_SCHED __builtin_amdgcn_sched_barrier(0)
    Unit cur, nxt; int ui = 0;
    if (!S.next(0, cur)) return;
    f32x4 acc[2][2][4][2];
#pragma unroll
    for (int a = 0; a < 2; ++a)
#pragma unroll
        for (int b = 0; b < 2; ++b)
#pragma unroll
            for (int m = 0; m < 4; ++m)
#pragma unroll
                for (int n = 0; n < 2; ++n) acc[a][b][m][n] = (f32x4){0.f, 0.f, 0.f, 0.f};
    bf16x8 At[4][2], B0[2][2], B1[2][2];
    const char* cA = (const char*)g.A + (size_t)cur.pm * tstep; const char* cB = (const char*)g.Bt + (size_t)cur.pn * tstep;
    S.a_ready(cur);
    if constexpr (SP2) {
        PG8_STAGE(PG8_SB(0, 0), cB, voffB); PG8_STAGE(PG8_SB(0, 1), cB + hstep, voffB); PG8_STAGE(PG8_SA(0, 0), cA, voffA); PG8_STAGE(PG8_SA(0, 1), cA + hstep, voffA);
        if (wr == 1) PG8_BAR;
        PG8_WAIT_V(2); PG8_BAR;
        PG8_STAGE(PG8_SB(1, 0), cB + kstep, voffB); PG8_STAGE(PG8_SA(1, 0), cA + kstep, voffA); PG8_STAGE(PG8_SB(1, 1), cB + hstep + kstep, voffB);
        PG8_WAIT_V(6); PG8_BAR;
    } else {
        PG8_STAGE(PG8_SB(0, 0), cB, voffB); PG8_STAGE(PG8_SA(0, 0), cA, voffA); PG8_STAGE(PG8_SB(0, 1), cB + hstep, voffB); PG8_STAGE(PG8_SA(0, 1), cA + hstep, voffA);
        if (wr == 1) PG8_BAR;
        PG8_WAIT_V(4); PG8_BAR;
        PG8_STAGE(PG8_SB(1, 0), cB + kstep, voffB); PG8_STAGE(PG8_SA(1, 0), cA + kstep, voffA); PG8_STAGE(PG8_SB(1, 1), cB + hstep + kstep, voffB);
        PG8_WAIT_V(6); PG8_BAR;
    }
    for (;;) {
        const bool has_next = S.next(ui + 1, nxt);
        const char* nA = has_next ? (const char*)g.A + (size_t)nxt.pm * tstep : cA; const char* nB = has_next ? (const char*)g.Bt + (size_t)nxt.pn * tstep : cB;
        for (int t = 0; t < nt; t += 2) {
            const bool last = (t == nt - 2);
            const char* a1 = cA + (size_t)(t + 1) * kstep;
            const char* a2 = last ? nA : cA + (size_t)(t + 2) * kstep; const char* b2 = last ? nB : cB + (size_t)(t + 2) * kstep;
            const char* a3 = a2 + kstep; const char* b3 = b2 + kstep;
            if (last && has_next) S.a_ready(nxt);
            if constexpr (SP2) {
            PG8_LDB(B0, 0, 0); PG8_LDB(B1, 0, 1); PG8_SCHED; PG8_LDA(At, 0, 0); PG8_STAGE(PG8_SA(1, 1), a1 + hstep, voffA);
            PG8_WAIT_V(8); PG8_WAIT_L(0); PG8_BAR; PG8_MMA(0, 0, At, B0); PG8_MMA(0, 1, At, B1); PG8_BAR; PG8_SCHED;
            PG8_LDA(At, 0, 1); PG8_STAGE(PG8_SB(0, 0), b2, voffB); PG8_STAGE(PG8_SB(0, 1), b2 + hstep, voffB); PG8_STAGE(PG8_SA(0, 0), a2, voffA);
            PG8_WAIT_V(8); PG8_WAIT_L(0); PG8_BAR; PG8_MMA(1, 0, At, B0); PG8_MMA(1, 1, At, B1); PG8_BAR; PG8_SCHED;
            PG8_LDB(B0, 1, 0); PG8_LDB(B1, 1, 1); PG8_SCHED; PG8_LDA(At, 1, 0); PG8_STAGE(PG8_SA(0, 1), a2 + hstep, voffA);
            PG8_WAIT_V(8); PG8_WAIT_L(0); PG8_BAR; PG8_MMA(0, 0, At, B0); PG8_MMA(0, 1, At, B1); PG8_BAR; PG8_SCHED;
            PG8_LDA(At, 1, 1); PG8_STAGE(PG8_SB(1, 0), b3, voffB); PG8_STAGE(PG8_SB(1, 1), b3 + hstep, voffB); PG8_STAGE(PG8_SA(1, 0), a3, voffA);
            PG8_WAIT_V(8); PG8_WAIT_L(0); PG8_BAR; PG8_MMA(1, 0, At, B0); PG8_MMA(1, 1, At, B1); PG8_BAR; PG8_SCHED;
            } else {
            PG8_LDB(B0, 0, 0); PG8_SCHED; PG8_LDA(At, 0, 0); PG8_STAGE(PG8_SA(1, 1), a1 + hstep, voffA);
            PG8_WAIT_L(8); PG8_BAR; PG8_WAIT_L(0); PG8_MMA(0, 0, At, B0); PG8_BAR; PG8_SCHED;
            PG8_LDB(B1, 0, 1); PG8_STAGE(PG8_SB(0, 0), b2, voffB);
            PG8_BAR; PG8_WAIT_L(0); PG8_MMA(0, 1, At, B1); PG8_BAR;
            PG8_LDA(At, 0, 1); PG8_STAGE(PG8_SA(0, 0), a2, voffA);
            PG8_BAR; PG8_WAIT_L(0); PG8_MMA(1, 0, At, B0); PG8_BAR; PG8_SCHED;
            PG8_STAGE(PG8_SB(0, 1), b2 + hstep, voffB);
            PG8_WAIT_V(6); PG8_BAR; PG8_MMA(1, 1, At, B1); PG8_BAR;
            PG8_LDB(B0, 1, 0); PG8_SCHED; PG8_LDA(At, 1, 0); PG8_STAGE(PG8_SA(0, 1), a2 + hstep, voffA);
            PG8_WAIT_L(8); PG8_BAR; PG8_WAIT_L(0); PG8_MMA(0, 0, At, B0); PG8_BAR; PG8_SCHED;
            PG8_LDB(B1, 1, 1); PG8_STAGE(PG8_SB(1, 0), b3, voffB);
            PG8_BAR; PG8_WAIT_L(0); PG8_MMA(0, 1, At, B1); PG8_BAR;
            PG8_LDA(At, 1, 1); PG8_STAGE(PG8_SA(1, 0), a3, voffA);
            PG8_BAR; PG8_WAIT_L(0); PG8_MMA(1, 0, At, B0); PG8_BAR; PG8_SCHED;
            PG8_STAGE(PG8_SB(1, 1), b3 + hstep, voffB);
            PG8_WAIT_V(6); PG8_BAR; PG8_MMA(1, 1, At, B1); PG8_BAR;
            }
        }
        if constexpr (ALIGN_EPI) { if (wr == 0) PG8_BAR; }
        if constexpr (!Epi::AFTER_DRAIN) { E(acc, cur, wr, wc, fr, fq); S.done(cur); }
        if (!has_next) break;
#pragma unroll
        for (int a = 0; a < 2; ++a)
#pragma unroll
            for (int b = 0; b < 2; ++b)
#pragma unroll
                for (int m = 0; m < 4; ++m)
#pragma unroll
                    for (int n = 0; n < 2; ++n) acc[a][b][m][n] = (f32x4){0.f, 0.f, 0.f, 0.f};
        cur = nxt; cA = nA; cB = nB; ++ui;
        if constexpr (ALIGN_EPI) { if (wr == 1) PG8_BAR; }
    }
    PG8_WAIT_V(0);
    if constexpr (!ALIGN_EPI) { if (wr == 0) PG8_BAR; }
    PG8_BAR;
    if constexpr (Epi::AFTER_DRAIN) { E.fused(acc, cur, wr, wc, fr, fq, lds, wid, lane); S.done(cur); }
#undef PG8_SA
#undef PG8_SB
#undef PG8_STAGE
#undef PG8_LDA
#undef PG8_LDB
#undef PG8_MMA
#undef PG8_WAIT_V
#undef PG8_WAIT_L
#undef PG8_BAR
#undef PG8_SCHED
}
}

using pg8::bf16_t; using pg8::bf16x8; using pg8::f32x4; using pg8::u32x4; using pg8::Unit; using pg8::cvt_pk_bf16;
#define LAS __attribute__((address_space(3)))
typedef short s16x4 __attribute__((ext_vector_type(4)));
typedef float f32x16 __attribute__((ext_vector_type(16)));
typedef unsigned u32x2 __attribute__((ext_vector_type(2)));

constexpr int DM = 2048, SEQ = 2048, MROWS = 8192, PLE = 256, INW = 3608, INWP = 3840, DFF = 5632;
constexpr int NTHREADS = 512;
constexpr size_t MiB = (size_t)1 << 20;
constexpr size_t TS = (size_t)MROWS * 256;
constexpr size_t WS_BIASK = 0, WS_BIASV = 512;
constexpr size_t WS_COS = 1 * MiB, WS_SIN = 1 * MiB + 131072, WS_GATES = 1 * MiB + 262144;
constexpr size_t WS_KCMP = 2 * MiB, WS_VCMP = 2 * MiB + 262144, WS_W2K = 2 * MiB + 524288, WS_W2V = WS_W2K + 32768;
constexpr size_t WS_W1K = 3 * MiB, WS_W1V = 4 * MiB, WS_POOLW = 5 * MiB, WS_WPP = 6 * MiB, WS_WIN = 7 * MiB, WS_WOUT = 22 * MiB;
constexpr size_t WS_WPG = 30 * MiB, WS_WD = 38 * MiB, WS_WGU = 60 * MiB, WS_PBF = 104 * MiB, WS_XN = 108 * MiB;
constexpr size_t WS_T = 140 * MiB, WS_Z = 196 * MiB, WS_SCR = 228 * MiB, WS_ACT = 140 * MiB, WS_PP = 140 * MiB, WS_END = 260 * MiB;
constexpr int LDS_BYTES = 147456;

#define LDS_WAIT() asm volatile("s_waitcnt lgkmcnt(0)" ::: "memory")
__device__ __forceinline__ float wave_sum(float v) {
#pragma unroll
    for (int o = 1; o < 64; o <<= 1) v += __shfl_xor(v, o);
    return v;
}
__device__ __forceinline__ float sigmoidf_(float x) { return __builtin_amdgcn_rcpf(1.f + __expf(-x)); }

struct EpiInProj {
    static constexpr bool PERM = true, AFTER_DRAIN = false;
    bf16_t* T; float* gates; const float* cosT; const float* sinT;
    __device__ __forceinline__ void operator()(const f32x4 (&acc)[2][2][4][2], const Unit& u, int wr, int wc, int fr, int fq) const {
        const int pn = u.pn; const int row0 = u.pm * 256 + wr * 64 + fr;
        if (pn < 14) {
            const bool rope = (wc == 0) && (pn >= 4) && (pn < 8 || ((pn & 1) == 0));
            bf16_t* base = T + (size_t)pn * TS;
#pragma unroll
            for (int ai = 0; ai < 2; ++ai)
#pragma unroll
                for (int m = 0; m < 4; ++m) {
                    const int row = row0 + ai * 128 + m * 16; const int pos = row & (SEQ - 1);
                    f32x4 cs0 = {1.f, 1.f, 1.f, 1.f}, cs1 = cs0, sn0 = {0.f, 0.f, 0.f, 0.f}, sn1 = sn0;
                    if (rope) { const float* ct = cosT + pos * 16 + 8 * (fq & 1); const float* st = sinT + pos * 16 + 8 * (fq & 1);
                        cs0 = *(const f32x4*)ct; cs1 = *(const f32x4*)(ct + 4); sn0 = *(const f32x4*)st; sn1 = *(const f32x4*)(st + 4);
                        if (fq < 2) { sn0 = -sn0; sn1 = -sn1; } }
#pragma unroll
                    for (int bj = 0; bj < 2; ++bj) {
                        f32x4 v0 = acc[ai][bj][m][0], v1 = acc[ai][bj][m][1];
                        if (rope) { f32x4 o0, o1;
#pragma unroll
                            for (int j = 0; j < 4; ++j) { o0[j] = __shfl_xor(v0[j], 32); o1[j] = __shfl_xor(v1[j], 32); }
                            v0 = v0 * cs0 + o0 * sn0; v1 = v1 * cs1 + o1 * sn1; }
                        u32x4 w; w.x = cvt_pk_bf16(v0[0], v0[1]); w.y = cvt_pk_bf16(v0[2], v0[3]); w.z = cvt_pk_bf16(v1[0], v1[1]); w.w = cvt_pk_bf16(v1[2], v1[3]);
                        *(u32x4*)(base + (size_t)row * 256 + bj * 128 + wc * 32 + 8 * fq) = w;
                    }
                }
        } else if (wc == 0 && fq < 3) {
#pragma unroll
            for (int ai = 0; ai < 2; ++ai)
#pragma unroll
                for (int m = 0; m < 4; ++m) {
                    const int row = row0 + ai * 128 + m * 16;
                    const f32x4 v0 = acc[ai][0][m][0], v1 = acc[ai][0][m][1];
                    const f32x4 s0 = {sigmoidf_(v0[0]), sigmoidf_(v0[1]), sigmoidf_(v0[2]), sigmoidf_(v0[3])}, s1 = {sigmoidf_(v1[0]), sigmoidf_(v1[1]), sigmoidf_(v1[2]), sigmoidf_(v1[3])};
                    *(f32x4*)(gates + (size_t)row * 24 + 8 * fq) = s0; *(f32x4*)(gates + (size_t)row * 24 + 8 * fq + 4) = s1;
                }
        }
    }
};
struct PoolOrder {
    int G, c;
    __device__ bool next(int i, Unit& u) const { const int L = i * G + c; if (L >= 128) return false; u.pm = L; u.pn = L >> 5; return true; }
    __device__ __forceinline__ void a_ready(const Unit&) const {}
    __device__ __forceinline__ void done(const Unit&) const {}
};
struct EpiPoolZ {
    static constexpr bool PERM = false, AFTER_DRAIN = false;
    float* Z;
    __device__ __forceinline__ void operator()(const f32x4 (&acc)[2][2][4][2], const Unit& u, int wr, int wc, int fr, int fq) const {
        const int row0 = (u.pm & 31) * 256 + wr * 64 + fr; const int col0 = u.pn * 256 + wc * 32 + 4 * fq;
        const __amdgpu_buffer_rsrc_t zr = __builtin_amdgcn_make_buffer_rsrc(Z, 0, MROWS * 1024 * 4, 0x00020000);
#pragma unroll
        for (int ai = 0; ai < 2; ++ai)
#pragma unroll
            for (int m = 0; m < 4; ++m)
#pragma unroll
                for (int bj = 0; bj < 2; ++bj)
#pragma unroll
                    for (int n = 0; n < 2; ++n) __builtin_amdgcn_raw_buffer_store_b128(__builtin_bit_cast(u32x4, acc[ai][bj][m][n]), zr, (unsigned)(((row0 + ai * 128 + m * 16) * 1024 + col0 + bj * 128 + n * 16) * 4), 0, 16);
    }
};
struct EpiStoreBf16 {
    static constexpr bool PERM = false, AFTER_DRAIN = false;
    bf16_t* O; int ldc;
    __device__ __forceinline__ void operator()(const f32x4 (&acc)[2][2][4][2], const Unit& u, int wr, int wc, int fr, int fq) const {
        const int row0 = u.pm * 256 + wr * 64 + fr; const int col0 = u.pn * 256 + wc * 32 + 4 * fq;
#pragma unroll
        for (int ai = 0; ai < 2; ++ai)
#pragma unroll
            for (int m = 0; m < 4; ++m)
#pragma unroll
                for (int bj = 0; bj < 2; ++bj)
#pragma unroll
                    for (int n = 0; n < 2; ++n) { const f32x4 v = acc[ai][bj][m][n]; u32x2 w; w.x = cvt_pk_bf16(v[0], v[1]); w.y = cvt_pk_bf16(v[2], v[3]);
                        *(u32x2*)(O + (size_t)(row0 + ai * 128 + m * 16) * ldc + col0 + bj * 128 + n * 16) = w; }
    }
};
struct EpiResid {
    static constexpr bool PERM = false, AFTER_DRAIN = false;
    const float* base; float* out;
    __device__ __forceinline__ void operator()(const f32x4 (&acc)[2][2][4][2], const Unit& u, int wr, int wc, int fr, int fq) const {
        const int row0 = u.pm * 256 + wr * 64 + fr; const int col0 = u.pn * 256 + wc * 32 + 4 * fq;
#pragma unroll
        for (int ai = 0; ai < 2; ++ai)
#pragma unroll
            for (int m = 0; m < 4; ++m)
#pragma unroll
                for (int bj = 0; bj < 2; ++bj)
#pragma unroll
                    for (int n = 0; n < 2; ++n) { const size_t off = (size_t)(row0 + ai * 128 + m * 16) * DM + col0 + bj * 128 + n * 16;
                        const f32x4 b = *(const f32x4*)(base + off); *(f32x4*)(out + off) = b + acc[ai][bj][m][n]; }
    }
};
struct EpiResidNorm {
    static constexpr bool PERM = true, AFTER_DRAIN = false;
    const float* basef; const bf16_t* baseb; bf16_t* hb; float* rowss;
    __device__ __forceinline__ void operator()(const f32x4 (&acc)[2][2][4][2], const Unit& u, int wr, int wc, int fr, int fq) const {
        const int row0 = u.pm * 256 + wr * 64 + fr; const int col0 = u.pn * 256 + wc * 32 + 8 * fq;
#pragma unroll
        for (int ai = 0; ai < 2; ++ai)
#pragma unroll
            for (int m = 0; m < 4; ++m) { const int row = row0 + ai * 128 + m * 16; float ss = 0.f;
#pragma unroll
                for (int bj = 0; bj < 2; ++bj) { const size_t off = (size_t)row * DM + col0 + bj * 128;
                    f32x4 b0, b1;
                    if (basef) { b0 = *(const f32x4*)(basef + off); b1 = *(const f32x4*)(basef + off + 4); }
                    else { const u32x4 bw = *(const u32x4*)(baseb + off);
                        b0 = (f32x4){__uint_as_float(bw.x << 16), __uint_as_float(bw.x & 0xffff0000u), __uint_as_float(bw.y << 16), __uint_as_float(bw.y & 0xffff0000u)};
                        b1 = (f32x4){__uint_as_float(bw.z << 16), __uint_as_float(bw.z & 0xffff0000u), __uint_as_float(bw.w << 16), __uint_as_float(bw.w & 0xffff0000u)}; }
                    const f32x4 o0 = b0 + acc[ai][bj][m][0], o1 = b1 + acc[ai][bj][m][1];
                    u32x4 w; w.x = cvt_pk_bf16(o0[0], o0[1]); w.y = cvt_pk_bf16(o0[2], o0[3]); w.z = cvt_pk_bf16(o1[0], o1[1]); w.w = cvt_pk_bf16(o1[2], o1[3]);
                    *(u32x4*)(hb + off) = w;
                    ss += ((o0[0] * o0[0] + o0[1] * o0[1]) + (o0[2] * o0[2] + o0[3] * o0[3])) + ((o1[0] * o1[0] + o1[1] * o1[1]) + (o1[2] * o1[2] + o1[3] * o1[3])); }
                ss += __shfl_xor(ss, 16); ss += __shfl_xor(ss, 32);
                if (fq == 0) unsafeAtomicAdd(rowss + row, ss); }
    }
};
struct UpperOrder {
    pg8::StaticOrder S; int lo, nup, c;
    __device__ bool next(int i, Unit& u) const { if (c < lo) return false; return S.next_linear((long)i * nup + (c - lo), u); }
    __device__ __forceinline__ void a_ready(const Unit&) const {}
    __device__ __forceinline__ void done(const Unit&) const {}
};
struct EpiSwiglu {
    static constexpr bool PERM = true, AFTER_DRAIN = false;
    bf16_t* O; const float* rowss;
    __device__ __forceinline__ void operator()(const f32x4 (&acc)[2][2][4][2], const Unit& u, int wr, int wc, int fr, int fq) const {
        const int row0 = u.pm * 256 + wr * 64 + fr; const int col0 = u.pn * 128 + wc * 32 + 8 * fq;
#pragma unroll
        for (int ai = 0; ai < 2; ++ai)
#pragma unroll
            for (int m = 0; m < 4; ++m) {
                const float rs = 1.0f / sqrtf(rowss[row0 + ai * 128 + m * 16] * (1.f / DM) + 1e-6f);
                float r[8];
#pragma unroll
                for (int n = 0; n < 2; ++n)
#pragma unroll
                    for (int j = 0; j < 4; ++j) { const float g = acc[ai][0][m][n][j] * rs, up = acc[ai][1][m][n][j] * rs; r[n * 4 + j] = g * sigmoidf_(g) * up; }
                u32x4 w; w.x = cvt_pk_bf16(r[0], r[1]); w.y = cvt_pk_bf16(r[2], r[3]); w.z = cvt_pk_bf16(r[4], r[5]); w.w = cvt_pk_bf16(r[6], r[7]);
                *(u32x4*)(O + (size_t)(row0 + ai * 128 + m * 16) * DFF + col0) = w;
            }
    }
};
struct EpiPle {
    static constexpr bool PERM = true, AFTER_DRAIN = false;
    const bf16_t* h; const bf16_t* pp; const float* rowss; bf16_t* hb3; float* rowss_out;
    __device__ __forceinline__ void operator()(const f32x4 (&acc)[2][2][4][2], const Unit& u, int wr, int wc, int fr, int fq) const {
        const int row0 = u.pm * 256 + wr * 64 + fr; const int col0 = u.pn * 256 + wc * 32 + 8 * fq;
#pragma unroll
        for (int ai = 0; ai < 2; ++ai)
#pragma unroll
            for (int m = 0; m < 4; ++m) { const int row = row0 + ai * 128 + m * 16; const float rs = 1.0f / sqrtf(rowss[row] * (1.f / DM) + 1e-6f); float ss = 0.f;
#pragma unroll
                for (int bj = 0; bj < 2; ++bj) { const size_t off = (size_t)row * DM + col0 + bj * 128;
                    const u32x4 bw = *(const u32x4*)(h + off); const u32x4 pw = *(const u32x4*)(pp + off);
                    const unsigned bwa[4] = {bw.x, bw.y, bw.z, bw.w}, pwa[4] = {pw.x, pw.y, pw.z, pw.w};
                    float o[8];
#pragma unroll
                    for (int e = 0; e < 8; ++e) { const float a_ = acc[ai][bj][m][e >> 2][e & 3] * rs;
                        const float bv = (e & 1) ? __uint_as_float(bwa[e >> 1] & 0xffff0000u) : __uint_as_float(bwa[e >> 1] << 16);
                        const float pv = (e & 1) ? __uint_as_float(pwa[e >> 1] & 0xffff0000u) : __uint_as_float(pwa[e >> 1] << 16);
                        o[e] = bv + pv * sigmoidf_(a_); ss += o[e] * o[e]; }
                    u32x4 w; w.x = cvt_pk_bf16(o[0], o[1]); w.y = cvt_pk_bf16(o[2], o[3]); w.z = cvt_pk_bf16(o[4], o[5]); w.w = cvt_pk_bf16(o[6], o[7]);
                    *(u32x4*)(hb3 + off) = w; }
                ss += __shfl_xor(ss, 16); ss += __shfl_xor(ss, 32);
                if (fq == 0) unsafeAtomicAdd(rowss_out + row, ss); }
    }
};

__device__ __forceinline__ void tr_item(const float* __restrict__ W, int K, int N, int nvalid, bf16_t* __restrict__ WT, int drow0, LAS float*, int k0, int n0, int lane, const float* __restrict__ gain = nullptr) {
    const int ko = lane & 7, nq = lane >> 3; const int n = n0 + 4 * nq; const bool ok = n < nvalid;
    const float* src = W + (size_t)(k0 + 8 * ko) * N + n;
    f32x4 v[8];
#pragma unroll
    for (int i = 0; i < 8; ++i) v[i] = ok ? __builtin_nontemporal_load((const f32x4*)(src + (size_t)i * N)) : (f32x4){0.f, 0.f, 0.f, 0.f};
    if (gain) { const f32x4 g0 = *(const f32x4*)(gain + k0 + 8 * ko), g1 = *(const f32x4*)(gain + k0 + 8 * ko + 4);
#pragma unroll
        for (int i = 0; i < 4; ++i) { v[i] = v[i] * g0[i]; v[4 + i] = v[4 + i] * g1[i]; } }
#pragma unroll
    for (int j = 0; j < 4; ++j) { u32x4 o; o.x = cvt_pk_bf16(v[0][j], v[1][j]); o.y = cvt_pk_bf16(v[2][j], v[3][j]); o.z = cvt_pk_bf16(v[4][j], v[5][j]); o.w = cvt_pk_bf16(v[6][j], v[7][j]);
        __builtin_nontemporal_store(o, (u32x4*)(WT + (size_t)(drow0 + 4 * nq + j) * K + k0 + 8 * ko)); }
}
template <bool OUT_BF16>
__device__ __forceinline__ void rms_row(const float* src, const float* __restrict__ g, void* dst, int lane) {
    const f32x4* xr = (const f32x4*)src + 2 * lane; f32x4 v[8]; float s = 0.f;
#pragma unroll
    for (int j = 0; j < 4; ++j) { v[2 * j] = xr[128 * j]; v[2 * j + 1] = xr[128 * j + 1]; }
#pragma unroll
    for (int j = 0; j < 8; ++j) s += (v[j][0] * v[j][0] + v[j][1] * v[j][1]) + (v[j][2] * v[j][2] + v[j][3] * v[j][3]);
    const float rstd = 1.0f / sqrtf(wave_sum(s) * (1.f / DM) + 1e-6f);
#pragma unroll
    for (int j = 0; j < 4; ++j) { const f32x4 g0 = ((const f32x4*)g)[2 * lane + 128 * j], g1 = ((const f32x4*)g)[2 * lane + 128 * j + 1];
        const f32x4 y0 = v[2 * j] * rstd * g0, y1 = v[2 * j + 1] * rstd * g1;
        if (OUT_BF16) { u32x4 w; w.x = cvt_pk_bf16(y0[0], y0[1]); w.y = cvt_pk_bf16(y0[2], y0[3]); w.z = cvt_pk_bf16(y1[0], y1[1]); w.w = cvt_pk_bf16(y1[2], y1[3]); ((u32x4*)dst)[lane + 64 * j] = w; }
        else { ((f32x4*)dst)[2 * lane + 128 * j] = y0; ((f32x4*)dst)[2 * lane + 128 * j + 1] = y1; } }
}

__device__ __forceinline__ float gelu_tanh(float x) { const float y = 0.7978845608028654f * (x + 0.044715f * x * x * x); const float e = __expf(2.f * y); return 0.5f * x * (2.f - 2.f * __builtin_amdgcn_rcpf(e + 1.f)); }
__device__ __forceinline__ void compress_job(LAS unsigned char* lds, const bf16_t* __restrict__ X, const bf16_t* __restrict__ W1t, const bf16_t* __restrict__ W2t,
                                             const float* __restrict__ bias, bf16_t* outc, int b, int g, int n0) {
    int tid_ = threadIdx.x; asm volatile("" : "+v"(tid_));
    const int tid = tid_, wid = __builtin_amdgcn_readfirstlane(tid >> 6), lane = tid & 63, fr = lane & 15, fq = lane >> 4;
    const int nn = min(n0 + fr, 126);
    const bf16_t* Ab = X + ((size_t)b * SEQ + 16 * nn) * 256 + g * 128 + 16 * fq;
    const bf16_t* Bb = W1t + (size_t)fr * 4096 + 16 * fq;
    f32x4 acc[8];
#pragma unroll
    for (int ct = 0; ct < 8; ++ct) acc[ct] = (f32x4){0.f, 0.f, 0.f, 0.f};
#pragma unroll 1
    for (int i = 0; i < 8; i += 2) {
        bf16x8 av[2][2], bv[2][8][2];
#pragma unroll
        for (int u = 0; u < 2; ++u) { const int pp = 8 * wid + i + u; const bf16_t* ap = Ab + (pp >> 1) * 256 + (pp & 1) * 64;
            av[u][0] = *(const bf16x8*)ap; av[u][1] = *(const bf16x8*)(ap + 8);
#pragma unroll
            for (int ct = 0; ct < 8; ++ct) { const bf16_t* bp = Bb + (size_t)ct * 16 * 4096 + 64 * pp; bv[u][ct][0] = *(const bf16x8*)bp; bv[u][ct][1] = *(const bf16x8*)(bp + 8); } }
        __builtin_amdgcn_sched_barrier(0);
#pragma unroll
        for (int u = 0; u < 2; ++u)
#pragma unroll
            for (int hh = 0; hh < 2; ++hh)
#pragma unroll
                for (int ct = 0; ct < 8; ++ct) acc[ct] = __builtin_amdgcn_mfma_f32_16x16x32_bf16(av[u][hh], bv[u][ct][hh], acc[ct], 0, 0, 0);
    }
    LAS float* part = (LAS float*)lds;
#pragma unroll
    for (int ct = 0; ct < 8; ++ct)
#pragma unroll
        for (int r = 0; r < 4; ++r) part[(wid * 16 + 4 * fq + r) * 132 + 16 * ct + fr] = acc[ct][r];
    __syncthreads();
    LAS bf16_t* hid = (LAS bf16_t*)(lds + 67584);
    { const int row = tid >> 5, c4 = (tid & 31) * 4; f32x4 s = *(const f32x4*)(bias + c4);
      { f32x4 bp[31];
#pragma unroll
        for (int l = 1; l < 32; ++l) bp[l - 1] = *(const f32x4*)(bias + l * 128 + c4);
#pragma unroll
        for (int l = 1; l < 32; ++l) s += bp[l - 1]; }
#pragma unroll
      for (int w = 0; w < 8; ++w) s += *(const LAS f32x4*)(part + (w * 16 + row) * 132 + c4);
      u32x2 hw; hw.x = cvt_pk_bf16(gelu_tanh(s[0]), gelu_tanh(s[1])); hw.y = cvt_pk_bf16(gelu_tanh(s[2]), gelu_tanh(s[3]));
      *(LAS u32x2*)(hid + row * 136 + c4) = hw; }
    __syncthreads();
    f32x4 acc2 = {0.f, 0.f, 0.f, 0.f};
    const __amdgpu_buffer_rsrc_t orsrc = __builtin_amdgcn_make_buffer_rsrc(outc, 0, 8 * 128 * 128 * 2, 0x00020000);
#pragma unroll
    for (int s = 0; s < 4; ++s) { const bf16x8 a = *(const LAS bf16x8*)(hid + fr * 136 + 32 * s + 8 * fq);
        const bf16x8 bb = *(const bf16x8*)(W2t + (size_t)(16 * wid + fr) * 128 + 32 * s + 8 * fq); acc2 = __builtin_amdgcn_mfma_f32_16x16x32_bf16(a, bb, acc2, 0, 0, 0); }
#pragma unroll
    for (int r = 0; r < 4; ++r) { const int n = n0 + 4 * fq + r; const float v = (n == 127) ? 0.f : acc2[r];
        __builtin_amdgcn_raw_buffer_store_b16((short)(cvt_pk_bf16(v, v) & 0xffffu), orsrc, (unsigned)((((b * 2 + g) * 128 + n) * 128 + 16 * wid + fr) * 2), 0, 16); }
    __syncthreads();
}


template <bool FENCE>
__device__ __forceinline__ void signal_done(unsigned* cnt, unsigned n) {
    asm volatile("s_waitcnt vmcnt(0)" ::: "memory"); __syncthreads();
    if (threadIdx.x == 0 && n) { if (FENCE) { __builtin_amdgcn_fence(__ATOMIC_RELEASE, "agent"); asm volatile("s_waitcnt vmcnt(0)" ::: "memory"); }
        (void)__hip_atomic_fetch_add(cnt, n, __ATOMIC_RELAXED, __HIP_MEMORY_SCOPE_AGENT); }
}
__device__ __forceinline__ void wait_count(unsigned* cnt, unsigned want) {
    if (threadIdx.x == 0) { unsigned spins = 0;
        while (__hip_atomic_load(cnt, __ATOMIC_RELAXED, __HIP_MEMORY_SCOPE_AGENT) < want && ++spins < (1u << 22)) __builtin_amdgcn_s_sleep(2);
        __builtin_amdgcn_fence(__ATOMIC_ACQUIRE, "agent"); asm volatile("s_waitcnt vmcnt(0)" ::: "memory"); }
    __syncthreads();
}
namespace att {
constexpr float SCALE = 0.08838834764831845f, CL2 = SCALE * 1.4426950408889634f, NEGB = -1e30f;
#define KSWZ(row, colB) ((row) * 256 + ((colB) ^ (((row) & 7) << 4)))
#define SBAR() __builtin_amdgcn_sched_barrier(0)
__device__ __forceinline__ int crow(int r, int hi) { return (r & 3) + 8 * (r >> 2) + 4 * hi; }
__device__ __forceinline__ int v_st(int k, int c) { const int kk = (k & ~0xC) | ((k & 4) << 1) | ((k & 8) >> 1); return ((kk >> 3) * 4 + (c >> 5)) * 512 + ((kk & 7) * 32 + (c & 31)) * 2; }
__device__ __forceinline__ int v_rd_base(int lane) { return ((lane & 3) << 3) | (((lane >> 2) & 3) << 6) | (((lane >> 4) & 1) << 5) | (((lane >> 5) & 1) << 8); }
constexpr int v_rd_off(int d0, int ks, int half) { return d0 * 512 + ks * 4096 + half * 2048; }
template <int OFF> __device__ __forceinline__ s16x4 tr_read(int vb) { s16x4 r; asm volatile("ds_read_b64_tr_b16 %0, %1 offset:%2" : "=&v"(r) : "v"(vb), "i"(OFF) : "memory"); return r; }
template <int D0> __device__ __forceinline__ void pv_one(f32x16& od, int vb, bf16x8 pa0, bf16x8 pa1, bf16x8 pa2, bf16x8 pa3) {
    const s16x4 l0 = tr_read<v_rd_off(D0, 0, 0)>(vb), h0 = tr_read<v_rd_off(D0, 0, 1)>(vb), l1 = tr_read<v_rd_off(D0, 1, 0)>(vb), h1 = tr_read<v_rd_off(D0, 1, 1)>(vb);
    const s16x4 l2 = tr_read<v_rd_off(D0, 2, 0)>(vb), h2 = tr_read<v_rd_off(D0, 2, 1)>(vb), l3 = tr_read<v_rd_off(D0, 3, 0)>(vb), h3 = tr_read<v_rd_off(D0, 3, 1)>(vb);
    asm volatile("s_waitcnt lgkmcnt(0)" ::: "memory"); SBAR();
#define PK(L, H) (bf16x8){L[0], L[1], L[2], L[3], H[0], H[1], H[2], H[3]}
    __builtin_amdgcn_s_setprio(1);
    od = __builtin_amdgcn_mfma_f32_32x32x16_bf16(pa0, PK(l0, h0), od, 0, 0, 0);
    od = __builtin_amdgcn_mfma_f32_32x32x16_bf16(pa1, PK(l1, h1), od, 0, 0, 0);
    od = __builtin_amdgcn_mfma_f32_32x32x16_bf16(pa2, PK(l2, h2), od, 0, 0, 0);
    od = __builtin_amdgcn_mfma_f32_32x32x16_bf16(pa3, PK(l3, h3), od, 0, 0, 0);
    __builtin_amdgcn_s_setprio(0);
#undef PK
}
__device__ __forceinline__ void pv_d0(f32x16* o, int vb, bf16x8 pa0, bf16x8 pa1, bf16x8 pa2, bf16x8 pa3) {
    pv_one<0>(o[0], vb, pa0, pa1, pa2, pa3); pv_one<1>(o[1], vb, pa0, pa1, pa2, pa3); pv_one<2>(o[2], vb, pa0, pa1, pa2, pa3); pv_one<3>(o[3], vb, pa0, pa1, pa2, pa3);
}
__device__ __forceinline__ void qkt(f32x16& p0, f32x16& p1, const LAS char* Ks, const bf16x8* qr, int r32, int hi) {
    p0 = f32x16{}; p1 = f32x16{};
    __builtin_amdgcn_s_setprio(1);
#pragma unroll
    for (int d0 = 0; d0 < 8; ++d0) { const int cb = (d0 * 16 + hi * 8) * 2;
        const bf16x8 b0 = *(const LAS bf16x8*)(Ks + KSWZ(r32, cb));
        const bf16x8 b1 = *(const LAS bf16x8*)(Ks + KSWZ(32 + r32, cb));
        p0 = __builtin_amdgcn_mfma_f32_32x32x16_bf16(b0, qr[d0], p0, 0, 0, 0);
        p1 = __builtin_amdgcn_mfma_f32_32x32x16_bf16(b1, qr[d0], p1, 0, 0, 0);
#ifdef QKT_SBAR
        if ((d0 & (QKT_SBAR - 1)) == QKT_SBAR - 1) SBAR();
#endif
    }
    __builtin_amdgcn_s_setprio(0);
}
__device__ __forceinline__ void sm_step(f32x16& p0, f32x16& p1, bool lane_on, float& m_reg, float& l_reg, f32x16* o, LAS float* al_l, int r32, int hi,
                                        bf16x8& pa0, bf16x8& pa1, bf16x8& pa2, bf16x8& pa3, float& alpha_out) {
    float pmax = p0[0];
#pragma unroll
    for (int r = 1; r < 16; ++r) pmax = fmaxf(pmax, p0[r]);
#pragma unroll
    for (int r = 0; r < 16; ++r) pmax = fmaxf(pmax, p1[r]);
    pmax = lane_on ? pmax : NEGB;
    { auto rr = __builtin_amdgcn_permlane32_swap(__float_as_uint(pmax), __float_as_uint(pmax), false, false);
      pmax = fmaxf(__uint_as_float(rr[0]), __uint_as_float(rr[1])); }
    float mn, alpha;
    if (__all(pmax - m_reg <= 8.0f / SCALE)) { mn = m_reg; alpha = 1.f; }
    else { mn = fmaxf(m_reg, pmax); alpha = __builtin_amdgcn_exp2f((m_reg - mn) * CL2); }
    m_reg = mn; alpha_out = alpha;
    const float mnC = (!lane_on || mn < -1e29f) ? -INFINITY : -mn * CL2;
#pragma unroll
    for (int r = 0; r < 16; ++r) p0[r] = __builtin_amdgcn_exp2f(fmaf(p0[r], CL2, mnC));
#pragma unroll
    for (int r = 0; r < 16; ++r) p1[r] = __builtin_amdgcn_exp2f(fmaf(p1[r], CL2, mnC));
    float ps = 0.f;
#pragma unroll
    for (int r = 0; r < 16; ++r) ps += p0[r];
#pragma unroll
    for (int r = 0; r < 16; ++r) ps += p1[r];
    { auto rr = __builtin_amdgcn_permlane32_swap(__float_as_uint(ps), __float_as_uint(ps), false, false);
      ps = __uint_as_float(rr[0]) + __uint_as_float(rr[1]); }
    l_reg = l_reg * alpha + ps;
    if (__any(alpha < 1.f)) { if (hi == 0) al_l[r32] = alpha; LDS_WAIT();
#pragma unroll
        for (int d = 0; d < 4; ++d)
#pragma unroll
            for (int r = 0; r < 16; ++r) o[d][r] *= al_l[crow(r, hi)];
    }
#define PK4(P, BASE, OUT) do { unsigned a0_ = cvt_pk_bf16(P[BASE + 0], P[BASE + 1]), a1_ = cvt_pk_bf16(P[BASE + 2], P[BASE + 3]);   \
    unsigned b0_ = cvt_pk_bf16(P[BASE + 4], P[BASE + 5]), b1_ = cvt_pk_bf16(P[BASE + 6], P[BASE + 7]);                              \
    auto r0_ = __builtin_amdgcn_permlane32_swap(a0_, b0_, false, false); auto r1_ = __builtin_amdgcn_permlane32_swap(a1_, b1_, false, false); \
    u32x4 w_ = {r0_[0], r1_[0], r0_[1], r1_[1]}; OUT = __builtin_bit_cast(bf16x8, w_); } while (0)
    PK4(p0, 0, pa0); PK4(p0, 8, pa1); PK4(p1, 0, pa2); PK4(p1, 8, pa3);
#undef PK4
}
struct Stg { bf16x8 k0, k1, v0, v1; };
__device__ __forceinline__ void tile_load(Stg& s, const bf16_t* Kb, const bf16_t* Vb, int pitch, int key0, int sr, int sc) {
    s.k0 = *(const bf16x8*)(Kb + (size_t)(key0 + sr) * pitch + sc); s.k1 = *(const bf16x8*)(Kb + (size_t)(key0 + 32 + sr) * pitch + sc);
    s.v0 = *(const bf16x8*)(Vb + (size_t)(key0 + sr) * pitch + sc); s.v1 = *(const bf16x8*)(Vb + (size_t)(key0 + 32 + sr) * pitch + sc);
}
__device__ __forceinline__ void tile_write(LAS char* Kl, LAS char* Vl, const Stg& s, int sr, int sc) {
    *(LAS bf16x8*)(Vl + v_st(sr, sc)) = s.v0; *(LAS bf16x8*)(Vl + v_st(32 + sr, sc)) = s.v1;
    *(LAS bf16x8*)(Kl + KSWZ(sr, sc * 2)) = s.k0; *(LAS bf16x8*)(Kl + KSWZ(32 + sr, sc * 2)) = s.k1;
}
__device__ __forceinline__ void tile_dma(LAS char* Kl, LAS char* Vl, const bf16_t* Kb, const bf16_t* Vb, int pitch, int key0, int wid, int lane) {
#pragma unroll
    for (int h = 0; h < 2; ++h) {
        const int ch = wid * 2 + h; const int L = ch * 1024 + lane * 16;
        { const int row = L >> 8, c16 = ((L >> 4) & 15) ^ (row & 7);
          __builtin_amdgcn_global_load_lds((const unsigned*)(Kb + (size_t)(key0 + row) * pitch + c16 * 8), (LAS unsigned*)(Kl + ch * 1024), 16, 0, 0); }
        { const int sub = L >> 9, kk = (sub >> 2) * 8 + ((L >> 6) & 7), c8 = (sub & 3) * 4 + ((L >> 4) & 3);
          const int k = (kk & ~0xC) | ((kk & 4) << 1) | ((kk & 8) >> 1);
          __builtin_amdgcn_global_load_lds((const unsigned*)(Vb + (size_t)(key0 + k) * pitch + c8 * 8), (LAS unsigned*)(Vl + ch * 1024), 16, 0, 0); }
    }
}
template <int MODE>
__device__ __forceinline__ void finalize(const f32x16* o, float l_reg, float gate, LAS float* li_l, int r32, int hi, float* scrA, float* scrB, bf16_t* catp) {
    if (hi == 0) li_l[r32] = l_reg > 0.f ? gate / l_reg : 0.f;
    LDS_WAIT();
#pragma unroll
    for (int r = 0; r < 16; ++r) {
        const int rc = (r & 3) + 8 * (r >> 2);
        unsigned lo = (unsigned)(4 * hi) * 1024u + (unsigned)r32, lc = (unsigned)(4 * hi) * 2048u + (unsigned)r32;
        asm volatile("" : "+v"(lo), "+v"(lc));
        const float f = li_l[rc + 4 * hi];
        if (MODE == 2) {
            float va[4], vb[4];
#pragma unroll
            for (int d0 = 0; d0 < 4; ++d0) { va[d0] = scrA[lo + rc * 1024 + 32 * d0]; vb[d0] = scrB[lo + rc * 1024 + 32 * d0]; }
#pragma unroll
            for (int d0 = 0; d0 < 4; ++d0) { const float v = o[d0][r] * f + (va[d0] + vb[d0]); catp[lc + rc * 2048 + 32 * d0] = (bf16_t)(cvt_pk_bf16(v, v) & 0xffffu); }
            if (r & 1) asm volatile("" ::: "memory");
        } else {
#pragma unroll
            for (int d0 = 0; d0 < 4; ++d0) { const float v = o[d0][r] * f; if (MODE == 0) scrA[lo + rc * 1024 + 32 * d0] = v; else scrB[lo + rc * 1024 + 32 * d0] = v; }
        }
    }
    LDS_WAIT();
}
template <bool WIN>
__device__ __forceinline__ void run_branch(LAS char* K_l, LAS char* V_l, const bf16_t* Kb, const bf16_t* Vb, unsigned tiles, unsigned lanemask, int c, int tl,
                                           const bf16x8* qr, float& m_reg, float& l_reg, f32x16* o, LAS float* al_l, int r32, int hi, int wid, int lane, int vb0) {
    unsigned rem = tiles; int j = __builtin_ctz(rem); rem &= rem - 1;
    __syncthreads();
    tile_dma(K_l, V_l, Kb, Vb, 256, 64 * j, wid, lane);
    asm volatile("s_waitcnt vmcnt(0)" ::: "memory"); __syncthreads();
    int cur = 0;
    for (;;) {
        const int jn = rem ? __builtin_ctz(rem) : -1;
        if (jn >= 0) { rem &= rem - 1; tile_dma(K_l + (cur ^ 1) * 32768, V_l + (cur ^ 1) * 32768, Kb, Vb, 256, 64 * jn, wid, lane); }
        const bool lane_on = (lanemask >> j) & 1u;
#ifdef ATT_NOANY
        {
#else
        if (__any(lane_on)) {
#endif
            f32x16 p0, p1; qkt(p0, p1, K_l + cur * 32768, qr, r32, hi);
            if (j == c) {
                int tlv = tl - 4 * hi; asm volatile("" : "+v"(tlv));
#pragma unroll
                for (int r = 0; r < 16; ++r) { const int kk = (r & 3) + 8 * (r >> 2); p0[r] = (kk > tlv) ? NEGB : p0[r]; p1[r] = (kk + 32 > tlv) ? NEGB : p1[r]; }
            }
            if (WIN && j == c - 8) {
                int tlv = tl - 4 * hi; asm volatile("" : "+v"(tlv));
#pragma unroll
                for (int r = 0; r < 16; ++r) { const int kk = (r & 3) + 8 * (r >> 2); p0[r] = (kk <= tlv) ? NEGB : p0[r]; p1[r] = (kk + 32 <= tlv) ? NEGB : p1[r]; }
            }
            bf16x8 pa0, pa1, pa2, pa3; float al;
            sm_step(p0, p1, lane_on, m_reg, l_reg, o, al_l, r32, hi, pa0, pa1, pa2, pa3, al);
            pv_d0(o, vb0 + cur * 32768, pa0, pa1, pa2, pa3);
        }
        if (jn < 0) break;
        asm volatile("s_waitcnt vmcnt(0)" ::: "memory"); __syncthreads();
        j = jn; cur ^= 1;
    }
}
constexpr int L_V = 0, L_K = 16384, L_IMP = 65536, L_SIMP = 99328, L_MASK = 107776, L_WS = 108288;
__device__ __forceinline__ void attn_unit(LAS unsigned char* ldsb, const bf16_t* __restrict__ T, const bf16_t* kcmp, const bf16_t* vcmp,
                                          const float* __restrict__ gates, float* scr, float* scr2, bf16_t* cat, int b, int g, int c, unsigned* cmp_cnt) {
    LAS char* lds = (LAS char*)ldsb;
    int tid_ = threadIdx.x; asm volatile("" : "+v"(tid_));
    const int tid = tid_, wid = __builtin_amdgcn_readfirstlane(tid >> 6), lane = tid & 63, r32 = lane & 31, hi = lane >> 5;
    const int hh = wid & 3, ch = wid >> 2, h = g * 4 + hh;
    const int tl = 32 * ch + r32, t = 64 * c + tl;
    const size_t row = (size_t)b * SEQ + t;
    LAS char* V_l = lds + L_V; LAS char* K_l = lds + L_K;
    LAS float* impw = (LAS float*)(lds + L_IMP) + wid * 1056;
    LAS float* simp = (LAS float*)(lds + L_SIMP);
    LAS unsigned* maskw = (LAS unsigned*)(lds + L_MASK);
    LAS float* li_l = (LAS float*)(lds + L_WS) + wid * 64; LAS float* al_l = li_l + 32;
    bf16x8 qr[8];
    { const bf16_t* Qw = T + (size_t)(4 + (h >> 1)) * TS + row * 256 + (h & 1) * 128 + hi * 8;
#pragma unroll
      for (int d0 = 0; d0 < 8; ++d0) qr[d0] = *(const bf16x8*)(Qw + d0 * 16); }
    const int vb0 = (int)(uintptr_t)V_l + v_rd_base(lane);
    const float g0 = gates[row * 24 + h * 3 + 0], g1 = gates[row * 24 + h * 3 + 1], g2 = gates[row * 24 + h * 3 + 2];
    float* scrp = scr + ((size_t)b * SEQ + 64 * c + 32 * ch) * 1024 + h * 128;
    float* scrq = scr2 + ((size_t)b * SEQ + 64 * c + 32 * ch) * 1024 + h * 128;
    bf16_t* catp = cat + ((size_t)b * SEQ + 64 * c + 32 * ch) * DM + 1024 + h * 128;
    if (tid == 0) maskw[64] = 0u;
    float m_reg = NEGB, l_reg = 0.f; f32x16 o[4];
#pragma unroll
    for (int d = 0; d < 4; ++d) o[d] = f32x16{};
    { const bf16_t* Kb = T + (size_t)12 * TS + (size_t)b * SEQ * 256 + g * 128; const bf16_t* Vb = T + (size_t)13 * TS + (size_t)b * SEQ * 256 + g * 128;
      const int lo = c >= 8 ? c - 8 : 0; const unsigned wt = (c == 31 ? 0xffffffffu : ((1u << (c + 1)) - 1u)) & ~((1u << lo) - 1u);
#ifndef ATT_SKIP_B2
      run_branch<true>(K_l, V_l, Kb, Vb, wt, 0xffffffffu, c, tl, qr, m_reg, l_reg, o, al_l, r32, hi, wid, lane, vb0);
#endif
      finalize<0>(o, l_reg, g2, li_l, r32, hi, scrp, scrq, catp);
    }
    wait_count(cmp_cnt, 128u);
    m_reg = NEGB; l_reg = 0.f;
#pragma unroll
    for (int d = 0; d < 4; ++d) o[d] = f32x16{};
    {
        const bf16_t* Kb = kcmp + (size_t)(b * 2 + g) * 128 * 128; const bf16_t* Vb = vcmp + (size_t)(b * 2 + g) * 128 * 128;
        const int nmax = (t >= 31) ? ((t - 31) >> 4) : -1;
        bf16x8 pa0, pa1, pa2, pa3; float alA, alB;
        float inn[4][4], lst[4][4];
        __syncthreads();
        tile_dma(K_l, V_l, Kb, Vb, 128, 0, wid, lane); tile_dma(K_l + 32768, V_l + 32768, Kb, Vb, 128, 64, wid, lane);
        asm volatile("s_waitcnt vmcnt(0)" ::: "memory"); __syncthreads();
        {
            f32x16 a0, a1;
            qkt(a0, a1, K_l, qr, r32, hi);
#pragma unroll
            for (int r = 0; r < 16; ++r) { const int n = crow(r, hi); a0[r] = (n <= nmax) ? a0[r] : NEGB; a1[r] = (n + 32 <= nmax) ? a1[r] : NEGB; }
            sm_step(a0, a1, true, m_reg, l_reg, o, al_l, r32, hi, pa0, pa1, pa2, pa3, alA);
#pragma unroll
            for (int c4 = 0; c4 < 4; ++c4) { inn[0][c4] = (a0[4 * c4] + a0[4 * c4 + 1]) + (a0[4 * c4 + 2] + a0[4 * c4 + 3]); lst[0][c4] = a0[4 * c4 + 3];
                                             inn[1][c4] = (a1[4 * c4] + a1[4 * c4 + 1]) + (a1[4 * c4 + 2] + a1[4 * c4 + 3]); lst[1][c4] = a1[4 * c4 + 3]; }
        }
        pv_d0(o, vb0, pa0, pa1, pa2, pa3);
        {
            f32x16 b0, b1;
            qkt(b0, b1, K_l + 32768, qr, r32, hi);
#pragma unroll
            for (int r = 0; r < 16; ++r) { const int n = 64 + crow(r, hi); b0[r] = (n <= nmax) ? b0[r] : NEGB; b1[r] = (n + 32 <= nmax) ? b1[r] : NEGB; }
            sm_step(b0, b1, true, m_reg, l_reg, o, al_l, r32, hi, pa0, pa1, pa2, pa3, alB);
#pragma unroll
            for (int c4 = 0; c4 < 4; ++c4) { inn[2][c4] = (b0[4 * c4] + b0[4 * c4 + 1]) + (b0[4 * c4 + 2] + b0[4 * c4 + 3]); lst[2][c4] = b0[4 * c4 + 3];
                                             inn[3][c4] = (b1[4 * c4] + b1[4 * c4 + 1]) + (b1[4 * c4 + 2] + b1[4 * c4 + 3]); lst[3][c4] = b1[4 * c4 + 3]; }
        }
        pv_d0(o, vb0 + 32768, pa0, pa1, pa2, pa3);
        const float inv = l_reg > 0.f ? 1.f / l_reg : 0.f; const float fa = alB * inv, fb = inv;
        float x[4][4];
#pragma unroll
        for (int TT = 0; TT < 4; ++TT)
#pragma unroll
            for (int c4 = 0; c4 < 4; ++c4) { const float f = TT < 2 ? fa : fb; inn[TT][c4] *= f; lst[TT][c4] *= f; x[TT][c4] = __shfl_xor(lst[TT][c4], 32); }
#pragma unroll
        for (int TT = 0; TT < 4; ++TT)
#pragma unroll
            for (int c4 = 0; c4 < 4; ++c4) {
                const float plo = c4 >= 1 ? x[TT][c4 >= 1 ? c4 - 1 : 0] : (TT >= 1 ? x[TT >= 1 ? TT - 1 : 0][3] : 0.f);
                const float prev = hi ? x[TT][c4] : plo;
                impw[r32 * 33 + 8 * TT + 2 * c4 + hi] = inn[TT][c4] + prev;
            }
#ifndef ATT_SKIP_FIN
        finalize<1>(o, l_reg, g0, li_l, r32, hi, scrp, scrq, catp);
#endif
    }
    __syncthreads();
    {
        const int pidx = tid >> 3, sub = tid & 7;
        const LAS float* ib = (const LAS float*)(lds + L_IMP) + ((pidx >> 5) * 4) * 1056 + (pidx & 31) * 33;
#pragma unroll
        for (int jj = 0; jj < 4; ++jj) { const int j = 4 * sub + jj; float sv = (ib[j] + ib[1056 + j]) + (ib[2112 + j] + ib[3168 + j]);
            if (j > c) sv = -1.f; else if (j == 0 || j == c || j == c - 1) sv = 3.0e38f;
            simp[pidx * 33 + j] = sv; }
        __syncthreads();
        float vj[4]; int rk[4];
#pragma unroll
        for (int jj = 0; jj < 4; ++jj) { vj[jj] = simp[pidx * 33 + 4 * sub + jj]; rk[jj] = 0; }
#pragma unroll 1
        for (int i = 0; i < 32; ++i) { const float vi = simp[pidx * 33 + i];
#pragma unroll
            for (int jj = 0; jj < 4; ++jj) rk[jj] += (vi > vj[jj] || (vi == vj[jj] && i < 4 * sub + jj)) ? 1 : 0; }
        unsigned bits = 0u;
#pragma unroll
        for (int jj = 0; jj < 4; ++jj) { const int j = 4 * sub + jj; if (rk[jj] < 16 && j <= c) bits |= 1u << j; }
        bits |= __shfl_xor(bits, 1); bits |= __shfl_xor(bits, 2); bits |= __shfl_xor(bits, 4);
        if (sub == 0) maskw[pidx] = bits;
        bits |= __shfl_xor(bits, 8); bits |= __shfl_xor(bits, 16); bits |= __shfl_xor(bits, 32);
        if (lane == 0) atomicOr((unsigned*)(maskw + 64), bits);
    }
    __syncthreads();
    const unsigned umask = __builtin_amdgcn_readfirstlane(maskw[64]);
    const unsigned mymask = maskw[tl];
    m_reg = NEGB; l_reg = 0.f;
#pragma unroll
    for (int d = 0; d < 4; ++d) o[d] = f32x16{};
    { const bf16_t* Kb = T + (size_t)10 * TS + (size_t)b * SEQ * 256 + g * 128; const bf16_t* Vb = T + (size_t)11 * TS + (size_t)b * SEQ * 256 + g * 128;
#ifndef ATT_SKIP_B1
      run_branch<false>(K_l, V_l, Kb, Vb, umask, mymask, c, tl, qr, m_reg, l_reg, o, al_l, r32, hi, wid, lane, vb0);
#endif
#ifndef ATT_SKIP_FIN
      finalize<2>(o, l_reg, g1, li_l, r32, hi, scrp, scrq, catp);
#endif
    }
    __syncthreads();
}
}

template <int W>
__device__ __forceinline__ void pool_rows16(const float* __restrict__ Z, const float* __restrict__ scale, bf16_t* cat, int base, int q) {
    const int seq0 = base & ~(SEQ - 1);
    f32x4 v[15 + W];
#pragma unroll
    for (int i = 0; i < 15 + W; ++i) { const int r = base - (W - 1) + i; v[i] = (r >= seq0) ? *((const f32x4*)Z + (size_t)r * 256 + q) : (f32x4){0.f, 0.f, 0.f, 0.f}; }
    const f32x4 sv = ((const f32x4*)scale)[q];
#pragma unroll
    for (int j = 0; j < 16; ++j) { f32x4 s = v[j + W - 1];
#pragma unroll
        for (int k = 1; k < W; ++k) s += v[j + W - 1 - k];
        const int t = (base + j) & (SEQ - 1); const int n = min(W, t + 1); const float rc = 1.0f / (float)n;
        const f32x4 y = (s * rc - v[j + W - 1]) * sv;
        u32x2 wv; wv.x = cvt_pk_bf16(y[0], y[1]); wv.y = cvt_pk_bf16(y[2], y[3]);
        *(u32x2*)(cat + (size_t)(base + j) * DM + 4 * q) = wv; }
}
__device__ __forceinline__ void pool_finalize(const float* __restrict__ Z, const float* __restrict__ scale, bf16_t* cat, int row_begin, int nrows) {
    const int q = threadIdx.x & 255, grp = __builtin_amdgcn_readfirstlane((int)(threadIdx.x & 255) >> 6);
    for (int base = row_begin + 16 * (int)(threadIdx.x >> 8); base < row_begin + nrows; base += 32) {
        if (grp == 0) pool_rows16<2>(Z, scale, cat, base, q); else if (grp == 1) pool_rows16<4>(Z, scale, cat, base, q);
        else if (grp == 2) pool_rows16<8>(Z, scale, cat, base, q); else pool_rows16<16>(Z, scale, cat, base, q);
    }
}

#define XB_TMO      128
#define XB_XCNT(j)  (256  + 64 * (j))
#define XB_XSUB(j)  (1280 + 64 * (j))
#define XB_XGEN(j)  (2304 + 64 * (j))
#define XB_TOP      3328
#define XB_TOPGEN   3392
#define XCD_BAR_WORDS 3456
#define XB_SPIN_CAP (1u << 18)

__device__ __forceinline__ unsigned xb_ld(unsigned* p)              { return __hip_atomic_load(p, __ATOMIC_RELAXED, __HIP_MEMORY_SCOPE_AGENT); }
__device__ __forceinline__ unsigned xb_add(unsigned* p, unsigned v) { return __hip_atomic_fetch_add(p, v, __ATOMIC_RELAXED, __HIP_MEMORY_SCOPE_AGENT); }
__device__ __forceinline__ unsigned xb_xcc_id() { return (unsigned)__builtin_amdgcn_s_getreg((3 << 11) | 20) & 0xFu; }
#define XB_SPIN(cond, bar) do { unsigned _sp = 0; while (cond) { __builtin_amdgcn_s_sleep(1); \
    if ((++_sp & 255u) == 0u) { if (xb_ld(&(bar)[XB_TMO])) break; if (_sp > XB_SPIN_CAP) { atomicAdd(&(bar)[XB_TMO], 1u); break; } } } } while (0)

struct XcdBarrier {
    unsigned* bar; unsigned x;
    volatile LAS unsigned* st;
};

__device__ __forceinline__ XcdBarrier xcd_barrier_post(unsigned* bar, volatile LAS unsigned* st) {
    XcdBarrier b; b.bar = bar; b.x = xb_xcc_id(); b.st = st;
    if (threadIdx.x == 0) (void)xb_add(&bar[XB_XCNT(b.x)], 1u);
    return b;
}
__device__ __forceinline__ void xcd_barrier_complete(unsigned* bar, unsigned x, unsigned& nloc, unsigned& nx) {
    const unsigned G = gridDim.x * gridDim.y * gridDim.z;
    unsigned sum, cnt, mine, sp = 0u;
    for (;;) {
        sum = 0u; cnt = 0u; mine = 0u;
#pragma unroll
        for (unsigned j = 0; j < 16; ++j) { const unsigned c = xb_ld(&bar[XB_XCNT(j)]); sum += c; cnt += (c > 0u) ? 1u : 0u; mine = (j == x) ? c : mine; }
        if (sum == G) break;
        __builtin_amdgcn_s_sleep(1);
        if ((++sp & 255u) == 0u) { if (xb_ld(&bar[XB_TMO])) break; if (sp > XB_SPIN_CAP) { atomicAdd(&bar[XB_TMO], 1u); break; } }
    }
    nloc = mine > 0u ? mine : 1u; nx = cnt > 0u ? cnt : 1u;
}

__device__ __forceinline__ void xcd_barrier(const XcdBarrier& b) {
    asm volatile("s_waitcnt vmcnt(0)" ::: "memory");
    __syncthreads();
    if (threadIdx.x == 0) {
        unsigned* bar = b.bar;
        __builtin_amdgcn_s_waitcnt(0);
        unsigned nloc = b.st[0], nx = b.st[1];
        if (nloc == 0u) { xcd_barrier_complete(bar, b.x, nloc, nx); b.st[0] = nloc; b.st[1] = nx; }
        const unsigned old = xb_add(&bar[XB_XSUB(b.x)], 1u);
        const unsigned gen = old / nloc;
        if (old + 1u == (gen + 1u) * nloc) {
            __builtin_amdgcn_fence(__ATOMIC_RELEASE, "agent");
            asm volatile("s_waitcnt vmcnt(0)" ::: "memory");
            const unsigned og = xb_add(&bar[XB_TOP], 1u);
            const unsigned tg = og / nx;
            if (og + 1u == (tg + 1u) * nx) xb_add(&bar[XB_TOPGEN], 1u);
            else XB_SPIN(xb_ld(&bar[XB_TOPGEN]) == tg, bar);
            __builtin_amdgcn_fence(__ATOMIC_ACQUIRE, "agent");
            xb_add(&bar[XB_XGEN(b.x)], 1u);
            asm volatile("s_waitcnt vmcnt(0)" ::: "memory");
        } else {
            XB_SPIN(xb_ld(&bar[XB_XGEN(b.x)]) == gen, bar);
            __builtin_amdgcn_fence(__ATOMIC_ACQUIRE, "agent");
            asm volatile("s_waitcnt vmcnt(0)" ::: "memory");
        }
    }
    __syncthreads();
}

#ifndef REPF
#define REPF 1
#endif
struct Args { const float* in[21]; float* out; unsigned char* ws; int ph_lo, ph_hi; };
#ifndef MK_PER_PHASE
#define MK_PER_PHASE 0
#endif
__global__ void __launch_bounds__(NTHREADS, 2) hymba_fwd(Args a) {
    extern __shared__ __attribute__((aligned(16))) unsigned char lds_raw[];
    LAS unsigned char* lds = (LAS unsigned char*)lds_raw;
    unsigned* xbar_words = (unsigned*)(a.ws + 262144);
    volatile LAS unsigned* xb_st = (volatile LAS unsigned*)(lds + 131072 + 64);
    if (threadIdx.x < 2) xb_st[threadIdx.x] = 0u;
    __syncthreads();
    XcdBarrier xb = xcd_barrier_post(xbar_words, xb_st);
    unsigned* ctl = (unsigned*)(a.ws + 262144 + 16384);
#define PHASE_IDS() int tid_ = threadIdx.x; asm volatile("" : "+v"(tid_)); const int tid = tid_, lane = tid & 63, wave = __builtin_amdgcn_readfirstlane(tid >> 6); \
    const int gw = bid * 8 + wave, NGW = G * 8, gtid = bid * NTHREADS + tid, GT = G * NTHREADS; (void)lane; (void)gw; (void)NGW; (void)gtid; (void)GT;
    const int G = gridDim.x, bid = blockIdx.x;
    unsigned char* ws = a.ws;
    const float* x = a.in[0]; float* hbuf = a.out;
    bf16_t* Win_t = (bf16_t*)(ws + WS_WIN); bf16_t* Wout_t = (bf16_t*)(ws + WS_WOUT); bf16_t* Wpg_t = (bf16_t*)(ws + WS_WPG); bf16_t* Wd_t = (bf16_t*)(ws + WS_WD);
    bf16_t* Wgu_t = (bf16_t*)(ws + WS_WGU); bf16_t* Wpp_t = (bf16_t*)(ws + WS_WPP); bf16_t* poolw_t = (bf16_t*)(ws + WS_POOLW);
    bf16_t* W1k = (bf16_t*)(ws + WS_W1K); bf16_t* W1v = (bf16_t*)(ws + WS_W1V); bf16_t* W2k = (bf16_t*)(ws + WS_W2K); bf16_t* W2v = (bf16_t*)(ws + WS_W2V);
    bf16_t* PBF = (bf16_t*)(ws + WS_PBF); bf16_t* XN = (bf16_t*)(ws + WS_XN); bf16_t* T = (bf16_t*)(ws + WS_T); float* Z = (float*)(ws + WS_Z);
    float* SCR = (float*)(ws + WS_SCR); bf16_t* ACT = (bf16_t*)(ws + WS_ACT); bf16_t* PP = (bf16_t*)a.out;
    float* rowss1 = (float*)(ws + 65536); float* rowss2 = (float*)(ws + 131072); float* rowss3 = (float*)(ws + 196608); bf16_t* HB1 = (bf16_t*)(ws + WS_SCR);
    float* cosT = (float*)(ws + WS_COS); float* sinT = (float*)(ws + WS_SIN); float* gatesb = (float*)(ws + WS_GATES);
    bf16_t* kcmp = (bf16_t*)(ws + WS_KCMP); bf16_t* vcmp = (bf16_t*)(ws + WS_VCMP); float* biasp = (float*)(ws + WS_BIASK);

#ifndef SKIP_P0
#ifndef REP0
#define REP0 1
#endif
    if (a.ph_lo <= 0 && 0 < a.ph_hi) for (int rep0 = 0; rep0 < REP0; ++rep0) {
        if (rep0) xcd_barrier(xb);
    {
        PHASE_IDS();
        LAS float* scr = (LAS float*)(lds + wave * 16384);
        constexpr int I_IN = 32 * 120, I_SQ = 32 * 64, I_GU = 32 * 176, I_DN = 88 * 64, I_PP = 4 * 64, I_PW = 4 * 8, I_W1 = 64 * 4, I_W2 = 2 * 4;
        constexpr int NITEMS = I_IN + 2 * I_SQ + 2 * I_GU + I_DN + I_PP + 4 * I_PW + 2 * I_W1 + 2 * I_W2;
        for (int it = gw; it < NITEMS; it += NGW) {
            int r = it; const float* Wsrc; const float* gain = nullptr; bf16_t* dst; int Kk, Nn, nv, nblk, mode = 0;
            if (r < I_GU) { Wsrc = a.in[14]; Kk = DM; Nn = DFF; nv = DFF; nblk = 176; dst = Wgu_t; mode = 1; gain = a.in[13]; }
            else if ((r -= I_GU) < I_GU) { Wsrc = a.in[15]; Kk = DM; Nn = DFF; nv = DFF; nblk = 176; dst = Wgu_t; mode = 2; gain = a.in[13]; }
            else if ((r -= I_GU) < I_DN) { Wsrc = a.in[16]; Kk = DFF; Nn = DM; nv = DM; nblk = 64; dst = Wd_t; }
            else if ((r -= I_DN) < I_IN) { Wsrc = a.in[3]; Kk = DM; Nn = INW; nv = INW; nblk = 120; dst = Win_t; }
            else if ((r -= I_IN) < I_SQ) { Wsrc = a.in[12]; Kk = DM; Nn = DM; nv = DM; nblk = 64; dst = Wout_t; }
            else if ((r -= I_SQ) < I_SQ) { Wsrc = a.in[18]; Kk = DM; Nn = DM; nv = DM; nblk = 64; dst = Wpg_t; gain = a.in[17]; }
            else if ((r -= I_SQ) < I_PP) { Wsrc = a.in[19]; Kk = PLE; Nn = DM; nv = DM; nblk = 64; dst = Wpp_t; }
            else if ((r -= I_PP) < 4 * I_PW) { const int gq = r / I_PW; r -= gq * I_PW; Wsrc = a.in[4] + gq * 65536; Kk = 256; Nn = 256; nv = 256; nblk = 8; dst = poolw_t + gq * 65536; }
            else if ((r -= 4 * I_PW) < I_W1) { Wsrc = a.in[7]; Kk = 4096; Nn = 128; nv = 128; nblk = 4; dst = W1k; }
            else if ((r -= I_W1) < I_W1) { Wsrc = a.in[10]; Kk = 4096; Nn = 128; nv = 128; nblk = 4; dst = W1v; }
            else if ((r -= I_W1) < I_W2) { Wsrc = a.in[8]; Kk = 128; Nn = 128; nv = 128; nblk = 4; dst = W2k; }
            else { r -= I_W2; Wsrc = a.in[11]; Kk = 128; Nn = 128; nv = 128; nblk = 4; dst = W2v; }
            const int grp = r >> 3, wq = r & 7, gpr = nblk >> 2, gkb = grp / gpr, gnb = grp - gkb * gpr; const int kb = gkb * 2 + (wq >> 2), nb = gnb * 4 + (wq & 3), n0 = nb * 32;
            const int drow = mode == 0 ? n0 : ((n0 >> 7) * 256 + (n0 & 127) + (mode == 2 ? 128 : 0));
            tr_item(Wsrc, Kk, Nn, nv, dst, drow, scr, kb * 64, n0, lane, gain);
        }
        for (int m = gw; m < MROWS; m += NGW) rms_row<true>(x + (size_t)m * DM, a.in[2], XN + (size_t)m * DM, lane);
        for (int i = gtid; i < MROWS * PLE / 8; i += GT) { const f32x4 v0 = ((const f32x4*)a.in[1])[2 * i], v1 = ((const f32x4*)a.in[1])[2 * i + 1]; u32x4 w; w.x = cvt_pk_bf16(v0[0], v0[1]); w.y = cvt_pk_bf16(v0[2], v0[3]); w.z = cvt_pk_bf16(v1[0], v1[1]); w.w = cvt_pk_bf16(v1[2], v1[3]); ((u32x4*)PBF)[i] = w; }
        for (int i = gtid; i < 3 * MROWS; i += GT) { if (i < MROWS) rowss1[i] = 0.f; else if (i < 2 * MROWS) rowss2[i - MROWS] = 0.f; else rowss3[i - 2 * MROWS] = 0.f; }
        for (int i = (G == 256 ? (tid < 128 ? bid * 128 + tid : SEQ * 16) : gtid); i < SEQ * 16; i += GT) { const int pos = i >> 4, fi = i & 15; const float inv = exp2f(-(float)fi * (18.931568569324174f / 16.f)); const float ang = (float)pos * inv;
            cosT[i] = cosf(ang); sinT[i] = sinf(ang); }
        __syncthreads();
        for (int tsk = (G == 256 ? bid - 192 : bid); tsk < 64; tsk += G) { if (tsk < 0) break;
            const int kv = tsk >> 5, l = tsk & 31; const float* pe = a.in[kv == 0 ? 6 : 9] + l * 128; const float* w1 = a.in[kv == 0 ? 7 : 10] + (size_t)l * 128 * 128;
            const int cc = tid & 127, part = tid >> 7; float s = 0.f;
#pragma unroll 8
            for (int k = part * 32; k < part * 32 + 32; ++k) s += pe[k] * w1[(size_t)k * 128 + cc];
            LAS float* red = (LAS float*)lds; red[part * 128 + cc] = s; __syncthreads();
            if (tid < 128) biasp[(size_t)tsk * 128 + tid] = (red[tid] + red[128 + tid]) + (red[256 + tid] + red[384 + tid]);
            __syncthreads();
        }
    }
    }
#endif
    if (a.ph_lo <= 0 && 1 < a.ph_hi) xcd_barrier(xb);
#ifndef SKIP_P1
#ifndef REP1
#define REP1 1
#endif
    if (a.ph_lo <= 1 && 1 < a.ph_hi) for (int rep1 = 0; rep1 < REP1; ++rep1) {
        if (rep1) xcd_barrier(xb);
    {
        pg8::Gemm g{XN, Win_t, MROWS, INWP, DM}; pg8::StaticOrder S; S.init(MROWS, INWP, G, bid);
        EpiInProj E{T, gatesb, cosT, sinT};
        pg8::gemm_phase<EpiInProj, pg8::StaticOrder, true, true>(lds, g, S, E);
    }
    }
#endif
    if (a.ph_lo <= 1 && 2 < a.ph_hi) xcd_barrier(xb);
#ifndef SKIP_P2
#ifndef REP2
#define REP2 1
#endif
    if (a.ph_lo <= 2 && 2 < a.ph_hi) for (int rep2 = 0; rep2 < REP2; ++rep2) {
        if (rep2) xcd_barrier(xb);
    {
        pg8::Gemm g{T, poolw_t, 4 * MROWS, 1024, 256}; PoolOrder S{G, bid}; EpiPoolZ E{Z};
        pg8::gemm_phase<EpiPoolZ, PoolOrder, true, true>(lds, g, S, E);
        signal_done<false>(ctl + 64, bid < 128 ? (unsigned)((127 - bid) / G + 1) : 0u);
        unsigned njobs = 0;
        for (int job = G - 1 - bid; job < 128; job += G) {
            const int kv = job >> 6, b = (job >> 4) & 3, gg = (job >> 3) & 1, n0 = (job & 7) * 16;
            compress_job(lds, T + (size_t)(8 + kv) * TS, kv ? W1v : W1k, kv ? W2v : W2k, biasp + (size_t)kv * 32 * 128, kv ? vcmp : kcmp, b, gg, n0);
            ++njobs;
        }
        signal_done<false>(ctl, njobs);
    }
    }
#endif
#ifndef SKIP_P3
#ifndef REP3
#define REP3 1
#endif
    if (a.ph_lo <= 3 && 3 < a.ph_hi) for (int rep3 = 0; rep3 < REP3; ++rep3) {
        if (rep3) xcd_barrier(xb);
    {
        bf16_t* CAT = XN;
        for (int u = bid; u < 256; u += G) { const int bg = u & 7, c = (u < 128) ? 16 + (u >> 3) : 15 - ((u - 128) >> 3); att::attn_unit(lds, T, kcmp, vcmp, gatesb, SCR, hbuf, CAT, bg >> 1, bg & 1, c, ctl); }
        wait_count(ctl + 64, 128u);
        { const int per = (MROWS + G - 1) / G; const int r0 = bid * per; const int nr = min(per, MROWS - r0); if (nr > 0) for (int repf = 0; repf < REPF; ++repf) pool_finalize(Z, a.in[5], CAT, r0, nr); }
    }
    }
#endif
    if (a.ph_lo <= 3 && 4 < a.ph_hi) xcd_barrier(xb);
#ifndef SKIP_P4
    if (a.ph_lo <= 4 && 4 < a.ph_hi) {
    {
        pg8::Gemm g{XN, Wout_t, MROWS, DM, DM}; pg8::StaticOrder S; S.init(MROWS, DM, G, bid); EpiResidNorm E{x, nullptr, HB1, rowss1};
        pg8::gemm_phase<EpiResidNorm, pg8::StaticOrder, true, true>(lds, g, S, E);
    }
    }
#endif
    if (a.ph_lo <= 4 && 5 < a.ph_hi) xcd_barrier(xb);
#ifndef SKIP_P5
    if (a.ph_lo <= 5 && 5 < a.ph_hi) {
    { }
    }
#endif
#ifndef SKIP_P6
#ifndef REP6
#define REP6 1
#endif
    if (a.ph_lo <= 6 && 6 < a.ph_hi) for (int rep6 = 0; rep6 < REP6; ++rep6) {
        if (rep6) xcd_barrier(xb);
    {
        pg8::Gemm g{HB1, Wgu_t, MROWS, 2 * DFF, DM}; pg8::StaticOrder S; S.init(MROWS, 2 * DFF, G, bid); EpiSwiglu E{ACT, rowss1};
        pg8::gemm_phase<EpiSwiglu, pg8::StaticOrder, true, true>(lds, g, S, E);
        if (G == 256) {
            pg8::Gemm g2{PBF, Wpp_t, MROWS, DM, PLE}; UpperOrder S2; S2.S.init(MROWS, DM, 1, 0); S2.lo = 128; S2.nup = 128; S2.c = bid; EpiStoreBf16 E2{PP, DM};
            pg8::gemm_phase<EpiStoreBf16, UpperOrder, true, true>(lds, g2, S2, E2);
        } else { pg8::Gemm g2{PBF, Wpp_t, MROWS, DM, PLE}; pg8::StaticOrder S2; S2.init(MROWS, DM, G, bid); EpiStoreBf16 E2{PP, DM}; pg8::gemm_phase<EpiStoreBf16, pg8::StaticOrder, true, true>(lds, g2, S2, E2); }
    }
    }
#endif
    if (a.ph_lo <= 6 && 7 < a.ph_hi) xcd_barrier(xb);
#ifndef SKIP_P7
    if (a.ph_lo <= 7 && 7 < a.ph_hi) {
    {
        pg8::Gemm g{ACT, Wd_t, MROWS, DM, DFF}; pg8::StaticOrder S; S.init(MROWS, DM, G, bid); EpiResidNorm E{nullptr, HB1, XN, rowss2};
        pg8::gemm_phase<EpiResidNorm, pg8::StaticOrder, true, true>(lds, g, S, E);
    }
    }
#endif
    if (a.ph_lo <= 7 && 8 < a.ph_hi) xcd_barrier(xb);
#ifndef SKIP_P8
    if (a.ph_lo <= 8 && 8 < a.ph_hi) {
    {
    }
    }
#endif
    __syncthreads();
#ifndef SKIP_P9
    if (a.ph_lo <= 9 && 9 < a.ph_hi) {
    {
        pg8::Gemm g{XN, Wpg_t, MROWS, DM, DM}; pg8::StaticOrder S; S.init(MROWS, DM, G, bid); EpiPle E{XN, PP, rowss2, HB1, rowss3};
        pg8::gemm_phase<EpiPle, pg8::StaticOrder, true, true>(lds, g, S, E);
    }
    }
#endif
    if (a.ph_lo <= 9 && 10 < a.ph_hi) xcd_barrier(xb);
#ifdef EXTRA_SYNCS
    for (int es = 0; es < EXTRA_SYNCS; ++es) xcd_barrier(xb);
#endif
#ifndef SKIP_P10
    if (a.ph_lo <= 10 && 10 < a.ph_hi) {
#ifdef DBG_STOP
        { PHASE_IDS(); const bf16_t* dbg = (const bf16_t*)(ws + (size_t)DBG_OFF * MiB);
          for (size_t i = gtid; i < (size_t)MROWS * DM; i += GT) {
#ifdef DBG_NANDET
              const float bv = __uint_as_float((unsigned)((const bf16_t*)(ws + WS_KCMP))[i % 131072] << 16); const float wv = __uint_as_float((unsigned)((const bf16_t*)(ws + WS_VCMP))[i % 131072] << 16);
              const bool bad1 = !(fabsf(bv) < 1e30f), bad2 = !(fabsf(wv) < 1e30f);
              hbuf[i] = x[i] + (bad1 ? 1000.f : 0.f) + (bad2 ? 3000.f : 0.f);
#else
              float dv = __uint_as_float((unsigned)dbg[i % ((size_t)DBG_ELEMS)] << 16); if (!(fabsf(dv) < 1e30f)) dv = 1000.f; hbuf[i] = x[i] + DBG_SCALE * dv;
#endif
          } }
        xcd_barrier(xb);
#endif
    { PHASE_IDS();
      for (int m = gw; m < MROWS; m += NGW) { const float rstd = 1.0f / sqrtf(rowss3[m] * (1.f / DM) + 1e-6f); const u32x4* hr = (const u32x4*)(HB1 + (size_t)m * DM); f32x4* orow = (f32x4*)(hbuf + (size_t)m * DM);
#pragma unroll
          for (int j = 0; j < 4; ++j) { const u32x4 w = hr[lane + 64 * j]; const f32x4 g0 = ((const f32x4*)a.in[20])[2 * lane + 128 * j], g1 = ((const f32x4*)a.in[20])[2 * lane + 128 * j + 1];
              const f32x4 v0 = {__uint_as_float(w.x << 16), __uint_as_float(w.x & 0xffff0000u), __uint_as_float(w.y << 16), __uint_as_float(w.y & 0xffff0000u)};
              const f32x4 v1 = {__uint_as_float(w.z << 16), __uint_as_float(w.z & 0xffff0000u), __uint_as_float(w.w << 16), __uint_as_float(w.w & 0xffff0000u)};
              orow[2 * lane + 128 * j] = v0 * rstd * g0; orow[2 * lane + 128 * j + 1] = v1 * rstd * g1; } } }
    }
#endif
}

extern "C" void kernel_launch(void* const* d_in, const int* in_sizes, int n_in, void* d_out, int out_size, void* d_ws, size_t ws_size, hipStream_t stream) {
    static int grid = 0;
    if (grid == 0) {
        if (n_in != 21 || in_sizes[0] != MROWS * DM || out_size != MROWS * DM || ws_size < WS_END) {
            fprintf(stderr, "kernel_launch: unexpected shapes (n_in %d, in0 %d, out %d, ws %zu < %zu)\n", n_in, n_in > 0 ? in_sizes[0] : -1, out_size, ws_size, (size_t)WS_END); grid = -1; return; }
        int dev = 0, cus = 0, per_cu = 0;
        hipGetDevice(&dev); hipDeviceGetAttribute(&cus, hipDeviceAttributeMultiprocessorCount, dev);
        if (hipFuncSetAttribute((const void*)hymba_fwd, hipFuncAttributeMaxDynamicSharedMemorySize, LDS_BYTES) != hipSuccess) { fprintf(stderr, "kernel_launch: hipFuncSetAttribute failed\n"); grid = -1; return; }
        if (hipOccupancyMaxActiveBlocksPerMultiprocessor(&per_cu, (const void*)hymba_fwd, NTHREADS, LDS_BYTES) != hipSuccess || per_cu < 1) { fprintf(stderr, "kernel_launch: occupancy query failed (%d)\n", per_cu); grid = -1; return; }
        grid = cus * per_cu;
        fprintf(stderr, "kernel_launch: %d CUs x %d blocks/CU -> grid %d\n", cus, per_cu, grid);
    }
    if (grid < 0) return;
    Args a{};
    for (int i = 0; i < 21; ++i) a.in[i] = (const float*)d_in[i];
    a.out = (float*)d_out; a.ws = (unsigned char*)d_ws;
#if MK_PER_PHASE
    hipError_t e = hipSuccess;
#ifdef DBG_STOP
    for (int k = 0; k <= DBG_STOP; ++k) { a.ph_lo = k; a.ph_hi = k + 1; hipLaunchKernelGGL(hymba_fwd, dim3(grid), dim3(NTHREADS), LDS_BYTES, stream, a); }
    { a.ph_lo = 10; a.ph_hi = 11; void* args[] = {&a}; (void)hipLaunchCooperativeKernel((const void*)hymba_fwd, dim3(grid), dim3(NTHREADS), args, LDS_BYTES, stream); }
#else
    for (int k = 0; k < 11; ++k) { a.ph_lo = k; a.ph_hi = k + 1; hipLaunchKernelGGL(hymba_fwd, dim3(grid), dim3(NTHREADS), LDS_BYTES, stream, a); }
#endif
    e = hipPeekAtLastError();
#else
    a.ph_lo = 0; a.ph_hi = 11;
    if (hipMemsetAsync((char*)d_ws + 262144, 0, 32768, stream) != hipSuccess) { fprintf(stderr, "kernel_launch: hipMemsetAsync failed\n"); return; }
    void* args[] = {&a};
    hipError_t e = hipLaunchCooperativeKernel((const void*)hymba_fwd, dim3(grid), dim3(NTHREADS), args, LDS_BYTES, stream);
#endif
    if (e != hipSuccess) fprintf(stderr, "kernel_launch: cooperative launch failed: %s (grid %d)\n", hipGetErrorString(e), grid);
}
```

```cpp
#include <hip/hip_runtime.h>
#include <cstdio>
#include <cstdint>
#include <cmath>
#define ATT_NOANY 1
namespace pg8 {
#define PG8_LAS __attribute__((address_space(3)))
typedef unsigned short bf16_t;
typedef short bf16x8 __attribute__((ext_vector_type(8)));
typedef float f32x4 __attribute__((ext_vector_type(4)));
typedef unsigned u32x4 __attribute__((ext_vector_type(4)));
constexpr int BM = 256, BK = 64, HALF = 128, HTB = HALF * BK * 2  , STAGE_BYTES = 8 * HTB, NXCD = 8, WGM = 8;

__host__ __device__ __forceinline__ int lds_byte(int r, int c) { const int st = (r >> 4) * 2 + (c >> 5), rr = r & 15, cc = c & 31, ob = rr * 64 + cc * 2; return st * 1024 + (ob ^ (((ob >> 9) & 1) << 5)); }
__host__ __device__ __forceinline__ void stage_rc(int b, int& R, int& C) { const int st = b / 1024, sb = b % 1024, swz = sb ^ (((sb >> 9) & 1) << 5); R = (st >> 1) * 16 + swz / 64; C = (st & 1) * 32 + (swz % 64) / 2; }
__host__ __device__ __forceinline__ int perm32(int rho) { const int n = rho >> 4, i = rho & 15; return 8 * (i >> 2) + 4 * n + (i & 3); }

struct Unit { int pm, pn; };
struct Gemm { const bf16_t* A; const bf16_t* Bt; int M, N, K; };

struct StaticOrder {
    int nM, nN, nwg, G, c;
    __host__ __device__ void init(int M, int N, int G_, int c_) { nM = M / BM; nN = N / BM; nwg = nM * nN; G = G_; c = c_; }
    __host__ __device__ bool next(int i, Unit& u) const {
        const long L = (long)i * G + c; if (L >= nwg) return false;
        int wgid = (int)L; { const int q = nwg / NXCD, r = nwg % NXCD, xcd = wgid % NXCD, off = wgid / NXCD; wgid = (xcd < r ? xcd * (q + 1) : r * (q + 1) + (xcd - r) * q) + off; }
        const int nig = WGM * nN, gid = wgid / nig, fm = gid * WGM, gsz = (nM - fm) < WGM ? (nM - fm) : WGM;
        u.pm = fm + ((wgid % nig) % gsz); u.pn = (wgid % nig) / gsz; return true;
    }
    __host__ __device__ bool next_linear(long L, Unit& u) const {
        if (L >= nwg) return false;
        int wgid = (int)L; { const int q = nwg / NXCD, r = nwg % NXCD, xcd = wgid % NXCD, off = wgid / NXCD; wgid = (xcd < r ? xcd * (q + 1) : r * (q + 1) + (xcd - r) * q) + off; }
        const int nig = WGM * nN, gid = wgid / nig, fm = gid * WGM, gsz = (nM - fm) < WGM ? (nM - fm) : WGM;
        u.pm = fm + ((wgid % nig) % gsz); u.pn = (wgid % nig) / gsz; return true;
    }
    __device__ __forceinline__ void a_ready(const Unit&) const {}
    __device__ __forceinline__ void done(const Unit&) const {}
};

typedef float f32x2_cv __attribute__((ext_vector_type(2))); typedef __bf16 bf16x2_cv __attribute__((ext_vector_type(2)));
__device__ __forceinline__ unsigned cvt_pk_bf16(float lo, float hi) { f32x2_cv v = {lo, hi}; bf16x2_cv b = __builtin_convertvector(v, bf16x2_cv); return __builtin_bit_cast(unsigned, b); }
template <class Epi, class Sched, bool ALIGN_EPI = false, bool SP2 = false>
__device__ __forceinline__ void gemm_phase(PG8_LAS unsigned char* lds, const Gemm g, const Sched& S, const Epi& E) {
    int tid_ = threadIdx.x; asm volatile("" : "+v"(tid_));
    const int tid = tid_, wid = __builtin_amdgcn_readfirstlane(tid >> 6), lane = tid & 63, wr = wid >> 2, wc = wid & 3, fr = lane & 15, fq = lane >> 4;
    const int K = g.K, nt = K / BK;
    unsigned voffA[2], voffB[2];
#pragma unroll
    for (int i = 0; i < 2; ++i) { int R, C; stage_rc(tid * 16 + i * 8192, R, C); const int Rb = Epi::PERM ? ((R & ~31) + perm32(R & 31)) : R;
        voffA[i] = (unsigned)(R * K + C) * 2u; voffB[i] = (unsigned)(Rb * K + C) * 2u; }
    const size_t kstep = (size_t)(BK * 2);
    const size_t hstep = (size_t)HALF * K * 2;
    const size_t tstep = 2 * hstep;
    const unsigned ldsw = (unsigned)wid * 1024u;
    const int aoff = lds_byte(wr * 64 + fr, fq * 8), boff = lds_byte(wc * 32 + fr, fq * 8);
#define PG8_SA(b, h) (((b) * 2 + (h)) * HTB)
#define PG8_SB(b, h) ((4 + (b) * 2 + (h)) * HTB)
#define PG8_STAGE(bufoff, gbase, voff) do { _Pragma("unroll") for (int _i = 0; _i < 2; ++_i) \
        __builtin_amdgcn_global_load_lds((const unsigned*)((const char*)(gbase) + (voff)[_i]), (PG8_LAS unsigned*)(lds + (bufoff) + ldsw + _i * 8192), 16, 0, 0); } while (0)
#define PG8_LDA(dst, b, h) do { _Pragma("unroll") for (int m = 0; m < 4; ++m) _Pragma("unroll") for (int k = 0; k < 2; ++k) dst[m][k] = *(const PG8_LAS bf16x8*)(lds + PG8_SA(b, h) + aoff + m * 2048 + k * 1024); } while (0)
#define PG8_LDB(dst, b, h) do { _Pragma("unroll") for (int n = 0; n < 2; ++n) _Pragma("unroll") for (int k = 0; k < 2; ++k) dst[n][k] = *(const PG8_LAS bf16x8*)(lds + PG8_SB(b, h) + boff + n * 2048 + k * 1024); } while (0)
#define PG8_MMA(ai, bj, At, Bt) do { __builtin_amdgcn_s_setprio(1); _Pragma("unroll") for (int m = 0; m < 4; ++m) _Pragma("unroll") for (int n = 0; n < 2; ++n) _Pragma("unroll") for (int k = 0; k < 2; ++k) \
        acc[ai][bj][m][n] = __builtin_amdgcn_mfma_f32_16x16x32_bf16(Bt[n][k], At[m][k], acc[ai][bj][m][n], 0, 0, 0); __builtin_amdgcn_s_setprio(0); } while (0)
#define PG8_WAIT_V(n) asm volatile("s_waitcnt vmcnt(" #n ")" ::: "memory")
#define PG8_WAIT_L(n) asm volatile("s_waitcnt lgkmcnt(" #n ")" ::: "memory")
#define PG8_BAR __builtin_amdgcn_s_barrier()
#define PG8_SCHED __builtin_amdgcn_sched_barrier(0)
    Unit cur, nxt; int ui = 0;
    if (!S.next(0, cur)) return;
    f32x4 acc[2][2][4][2];
#pragma unroll
    for (int a = 0; a < 2; ++a)
#pragma unroll
        for (int b = 0; b < 2; ++b)
#pragma unroll
            for (int m = 0; m < 4; ++m)
#pragma unroll
                for (int n = 0; n < 2; ++n) acc[a][b][m][n] = (f32x4){0.f, 0.f, 0.f, 0.f};
    bf16x8 At[4][2], B0[2][2], B1[2][2];
    const char* cA = (const char*)g.A + (size_t)cur.pm * tstep; const char* cB = (const char*)g.Bt + (size_t)cur.pn * tstep;
    S.a_ready(cur);
    if constexpr (SP2) {
        PG8_STAGE(PG8_SB(0, 0), cB, voffB); PG8_STAGE(PG8_SB(0, 1), cB + hstep, voffB); PG8_STAGE(PG8_SA(0, 0), cA, voffA); PG8_STAGE(PG8_SA(0, 1), cA + hstep, voffA);
        if (wr == 1) PG8_BAR;
        PG8_WAIT_V(2); PG8_BAR;
        PG8_STAGE(PG8_SB(1, 0), cB + kstep, voffB); PG8_STAGE(PG8_SA(1, 0), cA + kstep, voffA); PG8_STAGE(PG8_SB(1, 1), cB + hstep + kstep, voffB);
        PG8_WAIT_V(6); PG8_BAR;
    } else {
        PG8_STAGE(PG8_SB(0, 0), cB, voffB); PG8_STAGE(PG8_SA(0, 0), cA, voffA); PG8_STAGE(PG8_SB(0, 1), cB + hstep, voffB); PG8_STAGE(PG8_SA(0, 1), cA + hstep, voffA);
        if (wr == 1) PG8_BAR;
        PG8_WAIT_V(4); PG8_BAR;
        PG8_STAGE(PG8_SB(1, 0), cB + kstep, voffB); PG8_STAGE(PG8_SA(1, 0), cA + kstep, voffA); PG8_STAGE(PG8_SB(1, 1), cB + hstep + kstep, voffB);
        PG8_WAIT_V(6); PG8_BAR;
    }
    for (;;) {
        const bool has_next = S.next(ui + 1, nxt);
        const char* nA = has_next ? (const char*)g.A + (size_t)nxt.pm * tstep : cA; const char* nB = has_next ? (const char*)g.Bt + (size_t)nxt.pn * tstep : cB;
        for (int t = 0; t < nt; t += 2) {
            const bool last = (t == nt - 2);
            const char* a1 = cA + (size_t)(t + 1) * kstep;
            const char* a2 = last ? nA : cA + (size_t)(t + 2) * kstep; const char* b2 = last ? nB : cB + (size_t)(t + 2) * kstep;
            const char* a3 = a2 + kstep; const char* b3 = b2 + kstep;
            if (last && has_next) S.a_ready(nxt);
            if constexpr (SP2) {
            PG8_LDB(B0, 0, 0); PG8_LDB(B1, 0, 1); PG8_SCHED; PG8_LDA(At, 0, 0); PG8_STAGE(PG8_SA(1, 1), a1 + hstep, voffA);
            PG8_WAIT_V(8); PG8_WAIT_L(0); PG8_BAR; PG8_MMA(0, 0, At, B0); PG8_MMA(0, 1, At, B1); PG8_BAR; PG8_SCHED;
            PG8_LDA(At, 0, 1); PG8_STAGE(PG8_SB(0, 0), b2, voffB); PG8_STAGE(PG8_SB(0, 1), b2 + hstep, voffB); PG8_STAGE(PG8_SA(0, 0), a2, voffA);
            PG8_WAIT_V(8); PG8_WAIT_L(0); PG8_BAR; PG8_MMA(1, 0, At, B0); PG8_MMA(1, 1, At, B1); PG8_BAR; PG8_SCHED;
            PG8_LDB(B0, 1, 0); PG8_LDB(B1, 1, 1); PG8_SCHED; PG8_LDA(At, 1, 0); PG8_STAGE(PG8_SA(0, 1), a2 + hstep, voffA);
            PG8_WAIT_V(8); PG8_WAIT_L(0); PG8_BAR; PG8_MMA(0, 0, At, B0); PG8_MMA(0, 1, At, B1); PG8_BAR; PG8_SCHED;
            PG8_LDA(At, 1, 1); PG8_STAGE(PG8_SB(1, 0), b3, voffB); PG8_STAGE(PG8_SB(1, 1), b3 + hstep, voffB); PG8_STAGE(PG8_SA(1, 0), a3, voffA);
            PG8_WAIT_V(8); PG8_WAIT_L(0); PG8_BAR; PG8_MMA(1, 0, At, B0); PG8_MMA(1, 1, At, B1); PG8_BAR; PG8_SCHED;
            } else {
            PG8_LDB(B0, 0, 0); PG8_SCHED; PG8_LDA(At, 0, 0); PG8_STAGE(PG8_SA(1, 1), a1 + hstep, voffA);
            PG8_WAIT_L(8); PG8_BAR; PG8_WAIT_L(0); PG8_MMA(0, 0, At, B0); PG8_BAR; PG8_SCHED;
            PG8_LDB(B1, 0, 1); PG8_STAGE(PG8_SB(0, 0), b2, voffB);
            PG8_BAR; PG8_WAIT_L(0); PG8_MMA(0, 1, At, B1); PG8_BAR;
            PG8_LDA(At, 0, 1); PG8_STAGE(PG8_SA(0, 0), a2, voffA);
            PG8_BAR; PG8_WAIT_L(0); PG8_MMA(1, 0, At, B0); PG8_BAR; PG8_SCHED;
            PG8_STAGE(PG8_SB(0, 1), b2 + hstep, voffB);
            PG8_WAIT_V(6); PG8_BAR; PG8_MMA(1, 1, At, B1); PG8_BAR;
            PG8_LDB(B0, 1, 0); PG8_SCHED; PG8_LDA(At, 1, 0); PG8_STAGE(PG8_SA(0, 1), a2 + hstep, voffA);
            PG8_WAIT_L(8); PG8_BAR; PG8_WAIT_L(0); PG8_MMA(0, 0, At, B0); PG8_BAR; PG8_SCHED;
            PG8_LDB(B1, 1, 1); PG8_STAGE(PG8_SB(1, 0), b3, voffB);
            PG8_BAR; PG8_WAIT_L(0); PG8_MMA(0, 1, At, B1); PG8_BAR;
            PG8_LDA(At, 1, 1); PG8_STAGE(PG8_SA(1, 0), a3, voffA);
            PG8_BAR; PG8_WAIT_L(0); PG8_MMA(1, 0, At, B0); PG8_BAR; PG8_SCHED;
            PG8_STAGE(PG8_SB(1, 1), b3 + hstep, voffB);
            PG8_WAIT_V(6); PG8_BAR; PG8_MMA(1, 1, At, B1); PG8_BAR;
            }
        }
        if constexpr (ALIGN_EPI) { if (wr == 0) PG8_BAR; }
        if constexpr (!Epi::AFTER_DRAIN) { E(acc, cur, wr, wc, fr, fq); S.done(cur); }
        if (!has_next) break;
#pragma unroll
        for (int a = 0; a < 2; ++a)
#pragma unroll
            for (int b = 0; b < 2; ++b)
#pragma unroll
                for (int m = 0; m < 4; ++m)
#pragma unroll
                    for (int n = 0; n < 2; ++n) acc[a][b][m][n] = (f32x4){0.f, 0.f, 0.f, 0.f};
        cur = nxt; cA = nA; cB = nB; ++ui;
        if constexpr (ALIGN_EPI) { if (wr == 1) PG8_BAR; }
    }
    PG8_WAIT_V(0);
    if constexpr (!ALIGN_EPI) { if (wr == 0) PG8_BAR; }
    PG8_BAR;
    if constexpr (Epi::AFTER_DRAIN) { E.fused(acc, cur, wr, wc, fr, fq, lds, wid, lane); S.done(cur); }
#undef PG8_SA
#undef PG8_SB
#undef PG8_STAGE
#undef PG8_LDA
#undef PG8_LDB
#undef PG8_MMA
#undef PG8_WAIT_V
#undef PG8_WAIT_L
#undef PG8_BAR
#undef PG8_SCHED
}
}

using pg8::bf16_t; using pg8::bf16x8; using pg8::f32x4; using pg8::u32x4; using pg8::Unit; using pg8::cvt_pk_bf16;
#define LAS __attribute__((address_space(3)))
typedef short s16x4 __attribute__((ext_vector_type(4)));
typedef float f32x16 __attribute__((ext_vector_type(16)));
typedef unsigned u32x2 __attribute__((ext_vector_type(2)));

constexpr int DM = 2048, SEQ = 2048, MROWS = 8192, PLE = 256, INW = 3608, INWP = 3840, DFF = 5632;
constexpr int NTHREADS = 512;
constexpr size_t MiB = (size_t)1 << 20;
constexpr size_t TS = (size_t)MROWS * 256;
constexpr size_t WS_BIASK = 0, WS_BIASV = 512;
constexpr size_t WS_COS = 1 * MiB, WS_SIN = 1 * MiB + 131072, WS_GATES = 1 * MiB + 262144;
constexpr size_t WS_KCMP = 2 * MiB, WS_VCMP = 2 * MiB + 262144, WS_W2K = 2 * MiB + 524288, WS_W2V = WS_W2K + 32768;
constexpr size_t WS_W1K = 3 * MiB, WS_W1V = 4 * MiB, WS_POOLW = 5 * MiB, WS_WPP = 6 * MiB, WS_WIN = 7 * MiB, WS_WOUT = 22 * MiB;
constexpr size_t WS_WPG = 30 * MiB, WS_WD = 38 * MiB, WS_WGU = 60 * MiB, WS_PBF = 104 * MiB, WS_XN = 108 * MiB;
constexpr size_t WS_T = 140 * MiB, WS_Z = 196 * MiB, WS_SCR = 228 * MiB, WS_ACT = 140 * MiB, WS_PP = 140 * MiB, WS_END = 260 * MiB;
constexpr int LDS_BYTES = 147456;

#define LDS_WAIT() asm volatile("s_waitcnt lgkmcnt(0)" ::: "memory")
__device__ __forceinline__ float wave_sum(float v) {
#pragma unroll
    for (int o = 1; o < 64; o <<= 1) v += __shfl_xor(v, o);
    return v;
}
__device__ __forceinline__ float sigmoidf_(float x) { return __builtin_amdgcn_rcpf(1.f + __expf(-x)); }

struct EpiInProj {
    static constexpr bool PERM = true, AFTER_DRAIN = false;
    bf16_t* T; float* gates; const float* cosT; const float* sinT;
    __device__ __forceinline__ void operator()(const f32x4 (&acc)[2][2][4][2], const Unit& u, int wr, int wc, int fr, int fq) const {
        const int pn = u.pn; const int row0 = u.pm * 256 + wr * 64 + fr;
        if (pn < 14) {
            const bool rope = (wc == 0) && (pn >= 4) && (pn < 8 || ((pn & 1) == 0));
            bf16_t* base = T + (size_t)pn * TS;
#pragma unroll
            for (int ai = 0; ai < 2; ++ai)
#pragma unroll
                for (int m = 0; m < 4; ++m) {
                    const int row = row0 + ai * 128 + m * 16; const int pos = row & (SEQ - 1);
                    f32x4 cs0 = {1.f, 1.f, 1.f, 1.f}, cs1 = cs0, sn0 = {0.f, 0.f, 0.f, 0.f}, sn1 = sn0;
                    if (rope) { const float* ct = cosT + pos * 16 + 8 * (fq & 1); const float* st = sinT + pos * 16 + 8 * (fq & 1);
                        cs0 = *(const f32x4*)ct; cs1 = *(const f32x4*)(ct + 4); sn0 = *(const f32x4*)st; sn1 = *(const f32x4*)(st + 4);
                        if (fq < 2) { sn0 = -sn0; sn1 = -sn1; } }
#pragma unroll
                    for (int bj = 0; bj < 2; ++bj) {
                        f32x4 v0 = acc[ai][bj][m][0], v1 = acc[ai][bj][m][1];
                        if (rope) { f32x4 o0, o1;
#pragma unroll
                            for (int j = 0; j < 4; ++j) { o0[j] = __shfl_xor(v0[j], 32); o1[j] = __shfl_xor(v1[j], 32); }
                            v0 = v0 * cs0 + o0 * sn0; v1 = v1 * cs1 + o1 * sn1; }
                        u32x4 w; w.x = cvt_pk_bf16(v0[0], v0[1]); w.y = cvt_pk_bf16(v0[2], v0[3]); w.z = cvt_pk_bf16(v1[0], v1[1]); w.w = cvt_pk_bf16(v1[2], v1[3]);
                        *(u32x4*)(base + (size_t)row * 256 + bj * 128 + wc * 32 + 8 * fq) = w;
                    }
                }
        } else if (wc == 0 && fq < 3) {
#pragma unroll
            for (int ai = 0; ai < 2; ++ai)
#pragma unroll
                for (int m = 0; m < 4; ++m) {
                    const int row = row0 + ai * 128 + m * 16;
                    const f32x4 v0 = acc[ai][0][m][0], v1 = acc[ai][0][m][1];
                    const f32x4 s0 = {sigmoidf_(v0[0]), sigmoidf_(v0[1]), sigmoidf_(v0[2]), sigmoidf_(v0[3])}, s1 = {sigmoidf_(v1[0]), sigmoidf_(v1[1]), sigmoidf_(v1[2]), sigmoidf_(v1[3])};
                    *(f32x4*)(gates + (size_t)row * 24 + 8 * fq) = s0; *(f32x4*)(gates + (size_t)row * 24 + 8 * fq + 4) = s1;
                }
        }
    }
};
struct PoolOrder {
    int G, c;
    __device__ bool next(int i, Unit& u) const { const int L = i * G + c; if (L >= 128) return false; u.pm = L; u.pn = L >> 5; return true; }
    __device__ __forceinline__ void a_ready(const Unit&) const {}
    __device__ __forceinline__ void done(const Unit&) const {}
};
struct EpiPoolZ {
    static constexpr bool PERM = false, AFTER_DRAIN = false;
    float* Z;
    __device__ __forceinline__ void operator()(const f32x4 (&acc)[2][2][4][2], const Unit& u, int wr, int wc, int fr, int fq) const {
        const int row0 = (u.pm & 31) * 256 + wr * 64 + fr; const int col0 = u.pn * 256 + wc * 32 + 4 * fq;
        const __amdgpu_buffer_rsrc_t zr = __builtin_amdgcn_make_buffer_rsrc(Z, 0, MROWS * 1024 * 4, 0x00020000);
#pragma unroll
        for (int ai = 0; ai < 2; ++ai)
#pragma unroll
            for (int m = 0; m < 4; ++m)
#pragma unroll
                for (int bj = 0; bj < 2; ++bj)
#pragma unroll
                    for (int n = 0; n < 2; ++n) __builtin_amdgcn_raw_buffer_store_b128(__builtin_bit_cast(u32x4, acc[ai][bj][m][n]), zr, (unsigned)(((row0 + ai * 128 + m * 16) * 1024 + col0 + bj * 128 + n * 16) * 4), 0, 16);
    }
};
struct EpiStoreBf16 {
    static constexpr bool PERM = false, AFTER_DRAIN = false;
    bf16_t* O; int ldc;
    __device__ __forceinline__ void operator()(const f32x4 (&acc)[2][2][4][2], const Unit& u, int wr, int wc, int fr, int fq) const {
        const int row0 = u.pm * 256 + wr * 64 + fr; const int col0 = u.pn * 256 + wc * 32 + 4 * fq;
#pragma unroll
        for (int ai = 0; ai < 2; ++ai)
#pragma unroll
            for (int m = 0; m < 4; ++m)
#pragma unroll
                for (int bj = 0; bj < 2; ++bj)
#pragma unroll
                    for (int n = 0; n < 2; ++n) { const f32x4 v = acc[ai][bj][m][n]; u32x2 w; w.x = cvt_pk_bf16(v[0], v[1]); w.y = cvt_pk_bf16(v[2], v[3]);
                        *(u32x2*)(O + (size_t)(row0 + ai * 128 + m * 16) * ldc + col0 + bj * 128 + n * 16) = w; }
    }
};
struct EpiResid {
    static constexpr bool PERM = false, AFTER_DRAIN = false;
    const float* base; float* out;
    __device__ __forceinline__ void operator()(const f32x4 (&acc)[2][2][4][2], const Unit& u, int wr, int wc, int fr, int fq) const {
        const int row0 = u.pm * 256 + wr * 64 + fr; const int col0 = u.pn * 256 + wc * 32 + 4 * fq;
#pragma unroll
        for (int ai = 0; ai < 2; ++ai)
#pragma unroll
            for (int m = 0; m < 4; ++m)
#pragma unroll
                for (int bj = 0; bj < 2; ++bj)
#pragma unroll
                    for (int n = 0; n < 2; ++n) { const size_t off = (size_t)(row0 + ai * 128 + m * 16) * DM + col0 + bj * 128 + n * 16;
                        const f32x4 b = *(const f32x4*)(base + off); *(f32x4*)(out + off) = b + acc[ai][bj][m][n]; }
    }
};
struct EpiResidNorm {
    static constexpr bool PERM = true, AFTER_DRAIN = false;
    const float* basef; const bf16_t* baseb; bf16_t* hb; float* rowss;
    __device__ __forceinline__ void operator()(const f32x4 (&acc)[2][2][4][2], const Unit& u, int wr, int wc, int fr, int fq) const {
        const int row0 = u.pm * 256 + wr * 64 + fr; const int col0 = u.pn * 256 + wc * 32 + 8 * fq;
#pragma unroll
        for (int ai = 0; ai < 2; ++ai)
#pragma unroll
            for (int m = 0; m < 4; ++m) { const int row = row0 + ai * 128 + m * 16; float ss = 0.f;
#pragma unroll
                for (int bj = 0; bj < 2; ++bj) { const size_t off = (size_t)row * DM + col0 + bj * 128;
                    f32x4 b0, b1;
                    if (basef) { b0 = *(const f32x4*)(basef + off); b1 = *(const f32x4*)(basef + off + 4); }
                    else { const u32x4 bw = *(const u32x4*)(baseb + off);
                        b0 = (f32x4){__uint_as_float(bw.x << 16), __uint_as_float(bw.x & 0xffff0000u), __uint_as_float(bw.y << 16), __uint_as_float(bw.y & 0xffff0000u)};
                        b1 = (f32x4){__uint_as_float(bw.z << 16), __uint_as_float(bw.z & 0xffff0000u), __uint_as_float(bw.w << 16), __uint_as_float(bw.w & 0xffff0000u)}; }
                    const f32x4 o0 = b0 + acc[ai][bj][m][0], o1 = b1 + acc[ai][bj][m][1];
                    u32x4 w; w.x = cvt_pk_bf16(o0[0], o0[1]); w.y = cvt_pk_bf16(o0[2], o0[3]); w.z = cvt_pk_bf16(o1[0], o1[1]); w.w = cvt_pk_bf16(o1[2], o1[3]);
                    *(u32x4*)(hb + off) = w;
                    ss += ((o0[0] * o0[0] + o0[1] * o0[1]) + (o0[2] * o0[2] + o0[3] * o0[3])) + ((o1[0] * o1[0] + o1[1] * o1[1]) + (o1[2] * o1[2] + o1[3] * o1[3])); }
                ss += __shfl_xor(ss, 16); ss += __shfl_xor(ss, 32);
                if (fq == 0) unsafeAtomicAdd(rowss + row, ss); }
    }
};
struct UpperOrder {
    pg8::StaticOrder S; int lo, nup, c;
    __device__ bool next(int i, Unit& u) const { if (c < lo) return false; return S.next_linear((long)i * nup + (c - lo), u); }
    __device__ __forceinline__ void a_ready(const Unit&) const {}
    __device__ __forceinline__ void done(const Unit&) const {}
};
struct EpiSwiglu {
    static constexpr bool PERM = true, AFTER_DRAIN = false;
    bf16_t* O; const float* rowss;
    __device__ __forceinline__ void operator()(const f32x4 (&acc)[2][2][4][2], const Unit& u, int wr, int wc, int fr, int fq) const {
        const int row0 = u.pm * 256 + wr * 64 + fr; const int col0 = u.pn * 128 + wc * 32 + 8 * fq;
#pragma unroll
        for (int ai = 0; ai < 2; ++ai)
#pragma unroll
            for (int m = 0; m < 4; ++m) {
                const float rs = 1.0f / sqrtf(rowss[row0 + ai * 128 + m * 16] * (1.f / DM) + 1e-6f);
                float r[8];
#pragma unroll
                for (int n = 0; n < 2; ++n)
#pragma unroll
                    for (int j = 0; j < 4; ++j) { const float g = acc[ai][0][m][n][j] * rs, up = acc[ai][1][m][n][j] * rs; r[n * 4 + j] = g * sigmoidf_(g) * up; }
                u32x4 w; w.x = cvt_pk_bf16(r[0], r[1]); w.y = cvt_pk_bf16(r[2], r[3]); w.z = cvt_pk_bf16(r[4], r[5]); w.w = cvt_pk_bf16(r[6], r[7]);
                *(u32x4*)(O + (size_t)(row0 + ai * 128 + m * 16) * DFF + col0) = w;
            }
    }
};
struct EpiPle {
    static constexpr bool PERM = true, AFTER_DRAIN = false;
    const bf16_t* h; const bf16_t* pp; const float* rowss; bf16_t* hb3; float* rowss_out;
    __device__ __forceinline__ void operator()(const f32x4 (&acc)[2][2][4][2], const Unit& u, int wr, int wc, int fr, int fq) const {
        const int row0 = u.pm * 256 + wr * 64 + fr; const int col0 = u.pn * 256 + wc * 32 + 8 * fq;
#pragma unroll
        for (int ai = 0; ai < 2; ++ai)
#pragma unroll
            for (int m = 0; m < 4; ++m) { const int row = row0 + ai * 128 + m * 16; const float rs = 1.0f / sqrtf(rowss[row] * (1.f / DM) + 1e-6f); float ss = 0.f;
#pragma unroll
                for (int bj = 0; bj < 2; ++bj) { const size_t off = (size_t)row * DM + col0 + bj * 128;
                    const u32x4 bw = *(const u32x4*)(h + off); const u32x4 pw = *(const u32x4*)(pp + off);
                    const unsigned bwa[4] = {bw.x, bw.y, bw.z, bw.w}, pwa[4] = {pw.x, pw.y, pw.z, pw.w};
                    float o[8];
#pragma unroll
                    for (int e = 0; e < 8; ++e) { const float a_ = acc[ai][bj][m][e >> 2][e & 3] * rs;
                        const float bv = (e & 1) ? __uint_as_float(bwa[e >> 1] & 0xffff0000u) : __uint_as_float(bwa[e >> 1] << 16);
                        const float pv = (e & 1) ? __uint_as_float(pwa[e >> 1] & 0xffff0000u) : __uint_as_float(pwa[e >> 1] << 16);
                        o[e] = bv + pv * sigmoidf_(a_); ss += o[e] * o[e]; }
                    u32x4 w; w.x = cvt_pk_bf16(o[0], o[1]); w.y = cvt_pk_bf16(o[2], o[3]); w.z = cvt_pk_bf16(o[4], o[5]); w.w = cvt_pk_bf16(o[6], o[7]);
                    *(u32x4*)(hb3 + off) = w; }
                ss += __shfl_xor(ss, 16); ss += __shfl_xor(ss, 32);
                if (fq == 0) unsafeAtomicAdd(rowss_out + row, ss); }
    }
};

__device__ __forceinline__ void tr_item(const float* __restrict__ W, int K, int N, int nvalid, bf16_t* __restrict__ WT, int drow0, LAS float*, int k0, int n0, int lane, const float* __restrict__ gain = nullptr) {
    const int ko = lane & 7, nq = lane >> 3; const int n = n0 + 4 * nq; const bool ok = n < nvalid;
    const float* src = W + (size_t)(k0 + 8 * ko) * N + n;
    f32x4 v[8];
#pragma unroll
    for (int i = 0; i < 8; ++i) v[i] = ok ? __builtin_nontemporal_load((const f32x4*)(src + (size_t)i * N)) : (f32x4){0.f, 0.f, 0.f, 0.f};
    if (gain) { const f32x4 g0 = *(const f32x4*)(gain + k0 + 8 * ko), g1 = *(const f32x4*)(gain + k0 + 8 * ko + 4);
#pragma unroll
        for (int i = 0; i < 4; ++i) { v[i] = v[i] * g0[i]; v[4 + i] = v[4 + i] * g1[i]; } }
#pragma unroll
    for (int j = 0; j < 4; ++j) { u32x4 o; o.x = cvt_pk_bf16(v[0][j], v[1][j]); o.y = cvt_pk_bf16(v[2][j], v[3][j]); o.z = cvt_pk_bf16(v[4][j], v[5][j]); o.w = cvt_pk_bf16(v[6][j], v[7][j]);
        __builtin_nontemporal_store(o, (u32x4*)(WT + (size_t)(drow0 + 4 * nq + j) * K + k0 + 8 * ko)); }
}
template <bool OUT_BF16>
__device__ __forceinline__ void rms_row(const float* src, const float* __restrict__ g, void* dst, int lane) {
    const f32x4* xr = (const f32x4*)src + 2 * lane; f32x4 v[8]; float s = 0.f;
#pragma unroll
    for (int j = 0; j < 4; ++j) { v[2 * j] = xr[128 * j]; v[2 * j + 1] = xr[128 * j + 1]; }
#pragma unroll
    for (int j = 0; j < 8; ++j) s += (v[j][0] * v[j][0] + v[j][1] * v[j][1]) + (v[j][2] * v[j][2] + v[j][3] * v[j][3]);
    const float rstd = 1.0f / sqrtf(wave_sum(s) * (1.f / DM) + 1e-6f);
#pragma unroll
    for (int j = 0; j < 4; ++j) { const f32x4 g0 = ((const f32x4*)g)[2 * lane + 128 * j], g1 = ((const f32x4*)g)[2 * lane + 128 * j + 1];
        const f32x4 y0 = v[2 * j] * rstd * g0, y1 = v[2 * j + 1] * rstd * g1;
        if (OUT_BF16) { u32x4 w; w.x = cvt_pk_bf16(y0[0], y0[1]); w.y = cvt_pk_bf16(y0[2], y0[3]); w.z = cvt_pk_bf16(y1[0], y1[1]); w.w = cvt_pk_bf16(y1[2], y1[3]); ((u32x4*)dst)[lane + 64 * j] = w; }
        else { ((f32x4*)dst)[2 * lane + 128 * j] = y0; ((f32x4*)dst)[2 * lane + 128 * j + 1] = y1; } }
}

__device__ __forceinline__ float gelu_tanh(float x) { const float y = 0.7978845608028654f * (x + 0.044715f * x * x * x); const float e = __expf(2.f * y); return 0.5f * x * (2.f - 2.f * __builtin_amdgcn_rcpf(e + 1.f)); }
__device__ __forceinline__ void compress_job(LAS unsigned char* lds, const bf16_t* __restrict__ X, const bf16_t* __restrict__ W1t, const bf16_t* __restrict__ W2t,
                                             const float* __restrict__ bias, bf16_t* outc, int b, int g, int n0) {
    int tid_ = threadIdx.x; asm volatile("" : "+v"(tid_));
    const int tid = tid_, wid = __builtin_amdgcn_readfirstlane(tid >> 6), lane = tid & 63, fr = lane & 15, fq = lane >> 4;
    const int nn = min(n0 + fr, 126);
    const bf16_t* Ab = X + ((size_t)b * SEQ + 16 * nn) * 256 + g * 128 + 16 * fq;
    const bf16_t* Bb = W1t + (size_t)fr * 4096 + 16 * fq;
    f32x4 acc[8];
#pragma unroll
    for (int ct = 0; ct < 8; ++ct) acc[ct] = (f32x4){0.f, 0.f, 0.f, 0.f};
#pragma unroll 1
    for (int i = 0; i < 8; i += 2) {
        bf16x8 av[2][2], bv[2][8][2];
#pragma unroll
        for (int u = 0; u < 2; ++u) { const int pp = 8 * wid + i + u; const bf16_t* ap = Ab + (pp >> 1) * 256 + (pp & 1) * 64;
            av[u][0] = *(const bf16x8*)ap; av[u][1] = *(const bf16x8*)(ap + 8);
#pragma unroll
            for (int ct = 0; ct < 8; ++ct) { const bf16_t* bp = Bb + (size_t)ct * 16 * 4096 + 64 * pp; bv[u][ct][0] = *(const bf16x8*)bp; bv[u][ct][1] = *(const bf16x8*)(bp + 8); } }
        __builtin_amdgcn_sched_barrier(0);
#pragma unroll
        for (int u = 0; u < 2; ++u)
#pragma unroll
            for (int hh = 0; hh < 2; ++hh)
#pragma unroll
                for (int ct = 0; ct < 8; ++ct) acc[ct] = __builtin_amdgcn_mfma_f32_16x16x32_bf16(av[u][hh], bv[u][ct][hh], acc[ct], 0, 0, 0);
    }
    LAS float* part = (LAS float*)lds;
#pragma unroll
    for (int ct = 0; ct < 8; ++ct)
#pragma unroll
        for (int r = 0; r < 4; ++r) part[(wid * 16 + 4 * fq + r) * 132 + 16 * ct + fr] = acc[ct][r];
    __syncthreads();
    LAS bf16_t* hid = (LAS bf16_t*)(lds + 67584);
    { const int row = tid >> 5, c4 = (tid & 31) * 4; f32x4 s = *(const f32x4*)(bias + c4);
      { f32x4 bp[31];
#pragma unroll
        for (int l = 1; l < 32; ++l) bp[l - 1] = *(const f32x4*)(bias + l * 128 + c4);
#pragma unroll
        for (int l = 1; l < 32; ++l) s += bp[l - 1]; }
#pragma unroll
      for (int w = 0; w < 8; ++w) s += *(const LAS f32x4*)(part + (w * 16 + row) * 132 + c4);
      u32x2 hw; hw.x = cvt_pk_bf16(gelu_tanh(s[0]), gelu_tanh(s[1])); hw.y = cvt_pk_bf16(gelu_tanh(s[2]), gelu_tanh(s[3]));
      *(LAS u32x2*)(hid + row * 136 + c4) = hw; }
    __syncthreads();
    f32x4 acc2 = {0.f, 0.f, 0.f, 0.f};
    const __amdgpu_buffer_rsrc_t orsrc = __builtin_amdgcn_make_buffer_rsrc(outc, 0, 8 * 128 * 128 * 2, 0x00020000);
#pragma unroll
    for (int s = 0; s < 4; ++s) { const bf16x8 a = *(const LAS bf16x8*)(hid + fr * 136 + 32 * s + 8 * fq);
        const bf16x8 bb = *(const bf16x8*)(W2t + (size_t)(16 * wid + fr) * 128 + 32 * s + 8 * fq); acc2 = __builtin_amdgcn_mfma_f32_16x16x32_bf16(a, bb, acc2, 0, 0, 0); }
#pragma unroll
    for (int r = 0; r < 4; ++r) { const int n = n0 + 4 * fq + r; const float v = (n == 127) ? 0.f : acc2[r];
        __builtin_amdgcn_raw_buffer_store_b16((short)(cvt_pk_bf16(v, v) & 0xffffu), orsrc, (unsigned)((((b * 2 + g) * 128 + n) * 128 + 16 * wid + fr) * 2), 0, 16); }
    __syncthreads();
}


template <bool FENCE>
__device__ __forceinline__ void signal_done(unsigned* cnt, unsigned n) {
    asm volatile("s_waitcnt vmcnt(0)" ::: "memory"); __syncthreads();
    if (threadIdx.x == 0 && n) { if (FENCE) { __builtin_amdgcn_fence(__ATOMIC_RELEASE, "agent"); asm volatile("s_waitcnt vmcnt(0)" ::: "memory"); }
        (void)__hip_atomic_fetch_add(cnt, n, __ATOMIC_RELAXED, __HIP_MEMORY_SCOPE_AGENT); }
}
__device__ __forceinline__ void wait_count(unsigned* cnt, unsigned want) {
    if (threadIdx.x == 0) { unsigned spins = 0;
        while (__hip_atomic_load(cnt, __ATOMIC_RELAXED, __HIP_MEMORY_SCOPE_AGENT) < want && ++spins < (1u << 22)) __builtin_amdgcn_s_sleep(2);
        __builtin_amdgcn_fence(__ATOMIC_ACQUIRE, "agent"); asm volatile("s_waitcnt vmcnt(0)" ::: "memory"); }
    __syncthreads();
}
namespace att {
constexpr float SCALE = 0.08838834764831845f, CL2 = SCALE * 1.4426950408889634f, NEGB = -1e30f;
#define KSWZ(row, colB) ((row) * 256 + ((colB) ^ (((row) & 7) << 4)))
#define SBAR() __builtin_amdgcn_sched_barrier(0)
__device__ __forceinline__ int crow(int r, int hi) { return (r & 3) + 8 * (r >> 2) + 4 * hi; }
__device__ __forceinline__ int v_st(int k, int c) { const int kk = (k & ~0xC) | ((k & 4) << 1) | ((k & 8) >> 1); return ((kk >> 3) * 4 + (c >> 5)) * 512 + ((kk & 7) * 32 + (c & 31)) * 2; }
__device__ __forceinline__ int v_rd_base(int lane) { return ((lane & 3) << 3) | (((lane >> 2) & 3) << 6) | (((lane >> 4) & 1) << 5) | (((lane >> 5) & 1) << 8); }
constexpr int v_rd_off(int d0, int ks, int half) { return d0 * 512 + ks * 4096 + half * 2048; }
template <int OFF> __device__ __forceinline__ s16x4 tr_read(int vb) { s16x4 r; asm volatile("ds_read_b64_tr_b16 %0, %1 offset:%2" : "=&v"(r) : "v"(vb), "i"(OFF) : "memory"); return r; }
template <int D0> __device__ __forceinline__ void pv_one(f32x16& od, int vb, bf16x8 pa0, bf16x8 pa1, bf16x8 pa2, bf16x8 pa3) {
    const s16x4 l0 = tr_read<v_rd_off(D0, 0, 0)>(vb), h0 = tr_read<v_rd_off(D0, 0, 1)>(vb), l1 = tr_read<v_rd_off(D0, 1, 0)>(vb), h1 = tr_read<v_rd_off(D0, 1, 1)>(vb);
    const s16x4 l2 = tr_read<v_rd_off(D0, 2, 0)>(vb), h2 = tr_read<v_rd_off(D0, 2, 1)>(vb), l3 = tr_read<v_rd_off(D0, 3, 0)>(vb), h3 = tr_read<v_rd_off(D0, 3, 1)>(vb);
    asm volatile("s_waitcnt lgkmcnt(0)" ::: "memory"); SBAR();
#define PK(L, H) (bf16x8){L[0], L[1], L[2], L[3], H[0], H[1], H[2], H[3]}
    od = __builtin_amdgcn_mfma_f32_32x32x16_bf16(pa0, PK(l0, h0), od, 0, 0, 0);
    od = __builtin_amdgcn_mfma_f32_32x32x16_bf16(pa1, PK(l1, h1), od, 0, 0, 0);
    od = __builtin_amdgcn_mfma_f32_32x32x16_bf16(pa2, PK(l2, h2), od, 0, 0, 0);
    od = __builtin_amdgcn_mfma_f32_32x32x16_bf16(pa3, PK(l3, h3), od, 0, 0, 0);
#undef PK
}
__device__ __forceinline__ void pv_d0(f32x16* o, int vb, bf16x8 pa0, bf16x8 pa1, bf16x8 pa2, bf16x8 pa3) {
    pv_one<0>(o[0], vb, pa0, pa1, pa2, pa3); pv_one<1>(o[1], vb, pa0, pa1, pa2, pa3); pv_one<2>(o[2], vb, pa0, pa1, pa2, pa3); pv_one<3>(o[3], vb, pa0, pa1, pa2, pa3);
}
__device__ __forceinline__ void qkt(f32x16& p0, f32x16& p1, const LAS char* Ks, const bf16x8* qr, int r32, int hi) {
    p0 = f32x16{}; p1 = f32x16{};
#pragma unroll
    for (int d0 = 0; d0 < 8; ++d0) { const int cb = (d0 * 16 + hi * 8) * 2;
        const bf16x8 b0 = *(const LAS bf16x8*)(Ks + KSWZ(r32, cb));
        const bf16x8 b1 = *(const LAS bf16x8*)(Ks + KSWZ(32 + r32, cb));
        p0 = __builtin_amdgcn_mfma_f32_32x32x16_bf16(b0, qr[d0], p0, 0, 0, 0);
        p1 = __builtin_amdgcn_mfma_f32_32x32x16_bf16(b1, qr[d0], p1, 0, 0, 0);
#ifdef QKT_SBAR
        if ((d0 & (QKT_SBAR - 1)) == QKT_SBAR - 1) SBAR();
#endif
    }
}
__device__ __forceinline__ void sm_step(f32x16& p0, f32x16& p1, bool lane_on, float& m_reg, float& l_reg, f32x16* o, LAS float* al_l, int r32, int hi,
                                        bf16x8& pa0, bf16x8& pa1, bf16x8& pa2, bf16x8& pa3, float& alpha_out) {
    float pmax = p0[0];
#pragma unroll
    for (int r = 1; r < 16; ++r) pmax = fmaxf(pmax, p0[r]);
#pragma unroll
    for (int r = 0; r < 16; ++r) pmax = fmaxf(pmax, p1[r]);
    pmax = lane_on ? pmax : NEGB;
    { auto rr = __builtin_amdgcn_permlane32_swap(__float_as_uint(pmax), __float_as_uint(pmax), false, false);
      pmax = fmaxf(__uint_as_float(rr[0]), __uint_as_float(rr[1])); }
    float mn, alpha;
    if (__all(pmax - m_reg <= 8.0f / SCALE)) { mn = m_reg; alpha = 1.f; }
    else { mn = fmaxf(m_reg, pmax); alpha = __builtin_amdgcn_exp2f((m_reg - mn) * CL2); }
    m_reg = mn; alpha_out = alpha;
    const float mnC = (!lane_on || mn < -1e29f) ? -INFINITY : -mn * CL2;
#pragma unroll
    for (int r = 0; r < 16; ++r) p0[r] = __builtin_amdgcn_exp2f(fmaf(p0[r], CL2, mnC));
#pragma unroll
    for (int r = 0; r < 16; ++r) p1[r] = __builtin_amdgcn_exp2f(fmaf(p1[r], CL2, mnC));
    float ps = 0.f;
#pragma unroll
    for (int r = 0; r < 16; ++r) ps += p0[r];
#pragma unroll
    for (int r = 0; r < 16; ++r) ps += p1[r];
    { auto rr = __builtin_amdgcn_permlane32_swap(__float_as_uint(ps), __float_as_uint(ps), false, false);
      ps = __uint_as_float(rr[0]) + __uint_as_float(rr[1]); }
    l_reg = l_reg * alpha + ps;
    if (__any(alpha < 1.f)) { if (hi == 0) al_l[r32] = alpha; LDS_WAIT();
#pragma unroll
        for (int d = 0; d < 4; ++d)
#pragma unroll
            for (int r = 0; r < 16; ++r) o[d][r] *= al_l[crow(r, hi)];
    }
#define PK4(P, BASE, OUT) do { unsigned a0_ = cvt_pk_bf16(P[BASE + 0], P[BASE + 1]), a1_ = cvt_pk_bf16(P[BASE + 2], P[BASE + 3]);   \
    unsigned b0_ = cvt_pk_bf16(P[BASE + 4], P[BASE + 5]), b1_ = cvt_pk_bf16(P[BASE + 6], P[BASE + 7]);                              \
    auto r0_ = __builtin_amdgcn_permlane32_swap(a0_, b0_, false, false); auto r1_ = __builtin_amdgcn_permlane32_swap(a1_, b1_, false, false); \
    u32x4 w_ = {r0_[0], r1_[0], r0_[1], r1_[1]}; OUT = __builtin_bit_cast(bf16x8, w_); } while (0)
    PK4(p0, 0, pa0); PK4(p0, 8, pa1); PK4(p1, 0, pa2); PK4(p1, 8, pa3);
#undef PK4
}
struct Stg { bf16x8 k0, k1, v0, v1; };
__device__ __forceinline__ void tile_load(Stg& s, const bf16_t* Kb, const bf16_t* Vb, int pitch, int key0, int sr, int sc) {
    s.k0 = *(const bf16x8*)(Kb + (size_t)(key0 + sr) * pitch + sc); s.k1 = *(const bf16x8*)(Kb + (size_t)(key0 + 32 + sr) * pitch + sc);
    s.v0 = *(const bf16x8*)(Vb + (size_t)(key0 + sr) * pitch + sc); s.v1 = *(const bf16x8*)(Vb + (size_t)(key0 + 32 + sr) * pitch + sc);
}
__device__ __forceinline__ void tile_write(LAS char* Kl, LAS char* Vl, const Stg& s, int sr, int sc) {
    *(LAS bf16x8*)(Vl + v_st(sr, sc)) = s.v0; *(LAS bf16x8*)(Vl + v_st(32 + sr, sc)) = s.v1;
    *(LAS bf16x8*)(Kl + KSWZ(sr, sc * 2)) = s.k0; *(LAS bf16x8*)(Kl + KSWZ(32 + sr, sc * 2)) = s.k1;
}
__device__ __forceinline__ void tile_dma(LAS char* Kl, LAS char* Vl, const bf16_t* Kb, const bf16_t* Vb, int pitch, int key0, int wid, int lane) {
#pragma unroll
    for (int h = 0; h < 2; ++h) {
        const int ch = wid * 2 + h; const int L = ch * 1024 + lane * 16;
        { const int row = L >> 8, c16 = ((L >> 4) & 15) ^ (row & 7);
          __builtin_amdgcn_global_load_lds((const unsigned*)(Kb + (size_t)(key0 + row) * pitch + c16 * 8), (LAS unsigned*)(Kl + ch * 1024), 16, 0, 0); }
        { const int sub = L >> 9, kk = (sub >> 2) * 8 + ((L >> 6) & 7), c8 = (sub & 3) * 4 + ((L >> 4) & 3);
          const int k = (kk & ~0xC) | ((kk & 4) << 1) | ((kk & 8) >> 1);
          __builtin_amdgcn_global_load_lds((const unsigned*)(Vb + (size_t)(key0 + k) * pitch + c8 * 8), (LAS unsigned*)(Vl + ch * 1024), 16, 0, 0); }
    }
}
template <int MODE>
__device__ __forceinline__ void finalize(const f32x16* o, float l_reg, float gate, LAS float* li_l, int r32, int hi, float* scrA, float* scrB, bf16_t* catp) {
    if (hi == 0) li_l[r32] = l_reg > 0.f ? gate / l_reg : 0.f;
    LDS_WAIT();
#pragma unroll
    for (int r = 0; r < 16; ++r) {
        const int rc = (r & 3) + 8 * (r >> 2);
        unsigned lo = (unsigned)(4 * hi) * 1024u + (unsigned)r32, lc = (unsigned)(4 * hi) * 2048u + (unsigned)r32;
        asm volatile("" : "+v"(lo), "+v"(lc));
        const float f = li_l[rc + 4 * hi];
        if (MODE == 2) {
            float va[4], vb[4];
#pragma unroll
            for (int d0 = 0; d0 < 4; ++d0) { va[d0] = scrA[lo + rc * 1024 + 32 * d0]; vb[d0] = scrB[lo + rc * 1024 + 32 * d0]; }
#pragma unroll
            for (int d0 = 0; d0 < 4; ++d0) { const float v = o[d0][r] * f + (va[d0] + vb[d0]); catp[lc + rc * 2048 + 32 * d0] = (bf16_t)(cvt_pk_bf16(v, v) & 0xffffu); }
            if (r & 1) asm volatile("" ::: "memory");
        } else {
#pragma unroll
            for (int d0 = 0; d0 < 4; ++d0) { const float v = o[d0][r] * f; if (MODE == 0) scrA[lo + rc * 1024 + 32 * d0] = v; else scrB[lo + rc * 1024 + 32 * d0] = v; }
        }
    }
    LDS_WAIT();
}
template <bool WIN>
__device__ __forceinline__ void run_branch(LAS char* K_l, LAS char* V_l, const bf16_t* Kb, const bf16_t* Vb, unsigned tiles, unsigned lanemask, int c, int tl,
                                           const bf16x8* qr, float& m_reg, float& l_reg, f32x16* o, LAS float* al_l, int r32, int hi, int wid, int lane, int vb0) {
    unsigned rem = tiles; int j = __builtin_ctz(rem); rem &= rem - 1;
    __syncthreads();
    tile_dma(K_l, V_l, Kb, Vb, 256, 64 * j, wid, lane);
    asm volatile("s_waitcnt vmcnt(0)" ::: "memory"); __syncthreads();
    int cur = 0;
    for (;;) {
        const int jn = rem ? __builtin_ctz(rem) : -1;
        if (jn >= 0) { rem &= rem - 1; tile_dma(K_l + (cur ^ 1) * 32768, V_l + (cur ^ 1) * 32768, Kb, Vb, 256, 64 * jn, wid, lane); }
        const bool lane_on = (lanemask >> j) & 1u;
#ifdef ATT_NOANY
        {
#else
        if (__any(lane_on)) {
#endif
            f32x16 p0, p1; qkt(p0, p1, K_l + cur * 32768, qr, r32, hi);
            if (j == c) {
                int tlv = tl - 4 * hi; asm volatile("" : "+v"(tlv));
#pragma unroll
                for (int r = 0; r < 16; ++r) { const int kk = (r & 3) + 8 * (r >> 2); p0[r] = (kk > tlv) ? NEGB : p0[r]; p1[r] = (kk + 32 > tlv) ? NEGB : p1[r]; }
            }
            if (WIN && j == c - 8) {
                int tlv = tl - 4 * hi; asm volatile("" : "+v"(tlv));
#pragma unroll
                for (int r = 0; r < 16; ++r) { const int kk = (r & 3) + 8 * (r >> 2); p0[r] = (kk <= tlv) ? NEGB : p0[r]; p1[r] = (kk + 32 <= tlv) ? NEGB : p1[r]; }
            }
            bf16x8 pa0, pa1, pa2, pa3; float al;
            sm_step(p0, p1, lane_on, m_reg, l_reg, o, al_l, r32, hi, pa0, pa1, pa2, pa3, al);
            pv_d0(o, vb0 + cur * 32768, pa0, pa1, pa2, pa3);
        }
        if (jn < 0) break;
        asm volatile("s_waitcnt vmcnt(0)" ::: "memory"); __syncthreads();
        j = jn; cur ^= 1;
    }
}
constexpr int L_V = 0, L_K = 16384, L_IMP = 65536, L_SIMP = 99328, L_MASK = 107776, L_WS = 108288;
__device__ __forceinline__ void attn_unit(LAS unsigned char* ldsb, const bf16_t* __restrict__ T, const bf16_t* kcmp, const bf16_t* vcmp,
                                          const float* __restrict__ gates, float* scr, float* scr2, bf16_t* cat, int b, int g, int c, unsigned* cmp_cnt) {
    LAS char* lds = (LAS char*)ldsb;
    int tid_ = threadIdx.x; asm volatile("" : "+v"(tid_));
    const int tid = tid_, wid = __builtin_amdgcn_readfirstlane(tid >> 6), lane = tid & 63, r32 = lane & 31, hi = lane >> 5;
    const int hh = wid & 3, ch = wid >> 2, h = g * 4 + hh;
    const int tl = 32 * ch + r32, t = 64 * c + tl;
    const size_t row = (size_t)b * SEQ + t;
    LAS char* V_l = lds + L_V; LAS char* K_l = lds + L_K;
    LAS float* impw = (LAS float*)(lds + L_IMP) + wid * 1056;
    LAS float* simp = (LAS float*)(lds + L_SIMP);
    LAS unsigned* maskw = (LAS unsigned*)(lds + L_MASK);
    LAS float* li_l = (LAS float*)(lds + L_WS) + wid * 64; LAS float* al_l = li_l + 32;
    bf16x8 qr[8];
    { const bf16_t* Qw = T + (size_t)(4 + (h >> 1)) * TS + row * 256 + (h & 1) * 128 + hi * 8;
#pragma unroll
      for (int d0 = 0; d0 < 8; ++d0) qr[d0] = *(const bf16x8*)(Qw + d0 * 16); }
    const int vb0 = (int)(uintptr_t)V_l + v_rd_base(lane);
    const float g0 = gates[row * 24 + h * 3 + 0], g1 = gates[row * 24 + h * 3 + 1], g2 = gates[row * 24 + h * 3 + 2];
    float* scrp = scr + ((size_t)b * SEQ + 64 * c + 32 * ch) * 1024 + h * 128;
    float* scrq = scr2 + ((size_t)b * SEQ + 64 * c + 32 * ch) * 1024 + h * 128;
    bf16_t* catp = cat + ((size_t)b * SEQ + 64 * c + 32 * ch) * DM + 1024 + h * 128;
    if (tid == 0) maskw[64] = 0u;
    if (wid >= 4) __builtin_amdgcn_s_setprio(1);
    float m_reg = NEGB, l_reg = 0.f; f32x16 o[4];
#pragma unroll
    for (int d = 0; d < 4; ++d) o[d] = f32x16{};
    { const bf16_t* Kb = T + (size_t)12 * TS + (size_t)b * SEQ * 256 + g * 128; const bf16_t* Vb = T + (size_t)13 * TS + (size_t)b * SEQ * 256 + g * 128;
      const int lo = c >= 8 ? c - 8 : 0; const unsigned wt = (c == 31 ? 0xffffffffu : ((1u << (c + 1)) - 1u)) & ~((1u << lo) - 1u);
#ifndef ATT_SKIP_B2
      run_branch<true>(K_l, V_l, Kb, Vb, wt, 0xffffffffu, c, tl, qr, m_reg, l_reg, o, al_l, r32, hi, wid, lane, vb0);
#endif
      finalize<0>(o, l_reg, g2, li_l, r32, hi, scrp, scrq, catp);
    }
    wait_count(cmp_cnt, 128u);
    m_reg = NEGB; l_reg = 0.f;
#pragma unroll
    for (int d = 0; d < 4; ++d) o[d] = f32x16{};
    {
        const bf16_t* Kb = kcmp + (size_t)(b * 2 + g) * 128 * 128; const bf16_t* Vb = vcmp + (size_t)(b * 2 + g) * 128 * 128;
        const int nmax = (t >= 31) ? ((t - 31) >> 4) : -1;
        bf16x8 pa0, pa1, pa2, pa3; float alA, alB;
        float inn[4][4], lst[4][4];
        __syncthreads();
        tile_dma(K_l, V_l, Kb, Vb, 128, 0, wid, lane); tile_dma(K_l + 32768, V_l + 32768, Kb, Vb, 128, 64, wid, lane);
        asm volatile("s_waitcnt vmcnt(0)" ::: "memory"); __syncthreads();
        {
            f32x16 a0, a1;
            qkt(a0, a1, K_l, qr, r32, hi);
#pragma unroll
            for (int r = 0; r < 16; ++r) { const int n = crow(r, hi); a0[r] = (n <= nmax) ? a0[r] : NEGB; a1[r] = (n + 32 <= nmax) ? a1[r] : NEGB; }
            sm_step(a0, a1, true, m_reg, l_reg, o, al_l, r32, hi, pa0, pa1, pa2, pa3, alA);
#pragma unroll
            for (int c4 = 0; c4 < 4; ++c4) { inn[0][c4] = (a0[4 * c4] + a0[4 * c4 + 1]) + (a0[4 * c4 + 2] + a0[4 * c4 + 3]); lst[0][c4] = a0[4 * c4 + 3];
                                             inn[1][c4] = (a1[4 * c4] + a1[4 * c4 + 1]) + (a1[4 * c4 + 2] + a1[4 * c4 + 3]); lst[1][c4] = a1[4 * c4 + 3]; }
        }
        pv_d0(o, vb0, pa0, pa1, pa2, pa3);
        {
            f32x16 b0, b1;
            qkt(b0, b1, K_l + 32768, qr, r32, hi);
#pragma unroll
            for (int r = 0; r < 16; ++r) { const int n = 64 + crow(r, hi); b0[r] = (n <= nmax) ? b0[r] : NEGB; b1[r] = (n + 32 <= nmax) ? b1[r] : NEGB; }
            sm_step(b0, b1, true, m_reg, l_reg, o, al_l, r32, hi, pa0, pa1, pa2, pa3, alB);
#pragma unroll
            for (int c4 = 0; c4 < 4; ++c4) { inn[2][c4] = (b0[4 * c4] + b0[4 * c4 + 1]) + (b0[4 * c4 + 2] + b0[4 * c4 + 3]); lst[2][c4] = b0[4 * c4 + 3];
                                             inn[3][c4] = (b1[4 * c4] + b1[4 * c4 + 1]) + (b1[4 * c4 + 2] + b1[4 * c4 + 3]); lst[3][c4] = b1[4 * c4 + 3]; }
        }
        pv_d0(o, vb0 + 32768, pa0, pa1, pa2, pa3);
        const float inv = l_reg > 0.f ? 1.f / l_reg : 0.f; const float fa = alB * inv, fb = inv;
        float x[4][4];
#pragma unroll
        for (int TT = 0; TT < 4; ++TT)
#pragma unroll
            for (int c4 = 0; c4 < 4; ++c4) { const float f = TT < 2 ? fa : fb; inn[TT][c4] *= f; lst[TT][c4] *= f; x[TT][c4] = __shfl_xor(lst[TT][c4], 32); }
#pragma unroll
        for (int TT = 0; TT < 4; ++TT)
#pragma unroll
            for (int c4 = 0; c4 < 4; ++c4) {
                const float plo = c4 >= 1 ? x[TT][c4 >= 1 ? c4 - 1 : 0] : (TT >= 1 ? x[TT >= 1 ? TT - 1 : 0][3] : 0.f);
                const float prev = hi ? x[TT][c4] : plo;
                impw[r32 * 33 + 8 * TT + 2 * c4 + hi] = inn[TT][c4] + prev;
            }
#ifndef ATT_SKIP_FIN
        finalize<1>(o, l_reg, g0, li_l, r32, hi, scrp, scrq, catp);
#endif
    }
    __syncthreads();
    {
        const int pidx = tid >> 3, sub = tid & 7;
        const LAS float* ib = (const LAS float*)(lds + L_IMP) + ((pidx >> 5) * 4) * 1056 + (pidx & 31) * 33;
#pragma unroll
        for (int jj = 0; jj < 4; ++jj) { const int j = 4 * sub + jj; float sv = (ib[j] + ib[1056 + j]) + (ib[2112 + j] + ib[3168 + j]);
            if (j > c) sv = -1.f; else if (j == 0 || j == c || j == c - 1) sv = 3.0e38f;
            simp[pidx * 33 + j] = sv; }
        __syncthreads();
        float vj[4]; int rk[4];
#pragma unroll
        for (int jj = 0; jj < 4; ++jj) { vj[jj] = simp[pidx * 33 + 4 * sub + jj]; rk[jj] = 0; }
#pragma unroll 1
        for (int i = 0; i < 32; ++i) { const float vi = simp[pidx * 33 + i];
#pragma unroll
            for (int jj = 0; jj < 4; ++jj) rk[jj] += (vi > vj[jj] || (vi == vj[jj] && i < 4 * sub + jj)) ? 1 : 0; }
        unsigned bits = 0u;
#pragma unroll
        for (int jj = 0; jj < 4; ++jj) { const int j = 4 * sub + jj; if (rk[jj] < 16 && j <= c) bits |= 1u << j; }
        bits |= __shfl_xor(bits, 1); bits |= __shfl_xor(bits, 2); bits |= __shfl_xor(bits, 4);
        if (sub == 0) maskw[pidx] = bits;
        bits |= __shfl_xor(bits, 8); bits |= __shfl_xor(bits, 16); bits |= __shfl_xor(bits, 32);
        if (lane == 0) atomicOr((unsigned*)(maskw + 64), bits);
    }
    __syncthreads();
    const unsigned umask = __builtin_amdgcn_readfirstlane(maskw[64]);
    const unsigned mymask = maskw[tl];
    m_reg = NEGB; l_reg = 0.f;
#pragma unroll
    for (int d = 0; d < 4; ++d) o[d] = f32x16{};
    { const bf16_t* Kb = T + (size_t)10 * TS + (size_t)b * SEQ * 256 + g * 128; const bf16_t* Vb = T + (size_t)11 * TS + (size_t)b * SEQ * 256 + g * 128;
#ifndef ATT_SKIP_B1
      run_branch<false>(K_l, V_l, Kb, Vb, umask, mymask, c, tl, qr, m_reg, l_reg, o, al_l, r32, hi, wid, lane, vb0);
#endif
#ifndef ATT_SKIP_FIN
      finalize<2>(o, l_reg, g1, li_l, r32, hi, scrp, scrq, catp);
#endif
    }
    __builtin_amdgcn_s_setprio(0);
    __syncthreads();
}
}

template <int W>
__device__ __forceinline__ void pool_rows16(const float* __restrict__ Z, const float* __restrict__ scale, bf16_t* cat, int base, int q) {
    const int seq0 = base & ~(SEQ - 1);
    f32x4 v[15 + W];
#pragma unroll
    for (int i = 0; i < 15 + W; ++i) { const int r = base - (W - 1) + i; v[i] = (r >= seq0) ? *((const f32x4*)Z + (size_t)r * 256 + q) : (f32x4){0.f, 0.f, 0.f, 0.f}; }
    const f32x4 sv = ((const f32x4*)scale)[q];
#pragma unroll
    for (int j = 0; j < 16; ++j) { f32x4 s = v[j + W - 1];
#pragma unroll
        for (int k = 1; k < W; ++k) s += v[j + W - 1 - k];
        const int t = (base + j) & (SEQ - 1); const int n = min(W, t + 1); const float rc = 1.0f / (float)n;
        const f32x4 y = (s * rc - v[j + W - 1]) * sv;
        u32x2 wv; wv.x = cvt_pk_bf16(y[0], y[1]); wv.y = cvt_pk_bf16(y[2], y[3]);
        *(u32x2*)(cat + (size_t)(base + j) * DM + 4 * q) = wv; }
}
__device__ __forceinline__ void pool_finalize(const float* __restrict__ Z, const float* __restrict__ scale, bf16_t* cat, int row_begin, int nrows) {
    const int q = threadIdx.x & 255, grp = __builtin_amdgcn_readfirstlane((int)(threadIdx.x & 255) >> 6);
    for (int base = row_begin + 16 * (int)(threadIdx.x >> 8); base < row_begin + nrows; base += 32) {
        if (grp == 0) pool_rows16<2>(Z, scale, cat, base, q); else if (grp == 1) pool_rows16<4>(Z, scale, cat, base, q);
        else if (grp == 2) pool_rows16<8>(Z, scale, cat, base, q); else pool_rows16<16>(Z, scale, cat, base, q);
    }
}

#define XB_TMO      128
#define XB_XCNT(j)  (256  + 64 * (j))
#define XB_XSUB(j)  (1280 + 64 * (j))
#define XB_XGEN(j)  (2304 + 64 * (j))
#define XB_TOP      3328
#define XB_TOPGEN   3392
#define XCD_BAR_WORDS 3456
#define XB_SPIN_CAP (1u << 18)

__device__ __forceinline__ unsigned xb_ld(unsigned* p)              { return __hip_atomic_load(p, __ATOMIC_RELAXED, __HIP_MEMORY_SCOPE_AGENT); }
__device__ __forceinline__ unsigned xb_add(unsigned* p, unsigned v) { return __hip_atomic_fetch_add(p, v, __ATOMIC_RELAXED, __HIP_MEMORY_SCOPE_AGENT); }
__device__ __forceinline__ unsigned xb_xcc_id() { return (unsigned)__builtin_amdgcn_s_getreg((3 << 11) | 20) & 0xFu; }
#define XB_SPIN(cond, bar) do { unsigned _sp = 0; while (cond) { __builtin_amdgcn_s_sleep(1); \
    if ((++_sp & 255u) == 0u) { if (xb_ld(&(bar)[XB_TMO])) break; if (_sp > XB_SPIN_CAP) { atomicAdd(&(bar)[XB_TMO], 1u); break; } } } } while (0)

struct XcdBarrier {
    unsigned* bar; unsigned x;
    volatile LAS unsigned* st;
};

__device__ __forceinline__ XcdBarrier xcd_barrier_post(unsigned* bar, volatile LAS unsigned* st) {
    XcdBarrier b; b.bar = bar; b.x = xb_xcc_id(); b.st = st;
    if (threadIdx.x == 0) (void)xb_add(&bar[XB_XCNT(b.x)], 1u);
    return b;
}
__device__ __forceinline__ void xcd_barrier_complete(unsigned* bar, unsigned x, unsigned& nloc, unsigned& nx) {
    const unsigned G = gridDim.x * gridDim.y * gridDim.z;
    unsigned sum, cnt, mine, sp = 0u;
    for (;;) {
        sum = 0u; cnt = 0u; mine = 0u;
#pragma unroll
        for (unsigned j = 0; j < 16; ++j) { const unsigned c = xb_ld(&bar[XB_XCNT(j)]); sum += c; cnt += (c > 0u) ? 1u : 0u; mine = (j == x) ? c : mine; }
        if (sum == G) break;
        __builtin_amdgcn_s_sleep(1);
        if ((++sp & 255u) == 0u) { if (xb_ld(&bar[XB_TMO])) break; if (sp > XB_SPIN_CAP) { atomicAdd(&bar[XB_TMO], 1u); break; } }
    }
    nloc = mine > 0u ? mine : 1u; nx = cnt > 0u ? cnt : 1u;
}

__device__ __forceinline__ void xcd_barrier(const XcdBarrier& b) {
    asm volatile("s_waitcnt vmcnt(0)" ::: "memory");
    __syncthreads();
    if (threadIdx.x == 0) {
        unsigned* bar = b.bar;
        __builtin_amdgcn_s_waitcnt(0);
        unsigned nloc = b.st[0], nx = b.st[1];
        if (nloc == 0u) { xcd_barrier_complete(bar, b.x, nloc, nx); b.st[0] = nloc; b.st[1] = nx; }
        const unsigned old = xb_add(&bar[XB_XSUB(b.x)], 1u);
        const unsigned gen = old / nloc;
        if (old + 1u == (gen + 1u) * nloc) {
            __builtin_amdgcn_fence(__ATOMIC_RELEASE, "agent");
            asm volatile("s_waitcnt vmcnt(0)" ::: "memory");
            const unsigned og = xb_add(&bar[XB_TOP], 1u);
            const unsigned tg = og / nx;
            if (og + 1u == (tg + 1u) * nx) xb_add(&bar[XB_TOPGEN], 1u);
            else XB_SPIN(xb_ld(&bar[XB_TOPGEN]) == tg, bar);
            __builtin_amdgcn_fence(__ATOMIC_ACQUIRE, "agent");
            xb_add(&bar[XB_XGEN(b.x)], 1u);
            asm volatile("s_waitcnt vmcnt(0)" ::: "memory");
        } else {
            XB_SPIN(xb_ld(&bar[XB_XGEN(b.x)]) == gen, bar);
            __builtin_amdgcn_fence(__ATOMIC_ACQUIRE, "agent");
            asm volatile("s_waitcnt vmcnt(0)" ::: "memory");
        }
    }
    __syncthreads();
}

#ifndef REPF
#define REPF 1
#endif
struct Args { const float* in[21]; float* out; unsigned char* ws; int ph_lo, ph_hi; };
#ifndef MK_PER_PHASE
#define MK_PER_PHASE 0
#endif
__global__ void __launch_bounds__(NTHREADS, 2) hymba_fwd(Args a) {
    extern __shared__ __attribute__((aligned(16))) unsigned char lds_raw[];
    LAS unsigned char* lds = (LAS unsigned char*)lds_raw;
    unsigned* xbar_words = (unsigned*)(a.ws + 262144);
    volatile LAS unsigned* xb_st = (volatile LAS unsigned*)(lds + 131072 + 64);
    if (threadIdx.x < 2) xb_st[threadIdx.x] = 0u;
    __syncthreads();
    XcdBarrier xb = xcd_barrier_post(xbar_words, xb_st);
    unsigned* ctl = (unsigned*)(a.ws + 262144 + 16384);
#define PHASE_IDS() int tid_ = threadIdx.x; asm volatile("" : "+v"(tid_)); const int tid = tid_, lane = tid & 63, wave = __builtin_amdgcn_readfirstlane(tid >> 6); \
    const int gw = bid * 8 + wave, NGW = G * 8, gtid = bid * NTHREADS + tid, GT = G * NTHREADS; (void)lane; (void)gw; (void)NGW; (void)gtid; (void)GT;
    const int G = gridDim.x, bid = blockIdx.x;
    unsigned char* ws = a.ws;
    const float* x = a.in[0]; float* hbuf = a.out;
    bf16_t* Win_t = (bf16_t*)(ws + WS_WIN); bf16_t* Wout_t = (bf16_t*)(ws + WS_WOUT); bf16_t* Wpg_t = (bf16_t*)(ws + WS_WPG); bf16_t* Wd_t = (bf16_t*)(ws + WS_WD);
    bf16_t* Wgu_t = (bf16_t*)(ws + WS_WGU); bf16_t* Wpp_t = (bf16_t*)(ws + WS_WPP); bf16_t* poolw_t = (bf16_t*)(ws + WS_POOLW);
    bf16_t* W1k = (bf16_t*)(ws + WS_W1K); bf16_t* W1v = (bf16_t*)(ws + WS_W1V); bf16_t* W2k = (bf16_t*)(ws + WS_W2K); bf16_t* W2v = (bf16_t*)(ws + WS_W2V);
    bf16_t* PBF = (bf16_t*)(ws + WS_PBF); bf16_t* XN = (bf16_t*)(ws + WS_XN); bf16_t* T = (bf16_t*)(ws + WS_T); float* Z = (float*)(ws + WS_Z);
    float* SCR = (float*)(ws + WS_SCR); bf16_t* ACT = (bf16_t*)(ws + WS_ACT); bf16_t* PP = (bf16_t*)a.out;
    float* rowss1 = (float*)(ws + 65536); float* rowss2 = (float*)(ws + 131072); float* rowss3 = (float*)(ws + 196608); bf16_t* HB1 = (bf16_t*)(ws + WS_SCR);
    float* cosT = (float*)(ws + WS_COS); float* sinT = (float*)(ws + WS_SIN); float* gatesb = (float*)(ws + WS_GATES);
    bf16_t* kcmp = (bf16_t*)(ws + WS_KCMP); bf16_t* vcmp = (bf16_t*)(ws + WS_VCMP); float* biasp = (float*)(ws + WS_BIASK);

#ifndef SKIP_P0
#ifndef REP0
#define REP0 1
#endif
    if (a.ph_lo <= 0 && 0 < a.ph_hi) for (int rep0 = 0; rep0 < REP0; ++rep0) {
        if (rep0) xcd_barrier(xb);
    {
        PHASE_IDS();
        LAS float* scr = (LAS float*)(lds + wave * 16384);
        constexpr int I_IN = 32 * 120, I_SQ = 32 * 64, I_GU = 32 * 176, I_DN = 88 * 64, I_PP = 4 * 64, I_PW = 4 * 8, I_W1 = 64 * 4, I_W2 = 2 * 4;
        constexpr int NITEMS = I_IN + 2 * I_SQ + 2 * I_GU + I_DN + I_PP + 4 * I_PW + 2 * I_W1 + 2 * I_W2;
        for (int it = gw; it < NITEMS; it += NGW) {
            int r = it; const float* Wsrc; const float* gain = nullptr; bf16_t* dst; int Kk, Nn, nv, nblk, mode = 0;
            if (r < I_GU) { Wsrc = a.in[14]; Kk = DM; Nn = DFF; nv = DFF; nblk = 176; dst = Wgu_t; mode = 1; gain = a.in[13]; }
            else if ((r -= I_GU) < I_GU) { Wsrc = a.in[15]; Kk = DM; Nn = DFF; nv = DFF; nblk = 176; dst = Wgu_t; mode = 2; gain = a.in[13]; }
            else if ((r -= I_GU) < I_DN) { Wsrc = a.in[16]; Kk = DFF; Nn = DM; nv = DM; nblk = 64; dst = Wd_t; }
            else if ((r -= I_DN) < I_IN) { Wsrc = a.in[3]; Kk = DM; Nn = INW; nv = INW; nblk = 120; dst = Win_t; }
            else if ((r -= I_IN) < I_SQ) { Wsrc = a.in[12]; Kk = DM; Nn = DM; nv = DM; nblk = 64; dst = Wout_t; }
            else if ((r -= I_SQ) < I_SQ) { Wsrc = a.in[18]; Kk = DM; Nn = DM; nv = DM; nblk = 64; dst = Wpg_t; gain = a.in[17]; }
            else if ((r -= I_SQ) < I_PP) { Wsrc = a.in[19]; Kk = PLE; Nn = DM; nv = DM; nblk = 64; dst = Wpp_t; }
            else if ((r -= I_PP) < 4 * I_PW) { const int gq = r / I_PW; r -= gq * I_PW; Wsrc = a.in[4] + gq * 65536; Kk = 256; Nn = 256; nv = 256; nblk = 8; dst = poolw_t + gq * 65536; }
            else if ((r -= 4 * I_PW) < I_W1) { Wsrc = a.in[7]; Kk = 4096; Nn = 128; nv = 128; nblk = 4; dst = W1k; }
            else if ((r -= I_W1) < I_W1) { Wsrc = a.in[10]; Kk = 4096; Nn = 128; nv = 128; nblk = 4; dst = W1v; }
            else if ((r -= I_W1) < I_W2) { Wsrc = a.in[8]; Kk = 128; Nn = 128; nv = 128; nblk = 4; dst = W2k; }
            else { r -= I_W2; Wsrc = a.in[11]; Kk = 128; Nn = 128; nv = 128; nblk = 4; dst = W2v; }
            const int grp = r >> 3, wq = r & 7, gpr = nblk >> 2, gkb = grp / gpr, gnb = grp - gkb * gpr; const int kb = gkb * 2 + (wq >> 2), nb = gnb * 4 + (wq & 3), n0 = nb * 32;
            const int drow = mode == 0 ? n0 : ((n0 >> 7) * 256 + (n0 & 127) + (mode == 2 ? 128 : 0));
            tr_item(Wsrc, Kk, Nn, nv, dst, drow, scr, kb * 64, n0, lane, gain);
        }
        for (int m = gw; m < MROWS; m += NGW) rms_row<true>(x + (size_t)m * DM, a.in[2], XN + (size_t)m * DM, lane);
        for (int i = gtid; i < MROWS * PLE / 8; i += GT) { const f32x4 v0 = ((const f32x4*)a.in[1])[2 * i], v1 = ((const f32x4*)a.in[1])[2 * i + 1]; u32x4 w; w.x = cvt_pk_bf16(v0[0], v0[1]); w.y = cvt_pk_bf16(v0[2], v0[3]); w.z = cvt_pk_bf16(v1[0], v1[1]); w.w = cvt_pk_bf16(v1[2], v1[3]); ((u32x4*)PBF)[i] = w; }
        for (int i = gtid; i < 3 * MROWS; i += GT) { if (i < MROWS) rowss1[i] = 0.f; else if (i < 2 * MROWS) rowss2[i - MROWS] = 0.f; else rowss3[i - 2 * MROWS] = 0.f; }
        for (int i = (G == 256 ? (tid < 128 ? bid * 128 + tid : SEQ * 16) : gtid); i < SEQ * 16; i += GT) { const int pos = i >> 4, fi = i & 15; const float inv = exp2f(-(float)fi * (18.931568569324174f / 16.f)); const float ang = (float)pos * inv;
            cosT[i] = cosf(ang); sinT[i] = sinf(ang); }
        __syncthreads();
        for (int tsk = (G == 256 ? bid - 192 : bid); tsk < 64; tsk += G) { if (tsk < 0) break;
            const int kv = tsk >> 5, l = tsk & 31; const float* pe = a.in[kv == 0 ? 6 : 9] + l * 128; const float* w1 = a.in[kv == 0 ? 7 : 10] + (size_t)l * 128 * 128;
            const int cc = tid & 127, part = tid >> 7; float s = 0.f;
#pragma unroll 8
            for (int k = part * 32; k < part * 32 + 32; ++k) s += pe[k] * w1[(size_t)k * 128 + cc];
            LAS float* red = (LAS float*)lds; red[part * 128 + cc] = s; __syncthreads();
            if (tid < 128) biasp[(size_t)tsk * 128 + tid] = (red[tid] + red[128 + tid]) + (red[256 + tid] + red[384 + tid]);
            __syncthreads();
        }
    }
    }
#endif
    if (a.ph_lo <= 0 && 1 < a.ph_hi) xcd_barrier(xb);
#ifndef SKIP_P1
#ifndef REP1
#define REP1 1
#endif
    if (a.ph_lo <= 1 && 1 < a.ph_hi) for (int rep1 = 0; rep1 < REP1; ++rep1) {
        if (rep1) xcd_barrier(xb);
    {
        pg8::Gemm g{XN, Win_t, MROWS, INWP, DM}; pg8::StaticOrder S; S.init(MROWS, INWP, G, bid);
        EpiInProj E{T, gatesb, cosT, sinT};
        pg8::gemm_phase<EpiInProj, pg8::StaticOrder, true, true>(lds, g, S, E);
    }
    }
#endif
    if (a.ph_lo <= 1 && 2 < a.ph_hi) xcd_barrier(xb);
#ifndef SKIP_P2
#ifndef REP2
#define REP2 1
#endif
    if (a.ph_lo <= 2 && 2 < a.ph_hi) for (int rep2 = 0; rep2 < REP2; ++rep2) {
        if (rep2) xcd_barrier(xb);
    {
        pg8::Gemm g{T, poolw_t, 4 * MROWS, 1024, 256}; PoolOrder S{G, bid}; EpiPoolZ E{Z};
        pg8::gemm_phase<EpiPoolZ, PoolOrder, true, true>(lds, g, S, E);
        signal_done<false>(ctl + 64, bid < 128 ? (unsigned)((127 - bid) / G + 1) : 0u);
        unsigned njobs = 0;
        for (int job = G - 1 - bid; job < 128; job += G) {
            const int kv = job >> 6, b = (job >> 4) & 3, gg = (job >> 3) & 1, n0 = (job & 7) * 16;
            compress_job(lds, T + (size_t)(8 + kv) * TS, kv ? W1v : W1k, kv ? W2v : W2k, biasp + (size_t)kv * 32 * 128, kv ? vcmp : kcmp, b, gg, n0);
            ++njobs;
        }
        signal_done<false>(ctl, njobs);
    }
    }
#endif
#ifndef SKIP_P3
#ifndef REP3
#define REP3 1
#endif
    if (a.ph_lo <= 3 && 3 < a.ph_hi) for (int rep3 = 0; rep3 < REP3; ++rep3) {
        if (rep3) xcd_barrier(xb);
    {
        bf16_t* CAT = XN;
        for (int u = bid; u < 256; u += G) { const int bg = u & 7, c = (u < 128) ? 16 + (u >> 3) : 15 - ((u - 128) >> 3); att::attn_unit(lds, T, kcmp, vcmp, gatesb, SCR, hbuf, CAT, bg >> 1, bg & 1, c, ctl); }
        wait_count(ctl + 64, 128u);
        { const int per = (MROWS + G - 1) / G; const int r0 = bid * per; const int nr = min(per, MROWS - r0); if (nr > 0) for (int repf = 0; repf < REPF; ++repf) pool_finalize(Z, a.in[5], CAT, r0, nr); }
    }
    }
#endif
    if (a.ph_lo <= 3 && 4 < a.ph_hi) xcd_barrier(xb);
#ifndef SKIP_P4
    if (a.ph_lo <= 4 && 4 < a.ph_hi) {
    {
        pg8::Gemm g{XN, Wout_t, MROWS, DM, DM}; pg8::StaticOrder S; S.init(MROWS, DM, G, bid); EpiResidNorm E{x, nullptr, HB1, rowss1};
        pg8::gemm_phase<EpiResidNorm, pg8::StaticOrder, true, true>(lds, g, S, E);
    }
    }
#endif
    if (a.ph_lo <= 4 && 5 < a.ph_hi) xcd_barrier(xb);
#ifndef SKIP_P5
    if (a.ph_lo <= 5 && 5 < a.ph_hi) {
    { }
    }
#endif
#ifndef SKIP_P6
#ifndef REP6
#define REP6 1
#endif
    if (a.ph_lo <= 6 && 6 < a.ph_hi) for (int rep6 = 0; rep6 < REP6; ++rep6) {
        if (rep6) xcd_barrier(xb);
    {
        pg8::Gemm g{HB1, Wgu_t, MROWS, 2 * DFF, DM}; pg8::StaticOrder S; S.init(MROWS, 2 * DFF, G, bid); EpiSwiglu E{ACT, rowss1};
        pg8::gemm_phase<EpiSwiglu, pg8::StaticOrder, true, true>(lds, g, S, E);
        if (G == 256) {
            pg8::Gemm g2{PBF, Wpp_t, MROWS, DM, PLE}; UpperOrder S2; S2.S.init(MROWS, DM, 1, 0); S2.lo = 128; S2.nup = 128; S2.c = bid; EpiStoreBf16 E2{PP, DM};
            pg8::gemm_phase<EpiStoreBf16, UpperOrder, true, true>(lds, g2, S2, E2);
        } else { pg8::Gemm g2{PBF, Wpp_t, MROWS, DM, PLE}; pg8::StaticOrder S2; S2.init(MROWS, DM, G, bid); EpiStoreBf16 E2{PP, DM}; pg8::gemm_phase<EpiStoreBf16, pg8::StaticOrder, true, true>(lds, g2, S2, E2); }
    }
    }
#endif
    if (a.ph_lo <= 6 && 7 < a.ph_hi) xcd_barrier(xb);
#ifndef SKIP_P7
    if (a.ph_lo <= 7 && 7 < a.ph_hi) {
    {
        pg8::Gemm g{ACT, Wd_t, MROWS, DM, DFF}; pg8::StaticOrder S; S.init(MROWS, DM, G, bid); EpiResidNorm E{nullptr, HB1, XN, rowss2};
        pg8::gemm_phase<EpiResidNorm, pg8::StaticOrder, true, true>(lds, g, S, E);
    }
    }
#endif
    if (a.ph_lo <= 7 && 8 < a.ph_hi) xcd_barrier(xb);
#ifndef SKIP_P8
    if (a.ph_lo <= 8 && 8 < a.ph_hi) {
    {
    }
    }
#endif
    __syncthreads();
#ifndef SKIP_P9
    if (a.ph_lo <= 9 && 9 < a.ph_hi) {
    {
        pg8::Gemm g{XN, Wpg_t, MROWS, DM, DM}; pg8::StaticOrder S; S.init(MROWS, DM, G, bid); EpiPle E{XN, PP, rowss2, HB1, rowss3};
        pg8::gemm_phase<EpiPle, pg8::StaticOrder, true, true>(lds, g, S, E);
    }
    }
#endif
    if (a.ph_lo <= 9 && 10 < a.ph_hi) xcd_barrier(xb);
#ifdef EXTRA_SYNCS
    for (int es = 0; es < EXTRA_SYNCS; ++es) xcd_barrier(xb);
#endif
#ifndef SKIP_P10
    if (a.ph_lo <= 10 && 10 < a.ph_hi) {
#ifdef DBG_STOP
        { PHASE_IDS(); const bf16_t* dbg = (const bf16_t*)(ws + (size_t)DBG_OFF * MiB);
          for (size_t i = gtid; i < (size_t)MROWS * DM; i += GT) {
#ifdef DBG_NANDET
              const float bv = __uint_as_float((unsigned)((const bf16_t*)(ws + WS_KCMP))[i % 131072] << 16); const float wv = __uint_as_float((unsigned)((const bf16_t*)(ws + WS_VCMP))[i % 131072] << 16);
              const bool bad1 = !(fabsf(bv) < 1e30f), bad2 = !(fabsf(wv) < 1e30f);
              hbuf[i] = x[i] + (bad1 ? 1000.f : 0.f) + (bad2 ? 3000.f : 0.f);
#else
              float dv = __uint_as_float((unsigned)dbg[i % ((size_t)DBG_ELEMS)] << 16); if (!(fabsf(dv) < 1e30f)) dv = 1000.f; hbuf[i] = x[i] + DBG_SCALE * dv;
#endif
          } }
        xcd_barrier(xb);
#endif
    { PHASE_IDS();
      for (int m = gw; m < MROWS; m += NGW) { const float rstd = 1.0f / sqrtf(rowss3[m] * (1.f / DM) + 1e-6f); const u32x4* hr = (const u32x4*)(HB1 + (size_t)m * DM); f32x4* orow = (f32x4*)(hbuf + (size_t)m * DM);
#pragma unroll
          for (int j = 0; j < 4; ++j) { const u32x4 w = hr[lane + 64 * j]; const f32x4 g0 = ((const f32x4*)a.in[20])[2 * lane + 128 * j], g1 = ((const f32x4*)a.in[20])[2 * lane + 128 * j + 1];
              const f32x4 v0 = {__uint_as_float(w.x << 16), __uint_as_float(w.x & 0xffff0000u), __uint_as_float(w.y << 16), __uint_as_float(w.y & 0xffff0000u)};
              const f32x4 v1 = {__uint_as_float(w.z << 16), __uint_as_float(w.z & 0xffff0000u), __uint_as_float(w.w << 16), __uint_as_float(w.w & 0xffff0000u)};
              orow[2 * lane + 128 * j] = v0 * rstd * g0; orow[2 * lane + 128 * j + 1] = v1 * rstd * g1; } } }
    }
#endif
}

extern "C" void kernel_launch(void* const* d_in, const int* in_sizes, int n_in, void* d_out, int out_size, void* d_ws, size_t ws_size, hipStream_t stream) {
    static int grid = 0;
    if (grid == 0) {
        if (n_in != 21 || in_sizes[0] != MROWS * DM || out_size != MROWS * DM || ws_size < WS_END) {
            fprintf(stderr, "kernel_launch: unexpected shapes (n_in %d, in0 %d, out %d, ws %zu < %zu)\n", n_in, n_in > 0 ? in_sizes[0] : -1, out_size, ws_size, (size_t)WS_END); grid = -1; return; }
        int dev = 0, cus = 0, per_cu = 0;
        hipGetDevice(&dev); hipDeviceGetAttribute(&cus, hipDeviceAttributeMultiprocessorCount, dev);
        if (hipFuncSetAttribute((const void*)hymba_fwd, hipFuncAttributeMaxDynamicSharedMemorySize, LDS_BYTES) != hipSuccess) { fprintf(stderr, "kernel_launch: hipFuncSetAttribute failed\n"); grid = -1; return; }
        if (hipOccupancyMaxActiveBlocksPerMultiprocessor(&per_cu, (const void*)hymba_fwd, NTHREADS, LDS_BYTES) != hipSuccess || per_cu < 1) { fprintf(stderr, "kernel_launch: occupancy query failed (%d)\n", per_cu); grid = -1; return; }
        grid = cus * per_cu;
        fprintf(stderr, "kernel_launch: %d CUs x %d blocks/CU -> grid %d\n", cus, per_cu, grid);
    }
    if (grid < 0) return;
    Args a{};
    for (int i = 0; i < 21; ++i) a.in[i] = (const float*)d_in[i];
    a.out = (float*)d_out; a.ws = (unsigned char*)d_ws;
#if MK_PER_PHASE
    hipError_t e = hipSuccess;
#ifdef DBG_STOP
    for (int k = 0; k <= DBG_STOP; ++k) { a.ph_lo = k; a.ph_hi = k + 1; hipLaunchKernelGGL(hymba_fwd, dim3(grid), dim3(NTHREADS), LDS_BYTES, stream, a); }
    { a.ph_lo = 10; a.ph_hi = 11; void* args[] = {&a}; (void)hipLaunchCooperativeKernel((const void*)hymba_fwd, dim3(grid), dim3(NTHREADS), args, LDS_BYTES, stream); }
#else
    for (int k = 0; k < 11; ++k) { a.ph_lo = k; a.ph_hi = k + 1; hipLaunchKernelGGL(hymba_fwd, dim3(grid), dim3(NTHREADS), LDS_BYTES, stream, a); }
#endif
    e = hipPeekAtLastError();
#else
    a.ph_lo = 0; a.ph_hi = 11;
    if (hipMemsetAsync((char*)d_ws + 262144, 0, 32768, stream) != hipSuccess) { fprintf(stderr, "kernel_launch: hipMemsetAsync failed\n"); return; }
    void* args[] = {&a};
    hipError_t e = hipLaunchCooperativeKernel((const void*)hymba_fwd, dim3(grid), dim3(NTHREADS), args, LDS_BYTES, stream);
#endif
    if (e != hipSuccess) fprintf(stderr, "kernel_launch: cooperative launch failed: %s (grid %d)\n", hipGetErrorString(e), grid);
}
```
